# Optimizing an MI355X kernel written in HIP

```python
import math
import jax, jax.numpy as jnp
from jax import lax
import numpy as np

D_MODEL = 4096
BATCH = 2
SEQ = 8192
DEPTH = 2

RMS_EPS = 1e-6
MIX_WIDTH = D_MODEL
POOL_GROUPS = 4
POOL_WINDOWS = (2, 4, 8, 16)
POOL_WIDTH = MIX_WIDTH // 4
POOL_GROUP_DIM = POOL_WIDTH // POOL_GROUPS
NSA_HEAD_DIM = 128
NSA_HEADS = (MIX_WIDTH - POOL_WIDTH) // NSA_HEAD_DIM
NSA_KV_GROUPS = 4
NSA_HEADS_PER_GROUP = NSA_HEADS // NSA_KV_GROUPS
NSA_WIDTH = NSA_HEADS * NSA_HEAD_DIM
NSA_KV_WIDTH = NSA_KV_GROUPS * NSA_HEAD_DIM
N_BRANCH = 3
CMP_BLOCK = 32
CMP_STRIDE = 16
CMP_HIDDEN = 256
SLC_BLOCK = 64
SLC_TOPN = 16
SWA_WINDOW = 512
NSA_Q_BLOCK = 64
FORCE_BONUS = 1e4
NEG = -1e30
AB_IN_WIDTH = POOL_WIDTH + NSA_WIDTH + 2 * N_BRANCH * NSA_KV_WIDTH + N_BRANCH * NSA_HEADS
MLSTM_HEADS = 8
MLSTM_V_DIM = MIX_WIDTH // MLSTM_HEADS
MLSTM_QK_DIM = MLSTM_V_DIM // 2
MLSTM_CHUNK = 64
C_IN_WIDTH = 2 * MLSTM_HEADS * MLSTM_QK_DIM + 2 * MIX_WIDTH + 2 * MLSTM_HEADS
D_FF = 10944
CONV_WIDTH = 3

N_EVEN = (DEPTH + 1) // 2
N_ODD = DEPTH // 2

kernel_name = 'hybrid_pool_nsa_mlstm_convffn'


def _rmsnorm(x, gain):
    xf = x.astype(jnp.float32)
    y = xf * lax.rsqrt(jnp.mean(xf * xf, axis=-1, keepdims=True) + RMS_EPS)
    return (y * gain.astype(jnp.float32)).astype(x.dtype)


def _masked_softmax(s, mask):
    return jax.nn.softmax(jnp.where(mask, s, NEG), axis=-1)


def _pool_mixer(u, w_pool, scale):
    B_, S_, _ = u.shape
    uf = u.astype(jnp.float32).reshape(B_, S_, POOL_GROUPS, POOL_GROUP_DIM)
    cs = jnp.pad(jnp.cumsum(uf, axis=1), ((0, 0), (1, 0), (0, 0), (0, 0)))
    t = jnp.arange(S_)
    groups = []
    for g, w in enumerate(POOL_WINDOWS):
        lo = jnp.maximum(t + 1 - w, 0)
        win_sum = cs[:, 1:, g] - jnp.take(cs[:, :, g], lo, axis=1)
        count = jnp.minimum(t + 1, w).astype(jnp.float32)[None, :, None]
        groups.append(win_sum / count - uf[:, :, g])
    pooled = jnp.stack(groups, axis=2)
    y = jnp.einsum('bsgc,gcd->bsgd', pooled, w_pool.astype(jnp.float32))
    return y.reshape(B_, S_, POOL_WIDTH) * scale.astype(jnp.float32)


def _compress(kv, pos, w1, w2):
    B_, S_ = kv.shape[:2]
    n_cmp = (S_ - CMP_BLOCK) // CMP_STRIDE + 1
    idx = jnp.arange(n_cmp)[:, None] * CMP_STRIDE + jnp.arange(CMP_BLOCK)[None, :]
    blocks = kv[:, idx] + pos.astype(jnp.float32)[None, None, :, None, :]
    flat = jnp.transpose(blocks, (0, 3, 1, 2, 4)).reshape(B_, NSA_KV_GROUPS, n_cmp, CMP_BLOCK * NSA_HEAD_DIM)
    return jax.nn.gelu(flat @ w1.astype(jnp.float32)) @ w2.astype(jnp.float32)


def _nsa(q, k_cmp, v_cmp, k_slc, v_slc, k_swa, v_swa, gate_logits, cmp_pos, ck_w1, ck_w2, cv_w1, cv_w2):
    B_, S_ = q.shape[:2]
    G, HG, DH, QB = NSA_KV_GROUPS, NSA_HEADS_PER_GROUP, NSA_HEAD_DIM, NSA_Q_BLOCK
    n_cmp = (S_ - CMP_BLOCK) // CMP_STRIDE + 1
    n_slc = S_ // SLC_BLOCK
    top_n = min(SLC_TOPN, n_slc)
    qg = jnp.transpose(q.reshape(B_, S_, G, HG, DH), (0, 2, 3, 1, 4)) * (DH ** -0.5)
    gates = jnp.transpose(jax.nn.sigmoid(gate_logits).reshape(B_, S_, G, HG, N_BRANCH), (0, 2, 3, 1, 4))
    kc = _compress(k_cmp, cmp_pos, ck_w1, ck_w2)
    vc = _compress(v_cmp, cmp_pos, cv_w1, cv_w2)
    cmp_start = jnp.arange(n_cmp) * CMP_STRIDE
    cmp_end = cmp_start + CMP_BLOCK - 1
    slc_start = jnp.arange(n_slc) * SLC_BLOCK
    overlap = jnp.clip(jnp.minimum(cmp_start[:, None] + CMP_BLOCK, slc_start[None, :] + SLC_BLOCK)
                       - jnp.maximum(cmp_start[:, None], slc_start[None, :]), 0).astype(jnp.float32) / CMP_STRIDE
    ks_blocks = jnp.transpose(k_slc.reshape(B_, n_slc, SLC_BLOCK, G, DH), (0, 3, 1, 2, 4))
    vs_blocks = jnp.transpose(v_slc.reshape(B_, n_slc, SLC_BLOCK, G, DH), (0, 3, 1, 2, 4))
    pad = ((0, 0), (0, 0), (SWA_WINDOW, 0), (0, 0))
    kw_pad = jnp.pad(jnp.transpose(k_swa, (0, 2, 1, 3)), pad)
    vw_pad = jnp.pad(jnp.transpose(v_swa, (0, 2, 1, 3)), pad)
    gather_blocks = jax.vmap(jax.vmap(lambda blk, idx: blk[idx]))
    blk_ids = jnp.arange(n_slc)

    def query_block(qb):
        t0 = qb * QB
        t = t0 + jnp.arange(QB)
        qblk = lax.dynamic_slice_in_dim(qg, t0, QB, axis=3)
        gblk = lax.dynamic_slice_in_dim(gates, t0, QB, axis=3)
        valid_c = cmp_end[None, :] <= t[:, None]
        s_c = jnp.einsum('bghqd,bgnd->bghqn', qblk, kc)
        p_c = _masked_softmax(s_c, valid_c) * jnp.any(valid_c, axis=-1)[:, None].astype(jnp.float32)
        o_c = jnp.einsum('bghqn,bgnd->bghqd', p_c, vc)
        imp = jnp.einsum('bghqn,nj->bgqj', p_c, overlap)
        cur = t // SLC_BLOCK
        forced = (blk_ids[None, :] == 0) | (blk_ids[None, :] == cur[:, None]) | (blk_ids[None, :] == cur[:, None] - 1)
        future = blk_ids[None, :] * SLC_BLOCK > t[:, None]
        imp = jnp.where(forced, imp + FORCE_BONUS, jnp.where(future, -FORCE_BONUS, imp))
        _, sel = lax.top_k(imp, top_n)
        k_sel = gather_blocks(ks_blocks, sel).reshape(B_, G, QB, top_n * SLC_BLOCK, DH)
        v_sel = gather_blocks(vs_blocks, sel).reshape(B_, G, QB, top_n * SLC_BLOCK, DH)
        pos_sel = (sel[..., None] * SLC_BLOCK + jnp.arange(SLC_BLOCK)).reshape(B_, G, QB, top_n * SLC_BLOCK)
        s_s = jnp.einsum('bghqd,bgqkd->bghqk', qblk, k_sel)
        p_s = _masked_softmax(s_s, (pos_sel <= t[:, None])[:, :, None])
        o_s = jnp.einsum('bghqk,bgqkd->bghqd', p_s, v_sel)
        k_w = lax.dynamic_slice_in_dim(kw_pad, t0, QB + SWA_WINDOW, axis=2)
        v_w = lax.dynamic_slice_in_dim(vw_pad, t0, QB + SWA_WINDOW, axis=2)
        pos_w = t0 - SWA_WINDOW + jnp.arange(QB + SWA_WINDOW)
        dist = t[:, None] - pos_w[None, :]
        valid_w = (dist >= 0) & (dist < SWA_WINDOW) & (pos_w[None, :] >= 0)
        s_w = jnp.einsum('bghqd,bgkd->bghqk', qblk, k_w)
        o_w = jnp.einsum('bghqk,bgkd->bghqd', _masked_softmax(s_w, valid_w), v_w)
        return gblk[..., 0:1] * o_c + gblk[..., 1:2] * o_s + gblk[..., 2:3] * o_w

    out = lax.map(query_block, jnp.arange(S_ // QB))
    return jnp.transpose(out, (1, 0, 4, 2, 3, 5)).reshape(B_, S_, NSA_WIDTH)


def _ab_mixer(u, w_in, pool_w, pool_scale, cmp_pos, ck_w1, ck_w2, cv_w1, cv_w2, w_out):
    B_, S_, _ = u.shape
    proj = u @ w_in
    sizes = [POOL_WIDTH, NSA_WIDTH] + [NSA_KV_WIDTH] * (2 * N_BRANCH)
    cuts = []
    acc = 0
    for sz in sizes:
        acc += sz
        cuts.append(acc)
    p_in, q, kc, vc, ks, vs, kw, vw, g = jnp.split(proj, cuts, axis=-1)
    kvs = [a.astype(jnp.float32).reshape(B_, S_, NSA_KV_GROUPS, NSA_HEAD_DIM) for a in (kc, vc, ks, vs, kw, vw)]
    y_a = _pool_mixer(p_in, pool_w, pool_scale)
    y_b = _nsa(q.astype(jnp.float32).reshape(B_, S_, NSA_HEADS, NSA_HEAD_DIM), *kvs,
               g.astype(jnp.float32).reshape(B_, S_, NSA_HEADS, N_BRANCH), cmp_pos, ck_w1, ck_w2, cv_w1, cv_w2)
    return jnp.concatenate([y_a, y_b], axis=-1).astype(u.dtype) @ w_out


def _mlstm(q, k, v, ig, fg):
    B_, S_, H = q.shape[:3]
    L = MLSTM_CHUNK
    nc = S_ // L

    def to_chunks(a):
        a = a.astype(jnp.float32).reshape((B_, nc, L, H) + a.shape[3:])
        return jnp.moveaxis(a, (1, 3), (0, 2))

    qc = to_chunks(q) * (MLSTM_QK_DIM ** -0.5)
    kc, vc, ic = to_chunks(k), to_chunks(v), to_chunks(ig)
    lfc = jax.nn.log_sigmoid(to_chunks(fg))
    causal = jnp.tril(jnp.ones((L, L), dtype=bool))

    def step(carry, xs):
        C, n, m = carry
        qq, kk, vv, ii, lf = xs
        b = jnp.cumsum(lf, axis=-1)
        dmat = jnp.where(causal, b[..., :, None] - b[..., None, :] + ii[..., None, :], -jnp.inf)
        a = b + m[..., None]
        m_t = jnp.maximum(a, jnp.max(dmat, axis=-1))
        wq = jnp.einsum('bhtd,bhsd->bhts', qq, kk) * jnp.exp(dmat - m_t[..., None])
        inter = jnp.exp(a - m_t)
        num = inter[..., None] * jnp.einsum('bhtd,bhde->bhte', qq, C) + jnp.einsum('bhts,bhse->bhte', wq, vv)
        den = inter * jnp.einsum('bhtd,bhd->bht', qq, n) + jnp.sum(wq, axis=-1)
        h = num / jnp.maximum(jnp.abs(den), jnp.exp(-m_t))[..., None]
        b_last = b[..., -1]
        g = b_last[..., None] - b + ii
        m_new = jnp.maximum(b_last + m, jnp.max(g, axis=-1))
        decay = jnp.exp(b_last + m - m_new)
        kw = kk * jnp.exp(g - m_new[..., None])[..., None]
        C_new = decay[..., None, None] * C + jnp.einsum('bhsd,bhse->bhde', kw, vv)
        n_new = decay[..., None] * n + jnp.sum(kw, axis=2)
        return (C_new, n_new, m_new), h

    init = (jnp.zeros((B_, H, MLSTM_QK_DIM, MLSTM_V_DIM), jnp.float32),
            jnp.zeros((B_, H, MLSTM_QK_DIM), jnp.float32),
            jnp.zeros((B_, H), jnp.float32))
    _, hs = lax.scan(step, init, (qc, kc, vc, ic, lfc))
    return jnp.moveaxis(hs, (0, 2), (1, 3)).reshape(B_, S_, H, MLSTM_V_DIM)


def _c_mixer(u, w_in, b_if, head_norm, w_out):
    B_, S_, _ = u.shape
    H = MLSTM_HEADS
    qk_w = H * MLSTM_QK_DIM
    proj = u @ w_in
    q, k, v, o, gif = jnp.split(proj, [qk_w, 2 * qk_w, 2 * qk_w + MIX_WIDTH, 2 * qk_w + 2 * MIX_WIDTH], axis=-1)
    gif = gif.astype(jnp.float32) + b_if.astype(jnp.float32)
    h = _mlstm(q.reshape(B_, S_, H, MLSTM_QK_DIM), k.reshape(B_, S_, H, MLSTM_QK_DIM),
               v.reshape(B_, S_, H, MLSTM_V_DIM), gif[..., :H], gif[..., H:])
    h = h * lax.rsqrt(jnp.mean(h * h, axis=-1, keepdims=True) + RMS_EPS) * head_norm.astype(jnp.float32)
    y = jax.nn.sigmoid(o.astype(jnp.float32)) * h.reshape(B_, S_, MIX_WIDTH)
    return y.astype(u.dtype) @ w_out


def _conv_ffn(u, w_in, conv_w, conv_b, w_out):
    S_ = u.shape[1]
    hid = u @ w_in
    gate, up = hid[..., :D_FF], hid[..., D_FF:]
    gp = jnp.pad(gate, ((0, 0), (CONV_WIDTH - 1, 0), (0, 0)))
    gate = (conv_b + conv_w[0] * gp[:, 2:2 + S_] + conv_w[1] * gp[:, 1:1 + S_] + conv_w[2] * gp[:, 0:S_])
    return (jax.nn.silu(gate) * up) @ w_out


def setup_inputs(seed: int = 0) -> dict:
    key = jax.random.key(seed)
    ks = jax.random.split(key, 24)
    f32 = jnp.float32

    def nrm(k, shape, scale):
        return jax.random.normal(k, shape, f32) * scale

    def gain(k, shape, s=0.02):
        return 1.0 + s * jax.random.normal(k, shape, f32)

    H = MLSTM_HEADS
    b_if = jnp.concatenate([nrm(ks[12], (N_ODD, H), 0.1),
                            jnp.linspace(3.0, 6.0, H, dtype=f32)[None, :] + nrm(ks[13], (N_ODD, H), 0.1)], axis=-1)
    cmp_in = CMP_BLOCK * NSA_HEAD_DIM
    return {
        'x': nrm(ks[0], (BATCH, SEQ, D_MODEL), 1.0),
        'ln_pre': gain(ks[1], (DEPTH, D_MODEL)),
        'ln_post': gain(ks[2], (DEPTH, D_MODEL)),
        'w_in_ab': nrm(ks[3], (N_EVEN, D_MODEL, AB_IN_WIDTH), D_MODEL ** -0.5),
        'pool_w': nrm(ks[4], (N_EVEN, POOL_GROUPS, POOL_GROUP_DIM, POOL_GROUP_DIM), POOL_GROUP_DIM ** -0.5),
        'pool_scale': gain(ks[5], (N_EVEN, POOL_WIDTH), 0.1),
        'cmp_pos': nrm(ks[6], (N_EVEN, CMP_BLOCK, NSA_HEAD_DIM), 0.1),
        'cmp_k_w1': nrm(ks[7], (N_EVEN, cmp_in, CMP_HIDDEN), cmp_in ** -0.5),
        'cmp_k_w2': nrm(ks[8], (N_EVEN, CMP_HIDDEN, NSA_HEAD_DIM), CMP_HIDDEN ** -0.5),
        'cmp_v_w1': nrm(ks[9], (N_EVEN, cmp_in, CMP_HIDDEN), cmp_in ** -0.5),
        'cmp_v_w2': nrm(ks[10], (N_EVEN, CMP_HIDDEN, NSA_HEAD_DIM), CMP_HIDDEN ** -0.5),
        'w_out_ab': nrm(ks[11], (N_EVEN, MIX_WIDTH, D_MODEL), MIX_WIDTH ** -0.5),
        'w_in_c': nrm(ks[14], (N_ODD, D_MODEL, C_IN_WIDTH), D_MODEL ** -0.5),
        'b_if_c': b_if,
        'head_norm_c': gain(ks[15], (N_ODD, H, MLSTM_V_DIM)),
        'w_out_c': nrm(ks[16], (N_ODD, MIX_WIDTH, D_MODEL), MIX_WIDTH ** -0.5),
        'ffn_ln_pre': gain(ks[17], (DEPTH, D_MODEL)),
        'ffn_ln_post': gain(ks[18], (DEPTH, D_MODEL)),
        'ffn_w_in': nrm(ks[19], (DEPTH, D_MODEL, 2 * D_FF), D_MODEL ** -0.5),
        'ffn_conv_w': nrm(ks[20], (DEPTH, CONV_WIDTH, D_FF), CONV_WIDTH ** -0.5),
        'ffn_conv_b': nrm(ks[21], (DEPTH, D_FF), 0.02),
        'ffn_w_out': nrm(ks[22], (DEPTH, D_FF, D_MODEL), D_FF ** -0.5),
    }


def reference(x, ln_pre, ln_post, w_in_ab, pool_w, pool_scale, cmp_pos, cmp_k_w1, cmp_k_w2, cmp_v_w1, cmp_v_w2,
              w_out_ab, w_in_c, b_if_c, head_norm_c, w_out_c, ffn_ln_pre, ffn_ln_post, ffn_w_in, ffn_conv_w,
              ffn_conv_b, ffn_w_out):
    h = x
    for layer in range(DEPTH):
        i = layer // 2
        u = _rmsnorm(h, ln_pre[layer])
        if layer % 2 == 0:
            y = _ab_mixer(u, w_in_ab[i], pool_w[i], pool_scale[i], cmp_pos[i], cmp_k_w1[i], cmp_k_w2[i],
                          cmp_v_w1[i], cmp_v_w2[i], w_out_ab[i])
        else:
            y = _c_mixer(u, w_in_c[i], b_if_c[i], head_norm_c[i], w_out_c[i])
        h = h + _rmsnorm(y, ln_post[layer])
        u = _rmsnorm(h, ffn_ln_pre[layer])
        f = _conv_ffn(u, ffn_w_in[layer], ffn_conv_w[layer], ffn_conv_b[layer], ffn_w_out[layer])
        h = h + _rmsnorm(f, ffn_ln_post[layer])
    return h
```

```cpp
#include <hip/hip_runtime.h>
#include <cstdio>
#include <cstdint>
namespace pg8 {
#define PG8_LAS __attribute__((address_space(3)))
typedef unsigned short bf16_t;
typedef short bf16x8 __attribute__((ext_vector_type(8)));
typedef float f32x4 __attribute__((ext_vector_type(4)));
typedef unsigned u32x4 __attribute__((ext_vector_type(4)));
constexpr int BM = 256, BK = 64, HALF = 128, HTB = HALF * BK * 2  , STAGE_BYTES = 8 * HTB, NXCD = 8, WGM = 8;

__host__ __device__ __forceinline__ int lds_byte(int r, int c) { const int st = (r >> 4) * 2 + (c >> 5), rr = r & 15, cc = c & 31, ob = rr * 64 + cc * 2; return st * 1024 + (ob ^ (((ob >> 9) & 1) << 5)); }
__host__ __device__ __forceinline__ void stage_rc(int b, int& R, int& C) { const int st = b / 1024, sb = b % 1024, swz = sb ^ (((sb >> 9) & 1) << 5); R = (st >> 1) * 16 + swz / 64; C = (st & 1) * 32 + (swz % 64) / 2; }
__host__ __device__ __forceinline__ int perm32(int rho) { const int n = rho >> 4, i = rho & 15; return 8 * (i >> 2) + 4 * n + (i & 3); }

struct Unit { int pm, pn; };
struct Gemm { const bf16_t* A; const bf16_t* Bt; int M, N, K; };

struct StaticOrder {
    int nM, nN, nwg, G, c;
    __host__ __device__ void init(int M, int N, int G_, int c_) { nM = M / BM; nN = N / BM; nwg = nM * nN; G = G_; c = c_; }
    __host__ __device__ bool next(int i, Unit& u) const {
        const long L = (long)i * G + c; if (L >= nwg) return false;
        int wgid = (int)L; { const int q = nwg / NXCD, r = nwg % NXCD, xcd = wgid % NXCD, off = wgid / NXCD; wgid = (xcd < r ? xcd * (q + 1) : r * (q + 1) + (xcd - r) * q) + off; }
        const int nig = WGM * nN, gid = wgid / nig, fm = gid * WGM, gsz = (nM - fm) < WGM ? (nM - fm) : WGM;
        u.pm = fm + ((wgid % nig) % gsz); u.pn = (wgid % nig) / gsz; return true;
    }
    __device__ __forceinline__ void a_ready(const Unit&) const {}
    __device__ __forceinline__ void done(const Unit&) const {}
};

__device__ __forceinline__ unsigned cvt_pk_bf16(float lo, float hi) { unsigned r; asm volatile("v_cvt_pk_bf16_f32 %0, %1, %2" : "=v"(r) : "v"(lo), "v"(hi)); return r; }

struct EpiBf16P {
    static constexpr bool PERM = true, AFTER_DRAIN = false;
    bf16_t* O; int ldc;
    __device__ __forceinline__ void operator()(const f32x4 (&acc)[2][2][4][2], const Unit& u, int wr, int wc, int fr, int fq) const {
        const int row0 = u.pm * BM + wr * 64 + fr, col0 = u.pn * BM + wc * 32 + 8 * fq;
#pragma unroll
        for (int ai = 0; ai < 2; ++ai)
#pragma unroll
            for (int m = 0; m < 4; ++m) { bf16_t* rowp = O + (size_t)(row0 + ai * HALF + m * 16) * ldc + col0;
#pragma unroll
                for (int bj = 0; bj < 2; ++bj) { const f32x4 v0 = acc[ai][bj][m][0], v1 = acc[ai][bj][m][1];
                    u32x4 w; w.x = cvt_pk_bf16(v0[0], v0[1]); w.y = cvt_pk_bf16(v0[2], v0[3]); w.z = cvt_pk_bf16(v1[0], v1[1]); w.w = cvt_pk_bf16(v1[2], v1[3]);
                    *(u32x4*)(rowp + bj * HALF) = w; } }
    }
};
struct EpiGU {
    static constexpr bool PERM = true, AFTER_DRAIN = false;
    bf16_t* G; bf16_t* U; int ldc;
    __device__ __forceinline__ void operator()(const f32x4 (&acc)[2][2][4][2], const Unit& u, int wr, int wc, int fr, int fq) const {
        const int row0 = u.pm * BM + wr * 64 + fr, col0 = u.pn * HALF + wc * 32 + 8 * fq;
#pragma unroll
        for (int ai = 0; ai < 2; ++ai)
#pragma unroll
            for (int m = 0; m < 4; ++m) { const size_t off = (size_t)(row0 + ai * HALF + m * 16) * ldc + col0;
#pragma unroll
                for (int bj = 0; bj < 2; ++bj) { const f32x4 v0 = acc[ai][bj][m][0], v1 = acc[ai][bj][m][1];
                    u32x4 w; w.x = cvt_pk_bf16(v0[0], v0[1]); w.y = cvt_pk_bf16(v0[2], v0[3]); w.z = cvt_pk_bf16(v1[0], v1[1]); w.w = cvt_pk_bf16(v1[2], v1[3]);
                    *(u32x4*)((bj == 0 ? G : U) + off) = w; } }
    }
};
struct EpiF32P {
    static constexpr bool PERM = false, AFTER_DRAIN = false;
    float* C; int ldc;
    __device__ __forceinline__ void operator()(const f32x4 (&acc)[2][2][4][2], const Unit& u, int wr, int wc, int fr, int fq) const {
        const int row0 = u.pm * BM + wr * 64 + fr, col0 = u.pn * BM + wc * 32 + 4 * fq;
#pragma unroll
        for (int ai = 0; ai < 2; ++ai)
#pragma unroll
            for (int m = 0; m < 4; ++m) { float* rowp = C + (size_t)(row0 + ai * HALF + m * 16) * ldc + col0;
#pragma unroll
                for (int bj = 0; bj < 2; ++bj)
#pragma unroll
                    for (int n = 0; n < 2; ++n) *(f32x4*)(rowp + bj * HALF + n * 16) = acc[ai][bj][m][n]; }
    }
};

template <class Epi, class Sched, bool ALIGN_EPI = false, bool SP2 = false>
__device__ __forceinline__ void gemm_phase(PG8_LAS unsigned char* lds, const Gemm g, const Sched& S, const Epi& E) {
    const int tid = threadIdx.x, wid = __builtin_amdgcn_readfirstlane(tid >> 6), lane = tid & 63, wr = wid >> 2, wc = wid & 3, fr = lane & 15, fq = lane >> 4;
    const int K = g.K, nt = K / BK;
    unsigned voffA[2], voffB[2];
#pragma unroll
    for (int i = 0; i < 2; ++i) { int R, C; stage_rc(tid * 16 + i * 8192, R, C); const int Rb = Epi::PERM ? ((R & ~31) + perm32(R & 31)) : R;
        voffA[i] = (unsigned)(R * K + C) * 2u; voffB[i] = (unsigned)(Rb * K + C) * 2u; }
    const size_t kstep = (size_t)(BK * 2);
    const size_t hstep = (size_t)HALF * K * 2;
    const size_t tstep = 2 * hstep;
    const unsigned ldsw = (unsigned)wid * 1024u;
    const int aoff = lds_byte(wr * 64 + fr, fq * 8), boff = lds_byte(wc * 32 + fr, fq * 8);
#define PG8_SA(b, h) (((b) * 2 + (h)) * HTB)
#define PG8_SB(b, h) ((4 + (b) * 2 + (h)) * HTB)
#define PG8_STAGE(bufoff, gbase, voff) do { _Pragma("unroll") for (int _i = 0; _i < 2; ++_i) \
        __builtin_amdgcn_global_load_lds((const unsigned*)((const char*)(gbase) + (voff)[_i]), (PG8_LAS unsigned*)(lds + (bufoff) + ldsw + _i * 8192), 16, 0, 0); } while (0)
#define PG8_LDA(dst, b, h) do { _Pragma("unroll") for (int m = 0; m < 4; ++m) _Pragma("unroll") for (int k = 0; k < 2; ++k) dst[m][k] = *(const PG8_LAS bf16x8*)(lds + PG8_SA(b, h) + aoff + m * 2048 + k * 1024); } while (0)
#define PG8_LDB(dst, b, h) do { _Pragma("unroll") for (int n = 0; n < 2; ++n) _Pragma("unroll") for (int k = 0; k < 2; ++k) dst[n][k] = *(const PG8_LAS bf16x8*)(lds + PG8_SB(b, h) + boff + n * 2048 + k * 1024); } while (0)
#define PG8_MMA(ai, bj, At, Bt) do { __builtin_amdgcn_s_setprio(1); _Pragma("unroll") for (int m = 0; m < 4; ++m) _Pragma("unroll") for (int n = 0; n < 2; ++n) _Pragma("unroll") for (int k = 0; k < 2; ++k) \
        acc[ai][bj][m][n] = __builtin_amdgcn_mfma_f32_16x16x32_bf16(Bt[n][k], At[m][k], acc[ai][bj][m][n], 0, 0, 0); __builtin_amdgcn_s_setprio(0); } while (0)
#define PG8_WAIT_V(n) asm volatile("s_waitcnt vmcnt(" #n ")" ::: "memory")
#define PG8_WAIT_L(n) asm volatile("s_waitcnt lgkmcnt(" #n ")" ::: "memory")
#define PG8_BAR __builtin_amdgcn_s_barrier()
#define PG8_SCHED __builtin_amdgcn_sched_barrier(0)
    Unit cur, nxt; int ui = 0;
    if (!S.next(0, cur)) return;
    f32x4 acc[2][2][4][2];
#pragma unroll
    for (int a = 0; a < 2; ++a)
#pragma unroll
        for (int b = 0; b < 2; ++b)
#pragma unroll
            for (int m = 0; m < 4; ++m)
#pragma unroll
                for (int n = 0; n < 2; ++n) acc[a][b][m][n] = (f32x4){0.f, 0.f, 0.f, 0.f};
    bf16x8 At[4][2], B0[2][2], B1[2][2];
    const char* cA = (const char*)g.A + (size_t)cur.pm * tstep; const char* cB = (const char*)g.Bt + (size_t)cur.pn * tstep;
    S.a_ready(cur);
    if constexpr (SP2) {
        PG8_STAGE(PG8_SB(0, 0), cB, voffB); PG8_STAGE(PG8_SB(0, 1), cB + hstep, voffB); PG8_STAGE(PG8_SA(0, 0), cA, voffA); PG8_STAGE(PG8_SA(0, 1), cA + hstep, voffA);
        if (wr == 1) PG8_BAR;
        PG8_WAIT_V(2); PG8_BAR;
        PG8_STAGE(PG8_SB(1, 0), cB + kstep, voffB); PG8_STAGE(PG8_SA(1, 0), cA + kstep, voffA); PG8_STAGE(PG8_SB(1, 1), cB + hstep + kstep, voffB);
        PG8_WAIT_V(6); PG8_BAR;
    } else {
        PG8_STAGE(PG8_SB(0, 0), cB, voffB); PG8_STAGE(PG8_SA(0, 0), cA, voffA); PG8_STAGE(PG8_SB(0, 1), cB + hstep, voffB); PG8_STAGE(PG8_SA(0, 1), cA + hstep, voffA);
        if (wr == 1) PG8_BAR;
        PG8_WAIT_V(4); PG8_BAR;
        PG8_STAGE(PG8_SB(1, 0), cB + kstep, voffB); PG8_STAGE(PG8_SA(1, 0), cA + kstep, voffA); PG8_STAGE(PG8_SB(1, 1), cB + hstep + kstep, voffB);
        PG8_WAIT_V(6); PG8_BAR;
    }
    for (;;) {
        const bool has_next = S.next(ui + 1, nxt);
        const char* nA = has_next ? (const char*)g.A + (size_t)nxt.pm * tstep : cA; const char* nB = has_next ? (const char*)g.Bt + (size_t)nxt.pn * tstep : cB;
        for (int t = 0; t < nt; t += 2) {
            const bool last = (t == nt - 2);
            const char* a1 = cA + (size_t)(t + 1) * kstep;
            const char* a2 = last ? nA : cA + (size_t)(t + 2) * kstep; const char* b2 = last ? nB : cB + (size_t)(t + 2) * kstep;
            const char* a3 = a2 + kstep; const char* b3 = b2 + kstep;
            if (last && has_next) S.a_ready(nxt);
            if constexpr (SP2) {
            PG8_LDB(B0, 0, 0); PG8_LDB(B1, 0, 1); PG8_SCHED; PG8_LDA(At, 0, 0); PG8_STAGE(PG8_SA(1, 1), a1 + hstep, voffA);
            PG8_WAIT_V(8); PG8_WAIT_L(0); PG8_BAR; PG8_MMA(0, 0, At, B0); PG8_MMA(0, 1, At, B1); PG8_BAR; PG8_SCHED;
            PG8_LDA(At, 0, 1); PG8_STAGE(PG8_SB(0, 0), b2, voffB); PG8_STAGE(PG8_SB(0, 1), b2 + hstep, voffB); PG8_STAGE(PG8_SA(0, 0), a2, voffA);
            PG8_WAIT_V(8); PG8_WAIT_L(0); PG8_BAR; PG8_MMA(1, 0, At, B0); PG8_MMA(1, 1, At, B1); PG8_BAR; PG8_SCHED;
            PG8_LDB(B0, 1, 0); PG8_LDB(B1, 1, 1); PG8_SCHED; PG8_LDA(At, 1, 0); PG8_STAGE(PG8_SA(0, 1), a2 + hstep, voffA);
            PG8_WAIT_V(8); PG8_WAIT_L(0); PG8_BAR; PG8_MMA(0, 0, At, B0); PG8_MMA(0, 1, At, B1); PG8_BAR; PG8_SCHED;
            PG8_LDA(At, 1, 1); PG8_STAGE(PG8_SB(1, 0), b3, voffB); PG8_STAGE(PG8_SB(1, 1), b3 + hstep, voffB); PG8_STAGE(PG8_SA(1, 0), a3, voffA);
            PG8_WAIT_V(8); PG8_WAIT_L(0); PG8_BAR; PG8_MMA(1, 0, At, B0); PG8_MMA(1, 1, At, B1); PG8_BAR; PG8_SCHED;
            } else {
            PG8_LDB(B0, 0, 0); PG8_SCHED; PG8_LDA(At, 0, 0); PG8_STAGE(PG8_SA(1, 1), a1 + hstep, voffA);
            PG8_WAIT_L(8); PG8_BAR; PG8_WAIT_L(0); PG8_MMA(0, 0, At, B0); PG8_BAR; PG8_SCHED;
            PG8_LDB(B1, 0, 1); PG8_STAGE(PG8_SB(0, 0), b2, voffB);
            PG8_BAR; PG8_WAIT_L(0); PG8_MMA(0, 1, At, B1); PG8_BAR;
            PG8_LDA(At, 0, 1); PG8_STAGE(PG8_SA(0, 0), a2, voffA);
            PG8_BAR; PG8_WAIT_L(0); PG8_MMA(1, 0, At, B0); PG8_BAR; PG8_SCHED;
            PG8_STAGE(PG8_SB(0, 1), b2 + hstep, voffB);
            PG8_WAIT_V(6); PG8_BAR; PG8_MMA(1, 1, At, B1); PG8_BAR;
            PG8_LDB(B0, 1, 0); PG8_SCHED; PG8_LDA(At, 1, 0); PG8_STAGE(PG8_SA(0, 1), a2 + hstep, voffA);
            PG8_WAIT_L(8); PG8_BAR; PG8_WAIT_L(0); PG8_MMA(0, 0, At, B0); PG8_BAR; PG8_SCHED;
            PG8_LDB(B1, 1, 1); PG8_STAGE(PG8_SB(1, 0), b3, voffB);
            PG8_BAR; PG8_WAIT_L(0); PG8_MMA(0, 1, At, B1); PG8_BAR;
            PG8_LDA(At, 1, 1); PG8_STAGE(PG8_SA(1, 0), a3, voffA);
            PG8_BAR; PG8_WAIT_L(0); PG8_MMA(1, 0, At, B0); PG8_BAR; PG8_SCHED;
            PG8_STAGE(PG8_SB(1, 1), b3 + hstep, voffB);
            PG8_WAIT_V(6); PG8_BAR; PG8_MMA(1, 1, At, B1); PG8_BAR;
            }
        }
        if constexpr (ALIGN_EPI) { if (wr == 0) PG8_BAR; }
        if constexpr (!Epi::AFTER_DRAIN) { E(acc, cur, wr, wc, fr, fq); S.done(cur); }
        if (!has_next) break;
#pragma unroll
        for (int a = 0; a < 2; ++a)
#pragma unroll
            for (int b = 0; b < 2; ++b)
#pragma unroll
                for (int m = 0; m < 4; ++m)
#pragma unroll
                    for (int n = 0; n < 2; ++n) acc[a][b][m][n] = (f32x4){0.f, 0.f, 0.f, 0.f};
        cur = nxt; cA = nA; cB = nB; ++ui;
        if constexpr (ALIGN_EPI) { if (wr == 1) PG8_BAR; }
    }
    PG8_WAIT_V(0);
    if constexpr (!ALIGN_EPI) { if (wr == 0) PG8_BAR; }
    PG8_BAR;
    if constexpr (Epi::AFTER_DRAIN) { E.fused(acc, cur, wr, wc, fr, fq, lds, wid, lane); S.done(cur); }
#undef PG8_SA
#undef PG8_SB
#undef PG8_STAGE
#undef PG8_LDA
#undef PG8_LDB
#undef PG8_MMA
#undef PG8_WAIT_V
#undef PG8_WAIT_L
#undef PG8_BAR
#undef PG8_SCHED
}
}
#define LAS __attribute__((address_space(3)))
#define XB_TMO      128
#define XB_XCNT(j)  (256  + 64 * (j))
#define XB_XSUB(j)  (1280 + 64 * (j))
#define XB_XGEN(j)  (2304 + 64 * (j))
#define XB_TOP      3328
#define XB_TOPGEN   3392
#define XCD_BAR_WORDS 3456
#define XB_SPIN_CAP (1u << 18)

__device__ __forceinline__ unsigned xb_ld(unsigned* p)              { return __hip_atomic_load(p, __ATOMIC_RELAXED, __HIP_MEMORY_SCOPE_AGENT); }
__device__ __forceinline__ unsigned xb_add(unsigned* p, unsigned v) { return __hip_atomic_fetch_add(p, v, __ATOMIC_RELAXED, __HIP_MEMORY_SCOPE_AGENT); }
__device__ __forceinline__ unsigned xb_xcc_id() { return (unsigned)__builtin_amdgcn_s_getreg((3 << 11) | 20) & 0xFu; }
#define XB_SPIN(cond, bar) do { unsigned _sp = 0; while (cond) { __builtin_amdgcn_s_sleep(1); \
    if ((++_sp & 255u) == 0u) { if (xb_ld(&(bar)[XB_TMO])) break; if (_sp > XB_SPIN_CAP) { atomicAdd(&(bar)[XB_TMO], 1u); break; } } } } while (0)

struct XcdBarrier {
    unsigned* bar; unsigned x;
    volatile LAS unsigned* st;
};

__device__ __forceinline__ XcdBarrier xcd_barrier_post(unsigned* bar, volatile LAS unsigned* st) {
    XcdBarrier b; b.bar = bar; b.x = xb_xcc_id(); b.st = st;
    if (threadIdx.x == 0) (void)xb_add(&bar[XB_XCNT(b.x)], 1u);
    return b;
}
__device__ __forceinline__ void xcd_barrier_complete(unsigned* bar, unsigned x, unsigned& nloc, unsigned& nx) {
    const unsigned G = gridDim.x * gridDim.y * gridDim.z;
    unsigned sum, cnt, mine, sp = 0u;
    for (;;) {
        sum = 0u; cnt = 0u; mine = 0u;
#pragma unroll
        for (unsigned j = 0; j < 16; ++j) { const unsigned c = xb_ld(&bar[XB_XCNT(j)]); sum += c; cnt += (c > 0u) ? 1u : 0u; mine = (j == x) ? c : mine; }
        if (sum == G) break;
        __builtin_amdgcn_s_sleep(1);
        if ((++sp & 255u) == 0u) { if (xb_ld(&bar[XB_TMO])) break; if (sp > XB_SPIN_CAP) { atomicAdd(&bar[XB_TMO], 1u); break; } }
    }
    nloc = mine > 0u ? mine : 1u; nx = cnt > 0u ? cnt : 1u;
}

__device__ __forceinline__ void xcd_barrier(const XcdBarrier& b) {
    asm volatile("s_waitcnt vmcnt(0)" ::: "memory");
    __syncthreads();
    if (threadIdx.x == 0) {
        unsigned* bar = b.bar;
        __builtin_amdgcn_s_waitcnt(0);
        unsigned nloc = b.st[0], nx = b.st[1];
        if (nloc == 0u) { xcd_barrier_complete(bar, b.x, nloc, nx); b.st[0] = nloc; b.st[1] = nx; }
        const unsigned old = xb_add(&bar[XB_XSUB(b.x)], 1u);
        const unsigned gen = old / nloc;
        if (old + 1u == (gen + 1u) * nloc) {
            __builtin_amdgcn_fence(__ATOMIC_RELEASE, "agent");
            asm volatile("s_waitcnt vmcnt(0)" ::: "memory");
            const unsigned og = xb_add(&bar[XB_TOP], 1u);
            const unsigned tg = og / nx;
            if (og + 1u == (tg + 1u) * nx) xb_add(&bar[XB_TOPGEN], 1u);
            else XB_SPIN(xb_ld(&bar[XB_TOPGEN]) == tg, bar);
            __builtin_amdgcn_fence(__ATOMIC_ACQUIRE, "agent");
            xb_add(&bar[XB_XGEN(b.x)], 1u);
            asm volatile("s_waitcnt vmcnt(0)" ::: "memory");
        } else {
            XB_SPIN(xb_ld(&bar[XB_XGEN(b.x)]) == gen, bar);
            __builtin_amdgcn_fence(__ATOMIC_ACQUIRE, "agent");
            asm volatile("s_waitcnt vmcnt(0)" ::: "memory");
        }
    }
    __syncthreads();
}

typedef unsigned short bf16;
typedef float f32x4 __attribute__((ext_vector_type(4)));
typedef short bf16x8 __attribute__((ext_vector_type(8)));
typedef unsigned u32x4 __attribute__((ext_vector_type(4)));
typedef unsigned u32x2 __attribute__((ext_vector_type(2)));
constexpr int NWAVES = 8;
constexpr int TOK = 16384, DM = 4096, SEQ = 8192;
constexpr int AB_N = 7168, AB_W = 7240, C_N = 12288, C_W = 12304;
constexpr int DFF = 10944, FFP = 11008, F1N = 22016, F1W = 21888;
constexpr float RMS_EPS = 1e-6f;
constexpr float NEGF = -1e30f;
constexpr size_t MiB = 1u << 20;
constexpr size_t WS_CTL = 0, CTL_ZERO_BYTES = 1 * MiB;
constexpr size_t WS_WAB = 1 * MiB, WS_WABG = 57 * MiB, WS_WOAB = 58 * MiB, WS_WC = 90 * MiB, WS_WCG = 186 * MiB, WS_WOC = 187 * MiB;
constexpr size_t WS_WF1 = 219 * MiB, WF1_BYTES = 172 * MiB, WS_WF2 = 563 * MiB, WF2_BYTES = 86 * MiB;
constexpr size_t WS_R0 = 735 * MiB, WS_R1 = 1423 * MiB, WS_R2 = 1767 * MiB, WS_END = 1967 * MiB;
constexpr size_t WS_PROJ = WS_R0, WS_G = WS_R0, WS_U2 = WS_R0 + 344 * MiB, WS_Y = WS_R0 + 384 * MiB, WS_HOUT = WS_R0 + 384 * MiB;
constexpr size_t WS_U = WS_R1, WS_YMIX = WS_R1 + 128 * MiB, WS_ACT = WS_R1;
constexpr size_t WS_GLOG = WS_R2, WS_GIF = WS_R2 + 8 * MiB, WS_KCMP = WS_R2 + 10 * MiB, WS_VCMP = WS_R2 + 11 * MiB;
static_assert((size_t)F1N * DM * 2 == WF1_BYTES && (size_t)DM * FFP * 2 == WF2_BYTES, "weight copy sizes");
constexpr int CW_BAR = 4096;
constexpr int LDS_BYTES = 163840, MISC_OFF = LDS_BYTES - 256;

#define LDS_WAIT() asm volatile("s_waitcnt lgkmcnt(0)" ::: "memory")
__device__ __forceinline__ float bf2f(unsigned v) { return __uint_as_float(v << 16); }
__device__ __forceinline__ unsigned f2bf(float f) { unsigned u = __float_as_uint(f); return (u + 0x7fffu + ((u >> 16) & 1u)) >> 16; }
__device__ __forceinline__ unsigned pk2(float lo, float hi) { return f2bf(lo) | (f2bf(hi) << 16); }
__device__ __forceinline__ float wave_sum(float v) {
#pragma unroll
    for (int o = 32; o >= 1; o >>= 1) v += __shfl_xor(v, o);
    return v;
}
__device__ __forceinline__ float wave_max(float v) {
#pragma unroll
    for (int o = 32; o >= 1; o >>= 1) v = fmaxf(v, __shfl_xor(v, o));
    return v;
}
__device__ __forceinline__ void unpack8(const u32x4 w, float (&f)[8]) {
    f[0] = __uint_as_float(w.x << 16); f[1] = __uint_as_float(w.x & 0xffff0000u); f[2] = __uint_as_float(w.y << 16); f[3] = __uint_as_float(w.y & 0xffff0000u);
    f[4] = __uint_as_float(w.z << 16); f[5] = __uint_as_float(w.z & 0xffff0000u); f[6] = __uint_as_float(w.w << 16); f[7] = __uint_as_float(w.w & 0xffff0000u);
}
__device__ __forceinline__ float sigmoidf_(float x) { return 1.0f / (1.0f + __expf(-x)); }

__device__ __forceinline__ void tr_item(const float* W, int ldw, int k0, int n0, bf16* WT, size_t ldk, int dst_row0, LAS float* scr, int lane) {
#pragma unroll 8
    for (int i = 0; i < 32; ++i) { const int kk = 2 * i + (lane >> 5); scr[kk * 33 + (lane & 31)] = W[(size_t)(k0 + kk) * ldw + n0 + (lane & 31)]; }
    LDS_WAIT();
    const int c = lane & 7;
#pragma unroll
    for (int j = 0; j < 4; ++j) { const int n = (lane >> 3) + 8 * j; const LAS float* s = scr + (8 * c) * 33 + n;
        u32x4 o; o.x = pk2(s[0 * 33], s[1 * 33]); o.y = pk2(s[2 * 33], s[3 * 33]); o.z = pk2(s[4 * 33], s[5 * 33]); o.w = pk2(s[6 * 33], s[7 * 33]);
        *(u32x4*)(WT + (size_t)(dst_row0 + n) * ldk + k0 + 8 * c) = o; }
    LDS_WAIT();
}
__device__ __forceinline__ void rms_row_bf16(const float* xrow, const float* gain, bf16* orow, int lane) {
    const f32x4* xr = (const f32x4*)xrow + lane; const f32x4* gr = (const f32x4*)gain + lane;
    f32x4 v[16]; float ss = 0.f;
#pragma unroll
    for (int j = 0; j < 16; ++j) { v[j] = xr[64 * j]; ss += (v[j].x * v[j].x + v[j].y * v[j].y) + (v[j].z * v[j].z + v[j].w * v[j].w); }
    const float rstd = rsqrtf(wave_sum(ss) * (1.f / DM) + RMS_EPS);
    u32x2* o8 = (u32x2*)orow + lane;
#pragma unroll
    for (int j = 0; j < 16; ++j) { const f32x4 g = gr[64 * j]; u32x2 w; w.x = pk2(v[j].x * rstd * g.x, v[j].y * rstd * g.y); w.y = pk2(v[j].z * rstd * g.z, v[j].w * rstd * g.w); o8[64 * j] = w; }
}
__device__ __forceinline__ void post_row(const float* yrow, const float* gpost, const float* hin, float* hout, const float* gpre, bf16* urow, int lane) {
    const f32x4* yr = (const f32x4*)yrow + lane; const f32x4* gr = (const f32x4*)gpost + lane; const f32x4* hr = (const f32x4*)hin + lane; f32x4* ho = (f32x4*)hout + lane;
    f32x4 v[16]; float ss = 0.f;
#pragma unroll
    for (int j = 0; j < 16; ++j) { v[j] = yr[64 * j]; ss += (v[j].x * v[j].x + v[j].y * v[j].y) + (v[j].z * v[j].z + v[j].w * v[j].w); }
    const float rstd = rsqrtf(wave_sum(ss) * (1.f / DM) + RMS_EPS);
    float s2 = 0.f;
#pragma unroll
    for (int j = 0; j < 16; ++j) { const f32x4 g = gr[64 * j]; const f32x4 h0 = hr[64 * j]; f32x4 h; h.x = h0.x + v[j].x * rstd * g.x; h.y = h0.y + v[j].y * rstd * g.y; h.z = h0.z + v[j].z * rstd * g.z; h.w = h0.w + v[j].w * rstd * g.w;
        v[j] = h; s2 += (h.x * h.x + h.y * h.y) + (h.z * h.z + h.w * h.w); ho[64 * j] = h; }
    if (gpre) {
        const float r2 = rsqrtf(wave_sum(s2) * (1.f / DM) + RMS_EPS); const f32x4* pr = (const f32x4*)gpre + lane; u32x2* o8 = (u32x2*)urow + lane;
#pragma unroll
        for (int j = 0; j < 16; ++j) { const f32x4 g = pr[64 * j]; u32x2 w; w.x = pk2(v[j].x * r2 * g.x, v[j].y * r2 * g.y); w.y = pk2(v[j].z * r2 * g.z, v[j].w * r2 * g.w); o8[64 * j] = w; }
    }
}
__device__ __forceinline__ void post_phase(const float* y, const float* gpost, const float* hin, float* hout, const float* gpre, bf16* u) {
    const int lane = threadIdx.x & 63, gw = blockIdx.x * NWAVES + (threadIdx.x >> 6), NGW = gridDim.x * NWAVES;
    for (int m = gw; m < TOK; m += NGW) post_row(y + (size_t)m * DM, gpost, hin + (size_t)m * DM, hout + (size_t)m * DM, gpre, u + (size_t)m * DM, lane);
}

struct Ptrs {
    const float* in[22]; float* out; unsigned char* ws;
};

__device__ __forceinline__ void prologue_phase(const Ptrs& P, LAS unsigned char* lds) {
    const int tid = threadIdx.x, lane = tid & 63, wave = tid >> 6;
    LAS float* scr = (LAS float*)(lds + wave * 16384);
    const int gw = blockIdx.x * NWAVES + wave, NGW = gridDim.x * NWAVES;
    constexpr int IT_AB = 64 * 224, IT_OAB = 64 * 128, IT_C = 64 * 384, IT_OC = 64 * 128, IT_F1 = 64 * 684, IT_F2 = 171 * 128;
    constexpr int NITEMS = IT_AB + IT_OAB + IT_C + IT_OC + 2 * IT_F1 + 2 * IT_F2;
    unsigned char* ws = P.ws;
    for (int it = gw; it < NITEMS; it += NGW) {
        int r = it;
        if (r < IT_AB) { const int kb = r / 224, nb = r % 224; tr_item(P.in[3], AB_W, 64 * kb, 32 * nb, (bf16*)(ws + WS_WAB), DM, 32 * nb, scr, lane); continue; } r -= IT_AB;
        if (r < IT_OAB) { const int kb = r / 128, nb = r % 128; tr_item(P.in[11], DM, 64 * kb, 32 * nb, (bf16*)(ws + WS_WOAB), DM, 32 * nb, scr, lane); continue; } r -= IT_OAB;
        if (r < IT_C) { const int kb = r / 384, nb = r % 384; tr_item(P.in[12], C_W, 64 * kb, 32 * nb, (bf16*)(ws + WS_WC), DM, 32 * nb, scr, lane); continue; } r -= IT_C;
        if (r < IT_OC) { const int kb = r / 128, nb = r % 128; tr_item(P.in[15], DM, 64 * kb, 32 * nb, (bf16*)(ws + WS_WOC), DM, 32 * nb, scr, lane); continue; } r -= IT_OC;
        if (r < 2 * IT_F1) { const int l = r / IT_F1; r -= l * IT_F1; const int kb = r / 684, nb = r % 684, n0 = 32 * nb, part = n0 >= DFF ? 1 : 0, ff = n0 - part * DFF;
            tr_item(P.in[18] + (size_t)l * DM * F1W, F1W, 64 * kb, n0, (bf16*)(ws + WS_WF1 + l * WF1_BYTES), DM, 256 * (ff >> 7) + 128 * part + (ff & 127), scr, lane); continue; } r -= 2 * IT_F1;
        { const int l = r / IT_F2; r -= l * IT_F2; const int kb = r / 128, nb = r % 128;
            tr_item(P.in[21] + (size_t)l * DFF * DM, DM, 64 * kb, 32 * nb, (bf16*)(ws + WS_WF2 + l * WF2_BYTES), FFP, 32 * nb, scr, lane); }
    }
    const size_t gt = (size_t)blockIdx.x * 512 + tid, NT = (size_t)gridDim.x * 512;
    for (size_t i = gt; i < (size_t)2 * 128 * (DM / 8); i += NT) {
        const int l = (int)(i / (128 * 512)); const int rr = (int)(i % (128 * 512)); const int row = rr >> 9, ch = rr & 511;
        const int drow = 85 * 256 + (row >> 6) * 128 + 64 + (row & 63);
        *(u32x4*)((bf16*)(ws + WS_WF1 + l * WF1_BYTES) + (size_t)drow * DM + ch * 8) = (u32x4){0u, 0u, 0u, 0u}; }
    for (size_t i = gt; i < (size_t)2 * DM * 8; i += NT) {
        const int l = (int)(i / (DM * 8)); const int rr = (int)(i % (DM * 8)); const int row = rr >> 3, ch = rr & 7;
        *(u32x4*)((bf16*)(ws + WS_WF2 + l * WF2_BYTES) + (size_t)row * FFP + DFF + ch * 8) = (u32x4){0u, 0u, 0u, 0u}; }
    for (size_t i = gt; i < (size_t)80 * DM; i += NT) { const int rrow = (int)(i / DM), k = (int)(i % DM);
        ((bf16*)(ws + WS_WABG))[i] = rrow < 72 ? (bf16)f2bf(P.in[3][(size_t)k * AB_W + AB_N + rrow]) : (bf16)0; }
    for (size_t i = gt; i < (size_t)16 * DM; i += NT) { const int rrow = (int)(i / DM), k = (int)(i % DM);
        ((bf16*)(ws + WS_WCG))[i] = (bf16)f2bf(P.in[12][(size_t)k * C_W + C_N + rrow]); }
    for (int m = gw; m < TOK; m += NGW) rms_row_bf16(P.in[0] + (size_t)m * DM, P.in[1], (bf16*)(ws + WS_U) + (size_t)m * DM, lane);
}

template <int NT> __device__ __forceinline__ void skinny_phase(const bf16* A, const bf16* Wt, float* out, int ldo, int ncols) {
    const int lane = threadIdx.x & 63, gw = blockIdx.x * NWAVES + (threadIdx.x >> 6), NGW = gridDim.x * NWAVES;
    const int fr = lane & 15, fq = lane >> 4;
    for (int task = gw; task < TOK / 16; task += NGW) {
        const int t0 = task * 16;
        f32x4 acc[NT];
#pragma unroll
        for (int n = 0; n < NT; ++n) acc[n] = (f32x4){0.f, 0.f, 0.f, 0.f};
        const bf16* ap = A + (size_t)(t0 + fr) * DM + 8 * fq; const bf16* bp = Wt + (size_t)fr * DM + 8 * fq;
#pragma unroll 2
        for (int k0 = 0; k0 < DM; k0 += 32) {
            const bf16x8 a = *(const bf16x8*)(ap + k0);
#pragma unroll
            for (int n = 0; n < NT; ++n) { const bf16x8 b = *(const bf16x8*)(bp + (size_t)n * 16 * DM + k0); acc[n] = __builtin_amdgcn_mfma_f32_16x16x32_bf16(a, b, acc[n], 0, 0, 0); }
        }
#pragma unroll
        for (int n = 0; n < NT; ++n) { const int col = n * 16 + fr; if (col < ncols) {
#pragma unroll
            for (int r = 0; r < 4; ++r) out[(size_t)(t0 + 4 * fq + r) * ldo + col] = acc[n][r]; } }
    }
}

__device__ __forceinline__ void pool_naive_phase(const bf16* proj, const float* pool_w, const float* pool_scale, bf16* ymix, LAS unsigned char* lds) {
    const int tid = threadIdx.x; LAS float* pl = (LAS float*)lds;
    for (int unit = blockIdx.x; unit < 4096; unit += gridDim.x) {
        const int tt = unit >> 2, g = unit & 3, tok0 = tt * 16, w = 2 << g;
        { const int ti = tid >> 5, c8 = (tid & 31) * 8, tok = tok0 + ti, tpos = tok & (SEQ - 1), cnt = (tpos + 1 < w) ? tpos + 1 : w;
          float sum[8], cur[8];
#pragma unroll
          for (int j = 0; j < 8; ++j) sum[j] = 0.f;
          for (int j = 0; j < cnt; ++j) { float f[8]; unpack8(*(const u32x4*)(proj + (size_t)(tok - j) * AB_N + g * 256 + c8), f);
#pragma unroll
              for (int q = 0; q < 8; ++q) { sum[q] += f[q]; if (j == 0) cur[q] = f[q]; } }
          const float inv = 1.0f / (float)cnt;
#pragma unroll
          for (int q = 0; q < 8; ++q) pl[ti * 256 + c8 + q] = sum[q] * inv - cur[q]; }
        __syncthreads();
        { const int d = tid & 255, half = tid >> 8; float acc[8];
#pragma unroll
          for (int i = 0; i < 8; ++i) acc[i] = 0.f;
          const float* wp = pool_w + (size_t)g * 65536 + d;
          for (int c = 0; c < 256; ++c) { const float wv = wp[(size_t)c * 256];
#pragma unroll
              for (int i = 0; i < 8; ++i) acc[i] += pl[(half * 8 + i) * 256 + c] * wv; }
          const float sc = pool_scale[g * 256 + d];
#pragma unroll
          for (int i = 0; i < 8; ++i) ymix[(size_t)(tok0 + half * 8 + i) * DM + g * 256 + d] = (bf16)f2bf(acc[i] * sc); }
        __syncthreads();
    }
}
__device__ __forceinline__ float gelu_tanh(float x) { const float u = 0.7978845608028654f * (x + 0.044715f * x * x * x); return 0.5f * x * (1.0f + tanhf(u)); }
__device__ __forceinline__ void compress_naive_phase(const bf16* proj, const float* pos, const float* kw1, const float* kw2, const float* vw1, const float* vw2, bf16* kcmp, bf16* vcmp, LAS unsigned char* lds) {
    const int tid = threadIdx.x;
    LAS float* flat = (LAS float*)lds;
    LAS float* part = flat + 4 * 4096;
    LAS float* hid = part + 2 * 4 * 256;
    for (int unit = blockIdx.x; unit < 2048; unit += gridDim.x) {
        const int which = unit >> 10, b = (unit >> 9) & 1, g = (unit >> 7) & 3, ng = unit & 127;
        const float* w1 = which ? vw1 : kw1; const float* w2 = which ? vw2 : kw2; bf16* outp = which ? vcmp : kcmp;
        const int col0 = (which ? 4608 : 4096) + g * 128;
        for (int i = tid; i < 4 * 4096; i += 512) { const int nn = i >> 12, r = i & 4095, l = r >> 7, d = r & 127, n = 4 * ng + nn;
            float v = 0.f; if (n <= 510) v = bf2f(proj[(size_t)(b * SEQ + 16 * n + l) * AB_N + col0 + d]) + pos[l * 128 + d];
            flat[i] = v; }
        __syncthreads();
        { const int j = tid & 255, ih = tid >> 8; float a0 = 0.f, a1 = 0.f, a2 = 0.f, a3 = 0.f;
          const float* wp = w1 + (size_t)(ih * 2048) * 256 + j; const LAS float* fp = flat + ih * 2048;
          for (int i = 0; i < 2048; ++i) { const float wv = wp[(size_t)i * 256]; a0 += fp[i] * wv; a1 += fp[4096 + i] * wv; a2 += fp[8192 + i] * wv; a3 += fp[12288 + i] * wv; }
          part[(ih * 4 + 0) * 256 + j] = a0; part[(ih * 4 + 1) * 256 + j] = a1; part[(ih * 4 + 2) * 256 + j] = a2; part[(ih * 4 + 3) * 256 + j] = a3; }
        __syncthreads();
        for (int i = tid; i < 1024; i += 512) hid[i] = gelu_tanh(part[i] + part[1024 + i]);
        __syncthreads();
        { const int dd = tid & 127, nn = tid >> 7, n = 4 * ng + nn; float o = 0.f;
          for (int j = 0; j < 256; ++j) o += hid[nn * 256 + j] * w2[j * 128 + dd];
          if (n <= 510) outp[((size_t)(b * 4 + g) * 512 + n) * 128 + dd] = (bf16)f2bf(o); }
        __syncthreads();
    }
}

__device__ __forceinline__ void dot6(const bf16* krow, const LAS float* qs, float (&s)[6]) {
#pragma unroll
    for (int h = 0; h < 6; ++h) s[h] = 0.f;
#pragma unroll 4
    for (int c = 0; c < 16; ++c) { float kf[8]; unpack8(*(const u32x4*)(krow + 8 * c), kf);
#pragma unroll
        for (int h = 0; h < 6; ++h) { const f32x4 qa = *(const LAS f32x4*)(qs + h * 128 + 8 * c), qb = *(const LAS f32x4*)(qs + h * 128 + 8 * c + 4);
            s[h] += (kf[0] * qa.x + kf[1] * qa.y) + (kf[2] * qa.z + kf[3] * qa.w) + (kf[4] * qb.x + kf[5] * qb.y) + (kf[6] * qb.z + kf[7] * qb.w); } }
}
__device__ __forceinline__ void attn_block(const bf16* kbase, const bf16* vbase, int pos0, int lo, int hi, const LAS float* qs, LAS float* pb, int lane, float (&m)[6], float (&l)[6], float (&o)[6][2]) {
    const int pos = pos0 + lane; const bool valid = (pos >= lo && pos <= hi);
    float s[6];
    if (valid) dot6(kbase + (size_t)pos * AB_N, qs, s);
#pragma unroll
    for (int h = 0; h < 6; ++h) { const float sv = valid ? s[h] : NEGF; const float bm = wave_max(sv), mn = fmaxf(m[h], bm), alpha = __expf(m[h] - mn), p = valid ? __expf(sv - mn) : 0.f;
        l[h] = l[h] * alpha + wave_sum(p); m[h] = mn; o[h][0] *= alpha; o[h][1] *= alpha; pb[h * 64 + lane] = p; }
    LDS_WAIT();
    const int kmin = (lo - pos0) > 0 ? (lo - pos0) : 0, kmax = (hi - pos0) < 63 ? (hi - pos0) : 63;
    for (int k = kmin; k <= kmax; ++k) { const unsigned v2 = *(const unsigned*)(vbase + (size_t)(pos0 + k) * AB_N + 2 * lane); const float v0 = bf2f(v2 & 0xffffu), v1 = __uint_as_float(v2 & 0xffff0000u);
#pragma unroll
        for (int h = 0; h < 6; ++h) { const float p = pb[h * 64 + k]; o[h][0] += p * v0; o[h][1] += p * v1; } }
    LDS_WAIT();
}
__device__ __forceinline__ void nsa_naive_phase(const bf16* proj, const bf16* kcmp, const bf16* vcmp, const float* glog, bf16* ymix, LAS unsigned char* lds) {
    const int lane = threadIdx.x & 63, wave = threadIdx.x >> 6;
    LAS float* qs = (LAS float*)(lds + wave * 17536);
    LAS float* sc = qs + 768;
    LAS float* imp = sc + 3072;
    LAS float* pb = imp + 128;
    LAS int* sel = (LAS int*)(pb + 384);
    const int gw = blockIdx.x * NWAVES + wave, NGW = gridDim.x * NWAVES;
    for (int item = gw; item < 65536; item += NGW) {
        const int t = item >> 3, b = (item >> 2) & 1, g = item & 3;
        const size_t tok = (size_t)b * SEQ + t;
        const bf16* prow = proj + tok * AB_N;
#pragma unroll
        for (int j = 0; j < 12; ++j) { const int idx = lane + 64 * j, h = idx >> 7, d = idx & 127; qs[idx] = bf2f(prow[1024 + (g * 6 + h) * 128 + d]) * 0.08838834764831845f; }
        imp[lane] = 0.f; imp[lane + 64] = 0.f;
        LDS_WAIT();
        float oc[6][2];
#pragma unroll
        for (int h = 0; h < 6; ++h) { oc[h][0] = 0.f; oc[h][1] = 0.f; }
        const int ncv = (t >= 31) ? ((t - 31) >> 4) + 1 : 0;
        if (ncv > 0) {
            const bf16* kc = kcmp + (size_t)(b * 4 + g) * 512 * 128; const bf16* vc = vcmp + (size_t)(b * 4 + g) * 512 * 128;
            float mx[6], sm[6];
#pragma unroll
            for (int h = 0; h < 6; ++h) { mx[h] = NEGF; sm[h] = 0.f; }
            for (int n0 = 0; n0 < ncv; n0 += 64) { const int n = n0 + lane; if (n < ncv) { float s[6]; dot6(kc + (size_t)n * 128, qs, s);
#pragma unroll
                for (int h = 0; h < 6; ++h) { sc[h * 512 + n] = s[h]; mx[h] = fmaxf(mx[h], s[h]); } } }
#pragma unroll
            for (int h = 0; h < 6; ++h) mx[h] = wave_max(mx[h]);
            LDS_WAIT();
            for (int n0 = 0; n0 < ncv; n0 += 64) { const int n = n0 + lane; if (n < ncv) {
#pragma unroll
                for (int h = 0; h < 6; ++h) { const float e = __expf(sc[h * 512 + n] - mx[h]); sc[h * 512 + n] = e; sm[h] += e; } } }
#pragma unroll
            for (int h = 0; h < 6; ++h) sm[h] = 1.0f / wave_sum(sm[h]);
            LDS_WAIT();
            for (int n0 = 0; n0 < ncv; n0 += 64) { const int n = n0 + lane; if (n < ncv) {
#pragma unroll
                for (int h = 0; h < 6; ++h) sc[h * 512 + n] *= sm[h]; } }
            LDS_WAIT();
#pragma unroll
            for (int jj = 0; jj < 2; ++jj) { const int j = lane + 64 * jj; float a = 0.f;
#pragma unroll
                for (int i = 0; i < 5; ++i) { const int n = 4 * j - 1 + i; if (n >= 0 && n < ncv) { const float wgt = (i == 0 || i == 4) ? 1.0f : 2.0f;
#pragma unroll
                    for (int h = 0; h < 6; ++h) a += wgt * sc[h * 512 + n]; } }
                imp[j] = a; }
            for (int n = 0; n < ncv; ++n) { const unsigned v2 = *(const unsigned*)(vc + (size_t)n * 128 + 2 * lane); const float v0 = bf2f(v2 & 0xffffu), v1 = __uint_as_float(v2 & 0xffff0000u);
#pragma unroll
                for (int h = 0; h < 6; ++h) { const float p = sc[h * 512 + n]; oc[h][0] += p * v0; oc[h][1] += p * v1; } }
            LDS_WAIT();
        }
        const int cur = t >> 6; int nsel;
        if (cur < 16) { nsel = cur + 1; if (lane < nsel) sel[lane] = lane; }
        else {
            if (lane == 0) { sel[0] = 0; sel[1] = cur - 1; sel[2] = cur; }
            int cnt = 3;
#pragma unroll
            for (int jj = 0; jj < 2; ++jj) { const int j = lane + 64 * jj; const bool cand = (j >= 1 && j <= cur - 2); const float mv = cand ? imp[j] : 0.f; int rank = 0;
                for (int k = 1; k <= cur - 2; ++k) { const float ov = imp[k]; rank += ((ov > mv) || (ov == mv && k < j)) ? 1 : 0; }
                const bool pick = cand && rank < 13;
                const unsigned long long bm = __ballot(pick); const int posi = cnt + __popcll(bm & ((1ull << lane) - 1ull)); if (pick) sel[posi] = j; cnt += __popcll(bm); }
            nsel = cnt;
        }
        LDS_WAIT();
        const bf16* seqbase = proj + (size_t)b * SEQ * AB_N;
        float ms[6], ls[6], os[6][2];
#pragma unroll
        for (int h = 0; h < 6; ++h) { ms[h] = NEGF; ls[h] = 0.f; os[h][0] = 0.f; os[h][1] = 0.f; }
        for (int i = 0; i < nsel; ++i) { const int j = sel[i]; attn_block(seqbase + 5120 + g * 128, seqbase + 5632 + g * 128, 64 * j, 0, t, qs, pb, lane, ms, ls, os); }
        float mw[6], lw[6], ow[6][2];
#pragma unroll
        for (int h = 0; h < 6; ++h) { mw[h] = NEGF; lw[h] = 0.f; ow[h][0] = 0.f; ow[h][1] = 0.f; }
        const int lo = (t - 511) > 0 ? (t - 511) : 0;
        for (int p0 = lo & ~63; p0 <= t; p0 += 64) attn_block(seqbase + 6144 + g * 128, seqbase + 6656 + g * 128, p0, lo, t, qs, pb, lane, mw, lw, ow);
#pragma unroll
        for (int h = 0; h < 6; ++h) { const float* gl = glog + tok * 72 + (g * 6 + h) * 3; const float g0 = sigmoidf_(gl[0]), g1 = sigmoidf_(gl[1]) / ls[h], g2 = sigmoidf_(gl[2]) / lw[h];
            const float r0 = g0 * oc[h][0] + g1 * os[h][0] + g2 * ow[h][0], r1 = g0 * oc[h][1] + g1 * os[h][1] + g2 * ow[h][1];
            *(unsigned*)(ymix + tok * DM + 1024 + (g * 6 + h) * 128 + 2 * lane) = pk2(r0, r1); }
    }
}

__device__ __forceinline__ void act_phase(const bf16* G, const bf16* U2, const float* cw, const float* cb, bf16* act) {
    const size_t gt = (size_t)blockIdx.x * 512 + threadIdx.x, NT = (size_t)gridDim.x * 512;
    constexpr int CPR = FFP / 8;
    for (size_t item = gt; item < (size_t)TOK * CPR; item += NT) {
        const int tok = (int)(item / CPR), f8 = (int)(item % CPR) * 8; const size_t off = (size_t)tok * FFP + f8;
        if (f8 >= DFF) { *(u32x4*)(act + off) = (u32x4){0u, 0u, 0u, 0u}; continue; }
        const int tpos = tok & (SEQ - 1);
        float g0[8], g1[8], g2[8], up[8];
        unpack8(*(const u32x4*)(G + off), g0); unpack8(*(const u32x4*)(U2 + off), up);
        if (tpos >= 1) unpack8(*(const u32x4*)(G + off - FFP), g1); else {
#pragma unroll
            for (int j = 0; j < 8; ++j) g1[j] = 0.f; }
        if (tpos >= 2) unpack8(*(const u32x4*)(G + off - 2 * FFP), g2); else {
#pragma unroll
            for (int j = 0; j < 8; ++j) g2[j] = 0.f; }
        float r[8];
#pragma unroll
        for (int j = 0; j < 8; ++j) { const int f = f8 + j; const float x = cb[f] + cw[f] * g0[j] + cw[DFF + f] * g1[j] + cw[2 * DFF + f] * g2[j]; r[j] = x * sigmoidf_(x) * up[j]; }
        u32x4 w; w.x = pk2(r[0], r[1]); w.y = pk2(r[2], r[3]); w.z = pk2(r[4], r[5]); w.w = pk2(r[6], r[7]);
        *(u32x4*)(act + off) = w;
    }
}

__device__ __forceinline__ void mlstm_naive_phase(const bf16* projc, const float* gif, const float* bif, float* hout, LAS unsigned char* lds) {
    constexpr int QS = 264;
    const int tid = threadIdx.x, lane = tid & 63;
    LAS bf16* qs = (LAS bf16*)lds;
    LAS bf16* ks = qs + 64 * QS;
    LAS float* vsl = (LAS float*)(lds + 67584);
    LAS float* Cs = vsl + 2048;
    LAS float* ns = Cs + 256 * 36;
    LAS float* wq = ns + 256;
    LAS float* bb = wq + 64 * 65; LAS float* gi = bb + 64; LAS float* mt = gi + 64; LAS float* inter = mt + 64; LAS float* ksc = inter + 64; LAS float* dd = ksc + 64; LAS float* sca = dd + 64;
    for (int unit = blockIdx.x; unit < 256; unit += gridDim.x) {
        const int b = unit >> 7, h = (unit >> 4) & 7, es = unit & 15;
        for (int i = tid; i < 256 * 36; i += 512) Cs[i] = 0.f;
        if (tid < 256) ns[tid] = 0.f;
        if (tid == 0) sca[0] = 0.f;
        __syncthreads();
        for (int c = 0; c < 128; ++c) {
            const size_t tok0 = (size_t)b * SEQ + 64 * c;
#pragma unroll
            for (int i = 0; i < 4; ++i) { const int idx = tid + 512 * i, r = idx >> 5, ch = idx & 31; const bf16* src = projc + (tok0 + r) * C_N + h * 256 + ch * 8;
                *(LAS u32x4*)(qs + r * QS + ch * 8) = *(const u32x4*)src; *(LAS u32x4*)(ks + r * QS + ch * 8) = *(const u32x4*)(src + 2048); }
            if (tid < 256) { const int r = tid >> 2, q4 = tid & 3; float f[8]; unpack8(*(const u32x4*)(projc + (tok0 + r) * C_N + 4096 + h * 512 + es * 32 + q4 * 8), f);
#pragma unroll
                for (int j = 0; j < 8; ++j) vsl[r * 32 + q4 * 8 + j] = f[j]; }
            if (tid >= 448) {
                const int s = lane; const float ig = gif[(tok0 + s) * 16 + h] + bif[h], fg = gif[(tok0 + s) * 16 + 8 + h] + bif[8 + h];
                const float lf = fg >= 0.f ? -log1pf(__expf(-fg)) : fg - log1pf(__expf(fg));
                float bsum = lf;
#pragma unroll
                for (int o = 1; o < 64; o <<= 1) { const float tv = __shfl_up(bsum, o); if (lane >= o) bsum += tv; }
                float pm = ig - bsum;
#pragma unroll
                for (int o = 1; o < 64; o <<= 1) { const float tv = __shfl_up(pm, o); if (lane >= o) pm = fmaxf(pm, tv); }
                const float m_prev = sca[0]; const float mts = bsum + fmaxf(m_prev, pm);
                const float b_last = __shfl(bsum, 63), m_new = __shfl(mts, 63);
                bb[s] = bsum; gi[s] = ig; mt[s] = mts; inter[s] = __expf(bsum + m_prev - mts); ksc[s] = __expf(b_last - bsum + ig - m_new);
                if (s == 0) { sca[1] = __expf(b_last + m_prev - m_new); sca[2] = m_new; }
            }
            __syncthreads();
            {
                const int t = tid >> 3, sg = tid & 7; float acc[8];
#pragma unroll
                for (int i = 0; i < 8; ++i) acc[i] = 0.f;
                for (int ch = 0; ch < 32; ++ch) { float qv[8]; unpack8(*(const LAS u32x4*)(qs + t * QS + ch * 8), qv);
#pragma unroll
                    for (int i = 0; i < 8; ++i) { const int s = sg + 8 * i; if (s <= t) { float kv[8]; unpack8(*(const LAS u32x4*)(ks + s * QS + ch * 8), kv);
                        acc[i] += (qv[0] * kv[0] + qv[1] * kv[1]) + (qv[2] * kv[2] + qv[3] * kv[3]) + (qv[4] * kv[4] + qv[5] * kv[5]) + (qv[6] * kv[6] + qv[7] * kv[7]); } } }
                const float bt = bb[t], mtt = mt[t];
#pragma unroll
                for (int i = 0; i < 8; ++i) { const int s = sg + 8 * i; wq[t * 65 + s] = (s <= t) ? acc[i] * 0.0625f * __expf(bt - bb[s] + gi[s] - mtt) : 0.f; }
            }
            __syncthreads();
            if (tid < 64) { const int t = tid; float rs = 0.f, qn = 0.f;
                for (int s = 0; s < 64; ++s) rs += wq[t * 65 + s];
                for (int d = 0; d < 256; ++d) qn += bf2f(qs[t * QS + d]) * ns[d];
                const float den = inter[t] * qn * 0.0625f + rs; dd[t] = fmaxf(fabsf(den), __expf(-mt[t])); }
            f32x4 a = (f32x4){0.f, 0.f, 0.f, 0.f};
            const int t4 = tid >> 3, e0 = 4 * (tid & 7);
            { for (int ch = 0; ch < 32; ++ch) { float qv[8]; unpack8(*(const LAS u32x4*)(qs + t4 * QS + ch * 8), qv);
#pragma unroll
                    for (int j = 0; j < 8; ++j) { const f32x4 cv = *(const LAS f32x4*)(Cs + (ch * 8 + j) * 36 + e0); a += qv[j] * cv; } }
              a *= inter[t4] * 0.0625f;
              for (int s = 0; s <= t4; ++s) { const float w = wq[t4 * 65 + s]; const f32x4 vv = *(const LAS f32x4*)(vsl + s * 32 + e0); a += w * vv; } }
            __syncthreads();
            { const float inv = 1.0f / dd[t4]; *(f32x4*)(hout + (tok0 + t4) * DM + h * 512 + es * 32 + e0) = a * inv; }
            {
                const int d = tid >> 1, eh = tid & 1, eo = 16 * eh; float u[16]; float un = 0.f;
#pragma unroll
                for (int j = 0; j < 16; ++j) u[j] = 0.f;
                for (int s = 0; s < 64; ++s) { const float kk = bf2f(ks[s * QS + d]) * ksc[s]; un += kk;
#pragma unroll
                    for (int j = 0; j < 16; ++j) u[j] += kk * vsl[s * 32 + eo + j]; }
                const float decay = sca[1];
#pragma unroll
                for (int j = 0; j < 16; ++j) Cs[d * 36 + eo + j] = decay * Cs[d * 36 + eo + j] + u[j];
                if (eh == 0) ns[d] = decay * ns[d] + un;
            }
            __syncthreads();
            if (tid == 0) sca[0] = sca[2];
            __syncthreads();
        }
    }
}
__device__ __forceinline__ void cgate_phase(const float* hout, const bf16* projc, const float* hnorm, bf16* ymix) {
    const int lane = threadIdx.x & 63, gw = blockIdx.x * NWAVES + (threadIdx.x >> 6), NGW = gridDim.x * NWAVES;
    for (int item = gw; item < TOK * 8; item += NGW) {
        const int tok = item >> 3, h = item & 7; const size_t off = (size_t)tok * DM + h * 512 + lane * 8;
        const f32x4 a = *(const f32x4*)(hout + off), c = *(const f32x4*)(hout + off + 4);
        const float ss = wave_sum((a.x * a.x + a.y * a.y) + (a.z * a.z + a.w * a.w) + (c.x * c.x + c.y * c.y) + (c.z * c.z + c.w * c.w));
        const float rstd = rsqrtf(ss * (1.f / 512.f) + RMS_EPS);
        float og[8]; unpack8(*(const u32x4*)(projc + (size_t)tok * C_N + 8192 + h * 512 + lane * 8), og);
        const f32x4 n0 = *(const f32x4*)(hnorm + h * 512 + lane * 8), n1 = *(const f32x4*)(hnorm + h * 512 + lane * 8 + 4);
        u32x4 w; w.x = pk2(sigmoidf_(og[0]) * a.x * rstd * n0.x, sigmoidf_(og[1]) * a.y * rstd * n0.y); w.y = pk2(sigmoidf_(og[2]) * a.z * rstd * n0.z, sigmoidf_(og[3]) * a.w * rstd * n0.w);
        w.z = pk2(sigmoidf_(og[4]) * c.x * rstd * n1.x, sigmoidf_(og[5]) * c.y * rstd * n1.y); w.w = pk2(sigmoidf_(og[6]) * c.z * rstd * n1.z, sigmoidf_(og[7]) * c.w * rstd * n1.w);
        *(u32x4*)(ymix + off) = w;
    }
}

#ifndef MK_PER_PHASE
#define MK_PER_PHASE 0
#endif
constexpr int NPHASE = 19;
struct Args { const float* in[22]; float* out; unsigned char* ws; int ph_lo, ph_hi; };
__global__ void __launch_bounds__(NWAVES * 64, 2) mk_fwd(Args args) {
    extern __shared__ __attribute__((aligned(16))) unsigned char lds_raw[];
    LAS unsigned char* lds = (LAS unsigned char*)lds_raw;
    volatile LAS unsigned* MISC = (volatile LAS unsigned*)(lds + MISC_OFF);
    const int tid = threadIdx.x;
    if (tid < 64) MISC[tid] = 0u;
    __syncthreads();
    unsigned char* ws = args.ws;
    unsigned* ctl = (unsigned*)(ws + WS_CTL);
    XcdBarrier bar; bar.bar = ctl + CW_BAR; bar.x = 0; bar.st = nullptr;
    if (!MK_PER_PHASE) bar = xcd_barrier_post(ctl + CW_BAR, MISC + 8);
    Ptrs P;
#pragma unroll
    for (int i = 0; i < 22; ++i) P.in[i] = args.in[i];
    P.out = args.out; P.ws = ws;
    const int lo = args.ph_lo, hi = args.ph_hi;
#define IN(k) (lo <= (k) && (k) < hi)
#define SEAM(k) do { if (IN(k) && IN((k) + 1)) xcd_barrier(bar); } while (0)
    bf16* const U = (bf16*)(ws + WS_U); bf16* const PROJ = (bf16*)(ws + WS_PROJ); bf16* const YMIX = (bf16*)(ws + WS_YMIX); float* const Y = (float*)(ws + WS_Y);
    bf16* const Gb = (bf16*)(ws + WS_G); bf16* const U2 = (bf16*)(ws + WS_U2); bf16* const ACT = (bf16*)(ws + WS_ACT);
    float* const GLOG = (float*)(ws + WS_GLOG); float* const GIF = (float*)(ws + WS_GIF); bf16* const KCMP = (bf16*)(ws + WS_KCMP); bf16* const VCMP = (bf16*)(ws + WS_VCMP);
    float* const HOUT = (float*)(ws + WS_HOUT);
    const int G = gridDim.x, bx = blockIdx.x;

    if (IN(0)) { prologue_phase(P, lds); } SEAM(0);
    if (IN(1)) {
        pg8::Gemm g{U, (const bf16*)(ws + WS_WAB), TOK, AB_N, DM}; pg8::StaticOrder S; S.init(TOK, AB_N, G, bx);
        pg8::EpiBf16P E{PROJ, AB_N};
        pg8::gemm_phase<pg8::EpiBf16P, pg8::StaticOrder, true, true>(lds, g, S, E);
        skinny_phase<5>(U, (const bf16*)(ws + WS_WABG), GLOG, 72, 72);
    } SEAM(1);
    if (IN(2)) {
        pool_naive_phase(PROJ, P.in[4], P.in[5], YMIX, lds);
        compress_naive_phase(PROJ, P.in[6], P.in[7], P.in[8], P.in[9], P.in[10], KCMP, VCMP, lds);
    } SEAM(2);
    if (IN(3)) { nsa_naive_phase(PROJ, KCMP, VCMP, GLOG, YMIX, lds); } SEAM(3);
    if (IN(4)) {
        pg8::Gemm g{YMIX, (const bf16*)(ws + WS_WOAB), TOK, DM, DM}; pg8::StaticOrder S; S.init(TOK, DM, G, bx);
        pg8::EpiF32P E{Y, DM};
        pg8::gemm_phase<pg8::EpiF32P, pg8::StaticOrder, true, true>(lds, g, S, E);
    } SEAM(4);
    if (IN(5)) { post_phase(Y, P.in[2], P.in[0], P.out, P.in[16], U); } SEAM(5);
    if (IN(6)) {
        pg8::Gemm g{U, (const bf16*)(ws + WS_WF1), TOK, F1N, DM}; pg8::StaticOrder S; S.init(TOK, F1N, G, bx);
        pg8::EpiGU E{Gb, U2, FFP};
        pg8::gemm_phase<pg8::EpiGU, pg8::StaticOrder, true, true>(lds, g, S, E);
    } SEAM(6);
    if (IN(7)) { act_phase(Gb, U2, P.in[19], P.in[20], ACT); } SEAM(7);
    if (IN(8)) {
        pg8::Gemm g{ACT, (const bf16*)(ws + WS_WF2), TOK, DM, FFP}; pg8::StaticOrder S; S.init(TOK, DM, G, bx);
        pg8::EpiF32P E{Y, DM};
        pg8::gemm_phase<pg8::EpiF32P, pg8::StaticOrder, true, true>(lds, g, S, E);
    } SEAM(8);
    if (IN(9)) { post_phase(Y, P.in[17], P.out, P.out, P.in[1] + DM, U); } SEAM(9);
    if (IN(10)) {
        pg8::Gemm g{U, (const bf16*)(ws + WS_WC), TOK, C_N, DM}; pg8::StaticOrder S; S.init(TOK, C_N, G, bx);
        pg8::EpiBf16P E{PROJ, C_N};
        pg8::gemm_phase<pg8::EpiBf16P, pg8::StaticOrder, true, true>(lds, g, S, E);
        skinny_phase<1>(U, (const bf16*)(ws + WS_WCG), GIF, 16, 16);
    } SEAM(10);
    if (IN(11)) { mlstm_naive_phase(PROJ, GIF, P.in[13], HOUT, lds); } SEAM(11);
    if (IN(12)) { cgate_phase(HOUT, PROJ, P.in[14], YMIX); } SEAM(12);
    if (IN(13)) {
        pg8::Gemm g{YMIX, (const bf16*)(ws + WS_WOC), TOK, DM, DM}; pg8::StaticOrder S; S.init(TOK, DM, G, bx);
        pg8::EpiF32P E{Y, DM};
        pg8::gemm_phase<pg8::EpiF32P, pg8::StaticOrder, true, true>(lds, g, S, E);
    } SEAM(13);
    if (IN(14)) { post_phase(Y, P.in[2] + DM, P.out, P.out, P.in[16] + DM, U); } SEAM(14);
    if (IN(15)) {
        pg8::Gemm g{U, (const bf16*)(ws + WS_WF1 + WF1_BYTES), TOK, F1N, DM}; pg8::StaticOrder S; S.init(TOK, F1N, G, bx);
        pg8::EpiGU E{Gb, U2, FFP};
        pg8::gemm_phase<pg8::EpiGU, pg8::StaticOrder, true, true>(lds, g, S, E);
    } SEAM(15);
    if (IN(16)) { act_phase(Gb, U2, P.in[19] + 3 * DFF, P.in[20] + DFF, ACT); } SEAM(16);
    if (IN(17)) {
        pg8::Gemm g{ACT, (const bf16*)(ws + WS_WF2 + WF2_BYTES), TOK, DM, FFP}; pg8::StaticOrder S; S.init(TOK, DM, G, bx);
        pg8::EpiF32P E{Y, DM};
        pg8::gemm_phase<pg8::EpiF32P, pg8::StaticOrder, true, true>(lds, g, S, E);
    } SEAM(17);
    if (IN(18)) { post_phase(Y, P.in[17] + DM, P.out, P.out, nullptr, U); }
#undef IN
#undef SEAM
}

extern "C" void kernel_launch(void* const* d_in, const int* in_sizes, int n_in, void* d_out, int out_size, void* d_ws, size_t ws_size, hipStream_t stream) {
    static int grid = 0;
    if (grid == 0) {
        if (n_in != 22 || in_sizes[0] != TOK * DM || out_size != TOK * DM || ws_size < WS_END) { fprintf(stderr, "kernel_launch: unexpected problem shape or workspace (n_in %d, ws %zu < %zu); nothing launched\n", n_in, ws_size, (size_t)WS_END); grid = -1; return; }
        int dev = 0, cus = 0, per_cu = 0;
        if (hipGetDevice(&dev) != hipSuccess || hipDeviceGetAttribute(&cus, hipDeviceAttributeMultiprocessorCount, dev) != hipSuccess) { grid = -1; return; }
        if (hipFuncSetAttribute((const void*)mk_fwd, hipFuncAttributeMaxDynamicSharedMemorySize, LDS_BYTES) != hipSuccess) { fprintf(stderr, "kernel_launch: hipFuncSetAttribute failed\n"); grid = -1; return; }
        if (hipOccupancyMaxActiveBlocksPerMultiprocessor(&per_cu, (const void*)mk_fwd, NWAVES * 64, LDS_BYTES) != hipSuccess || per_cu < 1)
            fprintf(stderr, "kernel_launch: note: occupancy query reports %d workgroups per CU\n", per_cu);
        (void)hipGetLastError();
        grid = cus;
    }
    if (grid < 0) return;
    if (hipMemsetAsync((char*)d_ws + WS_CTL, 0, CTL_ZERO_BYTES, stream) != hipSuccess) return;
    Args a{};
    for (int i = 0; i < 22; ++i) a.in[i] = (const float*)d_in[i];
    a.out = (float*)d_out; a.ws = (unsigned char*)d_ws;
#if MK_PER_PHASE
    for (int p = 0; p < NPHASE; ++p) { a.ph_lo = p; a.ph_hi = p + 1; hipLaunchKernelGGL(mk_fwd, dim3(grid), dim3(NWAVES * 64), LDS_BYTES, stream, a); }
#else
    a.ph_lo = 0; a.ph_hi = NPHASE;
    hipLaunchKernelGGL(mk_fwd, dim3(grid), dim3(NWAVES * 64), LDS_BYTES, stream, a);
#endif
}
```

```cpp
#include <hip/hip_runtime.h>
#include <cstdio>
#include <cstdint>
namespace pg8 {
#define PG8_LAS __attribute__((address_space(3)))
typedef unsigned short bf16_t;
typedef short bf16x8 __attribute__((ext_vector_type(8)));
typedef float f32x4 __attribute__((ext_vector_type(4)));
typedef unsigned u32x4 __attribute__((ext_vector_type(4)));
constexpr int BM = 256, BK = 64, HALF = 128, HTB = HALF * BK * 2  , STAGE_BYTES = 8 * HTB, NXCD = 8, WGM = 8;

__host__ __device__ __forceinline__ int lds_byte(int r, int c) { const int st = (r >> 4) * 2 + (c >> 5), rr = r & 15, cc = c & 31, ob = rr * 64 + cc * 2; return st * 1024 + (ob ^ (((ob >> 9) & 1) << 5)); }
__host__ __device__ __forceinline__ void stage_rc(int b, int& R, int& C) { const int st = b / 1024, sb = b % 1024, swz = sb ^ (((sb >> 9) & 1) << 5); R = (st >> 1) * 16 + swz / 64; C = (st & 1) * 32 + (swz % 64) / 2; }
__host__ __device__ __forceinline__ int perm32(int rho) { const int n = rho >> 4, i = rho & 15; return 8 * (i >> 2) + 4 * n + (i & 3); }

struct Unit { int pm, pn, slot; };
struct Gemm { const bf16_t* A; const bf16_t* Bt; int M, N, K; int ld = 0; };

struct StaticOrder {
    int nM, nN, nwg, G, c;
    __host__ __device__ void init(int M, int N, int G_, int c_) { nM = M / BM; nN = N / BM; nwg = nM * nN; G = G_; c = c_; }
    __host__ __device__ bool next(int i, Unit& u) const {
        const long L = (long)i * G + c; if (L >= nwg) return false;
        int wgid = (int)L; { const int q = nwg / NXCD, r = nwg % NXCD, xcd = wgid % NXCD, off = wgid / NXCD; wgid = (xcd < r ? xcd * (q + 1) : r * (q + 1) + (xcd - r) * q) + off; }
        const int nig = WGM * nN, gid = wgid / nig, fm = gid * WGM, gsz = (nM - fm) < WGM ? (nM - fm) : WGM;
        u.pm = fm + ((wgid % nig) % gsz); u.pn = (wgid % nig) / gsz; return true;
    }
    __device__ __forceinline__ void a_ready(const Unit&) const {}
    __device__ __forceinline__ void done(const Unit&) const {}
};

__device__ __forceinline__ unsigned cvt_pk_bf16(float lo, float hi) { unsigned r; asm volatile("v_cvt_pk_bf16_f32 %0, %1, %2" : "=v"(r) : "v"(lo), "v"(hi)); return r; }

struct EpiBf16P {
    static constexpr bool PERM = true, AFTER_DRAIN = false;
    bf16_t* O; int ldc;
    __device__ __forceinline__ void operator()(const f32x4 (&acc)[2][2][4][2], const Unit& u, int wr, int wc, int fr, int fq) const {
        const int row0 = u.pm * BM + wr * 64 + fr, col0 = u.pn * BM + wc * 32 + 8 * fq;
#pragma unroll
        for (int ai = 0; ai < 2; ++ai)
#pragma unroll
            for (int m = 0; m < 4; ++m) { bf16_t* rowp = O + (size_t)(row0 + ai * HALF + m * 16) * ldc + col0;
#pragma unroll
                for (int bj = 0; bj < 2; ++bj) { const f32x4 v0 = acc[ai][bj][m][0], v1 = acc[ai][bj][m][1];
                    u32x4 w; w.x = cvt_pk_bf16(v0[0], v0[1]); w.y = cvt_pk_bf16(v0[2], v0[3]); w.z = cvt_pk_bf16(v1[0], v1[1]); w.w = cvt_pk_bf16(v1[2], v1[3]);
                    *(u32x4*)(rowp + bj * HALF) = w; } }
    }
};
struct EpiGU {
    static constexpr bool PERM = true, AFTER_DRAIN = false;
    bf16_t* G; bf16_t* U; int ldc;
    __device__ __forceinline__ void operator()(const f32x4 (&acc)[2][2][4][2], const Unit& u, int wr, int wc, int fr, int fq) const {
        const int row0 = u.pm * BM + wr * 64 + fr, col0 = u.pn * HALF + wc * 32 + 8 * fq;
#pragma unroll
        for (int ai = 0; ai < 2; ++ai)
#pragma unroll
            for (int m = 0; m < 4; ++m) { const size_t off = (size_t)(row0 + ai * HALF + m * 16) * ldc + col0;
#pragma unroll
                for (int bj = 0; bj < 2; ++bj) { const f32x4 v0 = acc[ai][bj][m][0], v1 = acc[ai][bj][m][1];
                    u32x4 w; w.x = cvt_pk_bf16(v0[0], v0[1]); w.y = cvt_pk_bf16(v0[2], v0[3]); w.z = cvt_pk_bf16(v1[0], v1[1]); w.w = cvt_pk_bf16(v1[2], v1[3]);
                    *(u32x4*)((bj == 0 ? G : U) + off) = w; } }
    }
};
struct EpiF32P {
    static constexpr bool PERM = false, AFTER_DRAIN = false;
    float* C; int ldc;
    __device__ __forceinline__ void operator()(const f32x4 (&acc)[2][2][4][2], const Unit& u, int wr, int wc, int fr, int fq) const {
        const int row0 = u.pm * BM + wr * 64 + fr, col0 = u.pn * BM + wc * 32 + 4 * fq;
#pragma unroll
        for (int ai = 0; ai < 2; ++ai)
#pragma unroll
            for (int m = 0; m < 4; ++m) { float* rowp = C + (size_t)(row0 + ai * HALF + m * 16) * ldc + col0;
#pragma unroll
                for (int bj = 0; bj < 2; ++bj)
#pragma unroll
                    for (int n = 0; n < 2; ++n) *(f32x4*)(rowp + bj * HALF + n * 16) = acc[ai][bj][m][n]; }
    }
};


struct PoolOrder { int c, G;
    __device__ __forceinline__ bool next(int i, Unit& u) const { const long L = (long)i * G + c; if (L >= 256) return false; u.pm = (int)L; u.pn = (int)L >> 6; return true; }
    __device__ __forceinline__ void a_ready(const Unit&) const {}
    __device__ __forceinline__ void done(const Unit&) const {}
};
struct EpiPool {
    static constexpr bool PERM = true, AFTER_DRAIN = false;
    bf16_t* O; const float* scale;
    __device__ __forceinline__ void operator()(const f32x4 (&acc)[2][2][4][2], const Unit& u, int wr, int wc, int fr, int fq) const {
        const int row0 = (u.pm & 63) * BM + wr * 64 + fr, col0 = u.pn * BM + wc * 32 + 8 * fq;
#pragma unroll
        for (int bj = 0; bj < 2; ++bj) { const f32x4 s0 = *(const f32x4*)(scale + col0 + bj * HALF), s1 = *(const f32x4*)(scale + col0 + bj * HALF + 4);
#pragma unroll
            for (int ai = 0; ai < 2; ++ai)
#pragma unroll
                for (int m = 0; m < 4; ++m) { const f32x4 v0 = acc[ai][bj][m][0] * s0, v1 = acc[ai][bj][m][1] * s1;
                    u32x4 w; w.x = cvt_pk_bf16(v0[0], v0[1]); w.y = cvt_pk_bf16(v0[2], v0[3]); w.z = cvt_pk_bf16(v1[0], v1[1]); w.w = cvt_pk_bf16(v1[2], v1[3]);
                    *(u32x4*)(O + (size_t)(row0 + ai * HALF + m * 16) * 4096 + col0 + bj * HALF) = w; } }
    }
};
struct CmpOrder { int c, G;
    __device__ __forceinline__ bool next(int i, Unit& u) const { const long L = (long)i * G + c; if (L >= 64) return false; const int w = (int)L >> 5, r = (int)L & 31; u.pm = w * 16 + (r >> 1); u.pn = w * 2 + (r & 1); return true; }
    __device__ __forceinline__ void a_ready(const Unit&) const {}
    __device__ __forceinline__ void done(const Unit&) const {}
};
struct EpiCmp {
    static constexpr bool PERM = false, AFTER_DRAIN = false;
    float* C;
    __device__ __forceinline__ void operator()(const f32x4 (&acc)[2][2][4][2], const Unit& u, int wr, int wc, int fr, int fq) const {
        const int row0 = u.pm * BM + wr * 64 + fr, col0 = (u.pn & 1) * BM + wc * 32 + 4 * fq;
#pragma unroll
        for (int ai = 0; ai < 2; ++ai)
#pragma unroll
            for (int m = 0; m < 4; ++m) { float* rowp = C + (size_t)(row0 + ai * HALF + m * 16) * 512 + col0;
#pragma unroll
                for (int bj = 0; bj < 2; ++bj)
#pragma unroll
                    for (int n = 0; n < 2; ++n) *(f32x4*)(rowp + bj * HALF + n * 16) = acc[ai][bj][m][n]; }
    }
};

__device__ __forceinline__ float dpp_ror1(float v) { return __builtin_bit_cast(float, __builtin_amdgcn_update_dpp(0, __builtin_bit_cast(int, v), 0x121, 0xf, 0xf, false)); }
__device__ __forceinline__ float dpp_ror2(float v) { return __builtin_bit_cast(float, __builtin_amdgcn_update_dpp(0, __builtin_bit_cast(int, v), 0x122, 0xf, 0xf, false)); }
struct ActOrder {
    StaticOrder S; const float* cw; const float* cb; int dff; PG8_LAS unsigned char* wl;
    __device__ __forceinline__ bool next(int i, Unit& u) const { if (!S.next(i, u)) return false; u.slot = i & 1; return true; }
    __device__ __forceinline__ void a_ready(const Unit& u) const {
        const int l = threadIdx.x & 31, wc = (threadIdx.x >> 6) & 3, a = l >> 3, q = l & 7;
        int ff = u.pn * HALF + wc * 32 + q * 4; ff = ff < dff - 4 ? ff : dff - 4;
        const float* src = (a < 3 ? cw + a * dff : cb) + ff;
        __builtin_amdgcn_global_load_lds((const unsigned*)src, (PG8_LAS unsigned*)(wl + u.slot * 1024), 16, 0, 0);
    }
    __device__ __forceinline__ void done(const Unit&) const {}
};
struct EpiAct {
    static constexpr bool PERM = true, AFTER_DRAIN = false;
    bf16_t* ACT; bf16_t* side; PG8_LAS unsigned char* wl; int ldc, dff;
    __device__ __forceinline__ void operator()(const f32x4 (&acc)[2][2][4][2], const Unit& u, int wr, int wc, int fr, int fq) const {
        const int ff0 = u.pn * HALF + wc * 32 + 8 * fq;
        float w0[8], w1[8], w2[8], bb[8];
        if (ff0 < dff) {
#pragma unroll
            for (int h = 0; h < 2; ++h) { const PG8_LAS float* wp = (const PG8_LAS float*)(wl + u.slot * 1024) + 8 * fq + 4 * h;
                const f32x4 a = *(const PG8_LAS f32x4*)wp, b1 = *(const PG8_LAS f32x4*)(wp + 32), c = *(const PG8_LAS f32x4*)(wp + 64), d = *(const PG8_LAS f32x4*)(wp + 96);
#pragma unroll
                for (int j = 0; j < 4; ++j) { w0[4 * h + j] = a[j]; w1[4 * h + j] = b1[j]; w2[4 * h + j] = c[j]; bb[4 * h + j] = d[j]; } }
        } else {
#pragma unroll
            for (int j = 0; j < 8; ++j) { w0[j] = 0.f; w1[j] = 0.f; w2[j] = 0.f; bb[j] = 0.f; } }
#pragma unroll
        for (int ai = 0; ai < 2; ++ai) {
            const int rowb = u.pm * BM + ai * HALF + wr * 64, chunk = rowb >> 6;
#pragma unroll
            for (int m = 0; m < 4; ++m) {
                float o[8];
#pragma unroll
                for (int e = 0; e < 8; ++e) { const float g = acc[ai][0][m][e >> 2][e & 3], up = acc[ai][1][m][e >> 2][e & 3];
                    const float gp = (m > 0) ? acc[ai][0][m > 0 ? m - 1 : 0][e >> 2][e & 3] : 0.f;
                    const float a1 = dpp_ror1(g), b1 = dpp_ror1(gp), a2 = dpp_ror2(g), b2 = dpp_ror2(gp);
                    const float p1 = fr >= 1 ? a1 : b1, p2 = fr >= 2 ? a2 : b2;
                    const float x = bb[e] + w0[e] * g + w1[e] * p1 + w2[e] * p2;
                    o[e] = x * __builtin_amdgcn_rcpf(1.0f + __builtin_amdgcn_exp2f(-1.4426950408889634f * x)) * up; }
                if (!(m == 0 && fr < 2)) { u32x4 w; w.x = cvt_pk_bf16(o[0], o[1]); w.y = cvt_pk_bf16(o[2], o[3]); w.z = cvt_pk_bf16(o[4], o[5]); w.w = cvt_pk_bf16(o[6], o[7]);
                    *(u32x4*)(ACT + (size_t)(rowb + 16 * m + fr) * ldc + ff0) = w; }
                if ((m == 0 && fr < 2) || (m == 3 && fr >= 14)) { const int rr = (m == 0) ? fr : fr - 12;
                    const f32x4 g0 = acc[ai][0][m][0], g1 = acc[ai][0][m][1], u0 = acc[ai][1][m][0], u1 = acc[ai][1][m][1];
                    u32x4 wg, wu; wg.x = cvt_pk_bf16(g0[0], g0[1]); wg.y = cvt_pk_bf16(g0[2], g0[3]); wg.z = cvt_pk_bf16(g1[0], g1[1]); wg.w = cvt_pk_bf16(g1[2], g1[3]);
                    wu.x = cvt_pk_bf16(u0[0], u0[1]); wu.y = cvt_pk_bf16(u0[2], u0[3]); wu.z = cvt_pk_bf16(u1[0], u1[1]); wu.w = cvt_pk_bf16(u1[2], u1[3]);
                    bf16_t* sp = side + ((size_t)(chunk * 4 + rr) * 2) * ldc + ff0; *(u32x4*)sp = wg; *(u32x4*)(sp + ldc) = wu; }
            }
        }
    }
};

struct EpiAB {
    static constexpr bool PERM = true, AFTER_DRAIN = false;
    bf16_t* O; float* glog;
    __device__ __forceinline__ void operator()(const f32x4 (&acc)[2][2][4][2], const Unit& u, int wr, int wc, int fr, int fq) const {
        const int row0 = u.pm * BM + wr * 64 + fr;
        if (u.pn < 28) { const int col0 = u.pn * BM + wc * 32 + 8 * fq;
#pragma unroll
            for (int ai = 0; ai < 2; ++ai)
#pragma unroll
                for (int m = 0; m < 4; ++m) { bf16_t* rowp = O + (size_t)(row0 + ai * HALF + m * 16) * 7168 + col0;
#pragma unroll
                    for (int bj = 0; bj < 2; ++bj) { const f32x4 v0 = acc[ai][bj][m][0], v1 = acc[ai][bj][m][1];
                        u32x4 w; w.x = cvt_pk_bf16(v0[0], v0[1]); w.y = cvt_pk_bf16(v0[2], v0[3]); w.z = cvt_pk_bf16(v1[0], v1[1]); w.w = cvt_pk_bf16(v1[2], v1[3]);
                        *(u32x4*)(rowp + bj * HALF) = w; } }
        } else { const int c0 = wc * 32 + 8 * fq;
            if (c0 < 72) {
#pragma unroll
                for (int ai = 0; ai < 2; ++ai)
#pragma unroll
                    for (int m = 0; m < 4; ++m) { float* rowp = glog + (size_t)(row0 + ai * HALF + m * 16) * 72 + c0;
                        *(f32x4*)rowp = acc[ai][0][m][0]; *(f32x4*)(rowp + 4) = acc[ai][0][m][1]; } } }
    }
};

struct GateOrder { int c, first, n, sh;
    __device__ __forceinline__ bool next(int i, Unit& u) const { if (i != 0 || c < first || c >= first + n) return false; u.pm = (c - first) >> sh; u.pn = 0; return true; }
    __device__ __forceinline__ void a_ready(const Unit&) const {}
    __device__ __forceinline__ void done(const Unit&) const {}
};
struct EpiGate {
    static constexpr bool PERM = true, AFTER_DRAIN = false;
    float* glog;
    __device__ __forceinline__ void operator()(const f32x4 (&acc)[2][2][4][2], const Unit& u, int wr, int wc, int fr, int fq) const {
        const int row0 = u.pm * BM + wr * 64 + fr, c0 = wc * 32 + 8 * fq;
        if (c0 < 72) {
#pragma unroll
            for (int ai = 0; ai < 2; ++ai)
#pragma unroll
                for (int m = 0; m < 4; ++m) { float* rowp = glog + (size_t)(row0 + ai * HALF + m * 16) * 72 + c0;
                    *(f32x4*)rowp = acc[ai][0][m][0]; *(f32x4*)(rowp + 4) = acc[ai][0][m][1]; } }
    }
};
template <class Epi, class Sched, bool ALIGN_EPI = false, bool SP2 = false>
__device__ __forceinline__ void gemm_phase(PG8_LAS unsigned char* lds, const Gemm g, const Sched& S, const Epi& E) {
    const int tid = threadIdx.x, wid = __builtin_amdgcn_readfirstlane(tid >> 6), lane = tid & 63, wr = wid >> 2, wc = wid & 3, fr = lane & 15, fq = lane >> 4;
    const int K = g.K, LD = g.ld ? g.ld : g.K, nt = K / BK;
    unsigned voffA[2], voffB[2];
#pragma unroll
    for (int i = 0; i < 2; ++i) { int R, C; stage_rc(tid * 16 + i * 8192, R, C); const int Rb = Epi::PERM ? ((R & ~31) + perm32(R & 31)) : R;
        voffA[i] = (unsigned)(R * LD + C) * 2u; voffB[i] = (unsigned)(Rb * LD + C) * 2u; }
    const size_t kstep = (size_t)(BK * 2);
    const size_t hstep = (size_t)HALF * LD * 2;
    const size_t tstep = 2 * hstep;
    const unsigned ldsw = (unsigned)wid * 1024u;
    const int aoff = lds_byte(wr * 64 + fr, fq * 8), boff = lds_byte(wc * 32 + fr, fq * 8);
#define PG8_SA(b, h) (((b) * 2 + (h)) * HTB)
#define PG8_SB(b, h) ((4 + (b) * 2 + (h)) * HTB)
#define PG8_STAGE(bufoff, gbase, voff) do { _Pragma("unroll") for (int _i = 0; _i < 2; ++_i) \
        __builtin_amdgcn_global_load_lds((const unsigned*)((const char*)(gbase) + (voff)[_i]), (PG8_LAS unsigned*)(lds + (bufoff) + ldsw + _i * 8192), 16, 0, 0); } while (0)
#define PG8_LDA(dst, b, h) do { _Pragma("unroll") for (int m = 0; m < 4; ++m) _Pragma("unroll") for (int k = 0; k < 2; ++k) dst[m][k] = *(const PG8_LAS bf16x8*)(lds + PG8_SA(b, h) + aoff + m * 2048 + k * 1024); } while (0)
#define PG8_LDB(dst, b, h) do { _Pragma("unroll") for (int n = 0; n < 2; ++n) _Pragma("unroll") for (int k = 0; k < 2; ++k) dst[n][k] = *(const PG8_LAS bf16x8*)(lds + PG8_SB(b, h) + boff + n * 2048 + k * 1024); } while (0)
#define PG8_MMA(ai, bj, At, Bt) do { __builtin_amdgcn_s_setprio(1); _Pragma("unroll") for (int m = 0; m < 4; ++m) _Pragma("unroll") for (int n = 0; n < 2; ++n) _Pragma("unroll") for (int k = 0; k < 2; ++k) \
        acc[ai][bj][m][n] = __builtin_amdgcn_mfma_f32_16x16x32_bf16(Bt[n][k], At[m][k], acc[ai][bj][m][n], 0, 0, 0); __builtin_amdgcn_s_setprio(0); } while (0)
#define PG8_WAIT_V(n) asm volatile("s_waitcnt vmcnt(" #n ")" ::: "memory")
#define PG8_WAIT_L(n) asm volatile("s_waitcnt lgkmcnt(" #n ")" ::: "memory")
#define PG8_BAR __builtin_amdgcn_s_barrier()
#define PG8_SCHED __builtin_amdgcn_sched_barrier(0)
    Unit cur, nxt; int ui = 0;
    if (!S.next(0, cur)) return;
    f32x4 acc[2][2][4][2];
#pragma unroll
    for (int a = 0; a < 2; ++a)
#pragma unroll
        for (int b = 0; b < 2; ++b)
#pragma unroll
            for (int m = 0; m < 4; ++m)
#pragma unroll
                for (int n = 0; n < 2; ++n) acc[a][b][m][n] = (f32x4){0.f, 0.f, 0.f, 0.f};
    bf16x8 At[4][2], B0[2][2], B1[2][2];
    const char* cA = (const char*)g.A + (size_t)cur.pm * tstep; const char* cB = (const char*)g.Bt + (size_t)cur.pn * tstep;
    S.a_ready(cur);
    if constexpr (SP2) {
        PG8_STAGE(PG8_SB(0, 0), cB, voffB); PG8_STAGE(PG8_SB(0, 1), cB + hstep, voffB); PG8_STAGE(PG8_SA(0, 0), cA, voffA); PG8_STAGE(PG8_SA(0, 1), cA + hstep, voffA);
        if (wr == 1) PG8_BAR;
        PG8_WAIT_V(2); PG8_BAR;
        PG8_STAGE(PG8_SB(1, 0), cB + kstep, voffB); PG8_STAGE(PG8_SA(1, 0), cA + kstep, voffA); PG8_STAGE(PG8_SB(1, 1), cB + hstep + kstep, voffB);
        PG8_WAIT_V(6); PG8_BAR;
    } else {
        PG8_STAGE(PG8_SB(0, 0), cB, voffB); PG8_STAGE(PG8_SA(0, 0), cA, voffA); PG8_STAGE(PG8_SB(0, 1), cB + hstep, voffB); PG8_STAGE(PG8_SA(0, 1), cA + hstep, voffA);
        if (wr == 1) PG8_BAR;
        PG8_WAIT_V(4); PG8_BAR;
        PG8_STAGE(PG8_SB(1, 0), cB + kstep, voffB); PG8_STAGE(PG8_SA(1, 0), cA + kstep, voffA); PG8_STAGE(PG8_SB(1, 1), cB + hstep + kstep, voffB);
        PG8_WAIT_V(6); PG8_BAR;
    }
    for (;;) {
        const bool has_next = S.next(ui + 1, nxt);
        const char* nA = has_next ? (const char*)g.A + (size_t)nxt.pm * tstep : cA; const char* nB = has_next ? (const char*)g.Bt + (size_t)nxt.pn * tstep : cB;
        for (int t = 0; t < nt; t += 2) {
            const bool last = (t == nt - 2);
            const char* a1 = cA + (size_t)(t + 1) * kstep;
            const char* a2 = last ? nA : cA + (size_t)(t + 2) * kstep; const char* b2 = last ? nB : cB + (size_t)(t + 2) * kstep;
            const char* a3 = a2 + kstep; const char* b3 = b2 + kstep;
            if (last && has_next) S.a_ready(nxt);
            if constexpr (SP2) {
            PG8_LDB(B0, 0, 0); PG8_LDB(B1, 0, 1); PG8_SCHED; PG8_LDA(At, 0, 0); PG8_STAGE(PG8_SA(1, 1), a1 + hstep, voffA);
            PG8_WAIT_V(8); PG8_WAIT_L(0); PG8_BAR; PG8_MMA(0, 0, At, B0); PG8_MMA(0, 1, At, B1); PG8_BAR; PG8_SCHED;
            PG8_LDA(At, 0, 1); PG8_STAGE(PG8_SB(0, 0), b2, voffB); PG8_STAGE(PG8_SB(0, 1), b2 + hstep, voffB); PG8_STAGE(PG8_SA(0, 0), a2, voffA);
            PG8_WAIT_V(8); PG8_WAIT_L(0); PG8_BAR; PG8_MMA(1, 0, At, B0); PG8_MMA(1, 1, At, B1); PG8_BAR; PG8_SCHED;
            PG8_LDB(B0, 1, 0); PG8_LDB(B1, 1, 1); PG8_SCHED; PG8_LDA(At, 1, 0); PG8_STAGE(PG8_SA(0, 1), a2 + hstep, voffA);
            PG8_WAIT_V(8); PG8_WAIT_L(0); PG8_BAR; PG8_MMA(0, 0, At, B0); PG8_MMA(0, 1, At, B1); PG8_BAR; PG8_SCHED;
            PG8_LDA(At, 1, 1); PG8_STAGE(PG8_SB(1, 0), b3, voffB); PG8_STAGE(PG8_SB(1, 1), b3 + hstep, voffB); PG8_STAGE(PG8_SA(1, 0), a3, voffA);
            PG8_WAIT_V(8); PG8_WAIT_L(0); PG8_BAR; PG8_MMA(1, 0, At, B0); PG8_MMA(1, 1, At, B1); PG8_BAR; PG8_SCHED;
            } else {
            PG8_LDB(B0, 0, 0); PG8_SCHED; PG8_LDA(At, 0, 0); PG8_STAGE(PG8_SA(1, 1), a1 + hstep, voffA);
            PG8_WAIT_L(8); PG8_BAR; PG8_WAIT_L(0); PG8_MMA(0, 0, At, B0); PG8_BAR; PG8_SCHED;
            PG8_LDB(B1, 0, 1); PG8_STAGE(PG8_SB(0, 0), b2, voffB);
            PG8_BAR; PG8_WAIT_L(0); PG8_MMA(0, 1, At, B1); PG8_BAR;
            PG8_LDA(At, 0, 1); PG8_STAGE(PG8_SA(0, 0), a2, voffA);
            PG8_BAR; PG8_WAIT_L(0); PG8_MMA(1, 0, At, B0); PG8_BAR; PG8_SCHED;
            PG8_STAGE(PG8_SB(0, 1), b2 + hstep, voffB);
            PG8_WAIT_V(6); PG8_BAR; PG8_MMA(1, 1, At, B1); PG8_BAR;
            PG8_LDB(B0, 1, 0); PG8_SCHED; PG8_LDA(At, 1, 0); PG8_STAGE(PG8_SA(0, 1), a2 + hstep, voffA);
            PG8_WAIT_L(8); PG8_BAR; PG8_WAIT_L(0); PG8_MMA(0, 0, At, B0); PG8_BAR; PG8_SCHED;
            PG8_LDB(B1, 1, 1); PG8_STAGE(PG8_SB(1, 0), b3, voffB);
            PG8_BAR; PG8_WAIT_L(0); PG8_MMA(0, 1, At, B1); PG8_BAR;
            PG8_LDA(At, 1, 1); PG8_STAGE(PG8_SA(1, 0), a3, voffA);
            PG8_BAR; PG8_WAIT_L(0); PG8_MMA(1, 0, At, B0); PG8_BAR; PG8_SCHED;
            PG8_STAGE(PG8_SB(1, 1), b3 + hstep, voffB);
            PG8_WAIT_V(6); PG8_BAR; PG8_MMA(1, 1, At, B1); PG8_BAR;
            }
        }
        if constexpr (ALIGN_EPI) { if (wr == 0) PG8_BAR; }
        if constexpr (!Epi::AFTER_DRAIN) { E(acc, cur, wr, wc, fr, fq); S.done(cur); }
        if (!has_next) break;
#pragma unroll
        for (int a = 0; a < 2; ++a)
#pragma unroll
            for (int b = 0; b < 2; ++b)
#pragma unroll
                for (int m = 0; m < 4; ++m)
#pragma unroll
                    for (int n = 0; n < 2; ++n) acc[a][b][m][n] = (f32x4){0.f, 0.f, 0.f, 0.f};
        cur = nxt; cA = nA; cB = nB; ++ui;
        if constexpr (ALIGN_EPI) { if (wr == 1) PG8_BAR; }
    }
    PG8_WAIT_V(0);
    if constexpr (!ALIGN_EPI) { if (wr == 0) PG8_BAR; }
    PG8_BAR;
    if constexpr (Epi::AFTER_DRAIN) { E.fused(acc, cur, wr, wc, fr, fq, lds, wid, lane); S.done(cur); }
#undef PG8_SA
#undef PG8_SB
#undef PG8_STAGE
#undef PG8_LDA
#undef PG8_LDB
#undef PG8_MMA
#undef PG8_WAIT_V
#undef PG8_WAIT_L
#undef PG8_BAR
#undef PG8_SCHED
}
}
#define LAS __attribute__((address_space(3)))
#define XB_TMO      128
#define XB_XCNT(j)  (256  + 64 * (j))
#define XB_XSUB(j)  (1280 + 64 * (j))
#define XB_XGEN(j)  (2304 + 64 * (j))
#define XB_TOP      3328
#define XB_TOPGEN   3392
#define XCD_BAR_WORDS 3456
#define XB_SPIN_CAP (1u << 18)

__device__ __forceinline__ unsigned xb_ld(unsigned* p)              { return __hip_atomic_load(p, __ATOMIC_RELAXED, __HIP_MEMORY_SCOPE_AGENT); }
__device__ __forceinline__ unsigned xb_add(unsigned* p, unsigned v) { return __hip_atomic_fetch_add(p, v, __ATOMIC_RELAXED, __HIP_MEMORY_SCOPE_AGENT); }
__device__ __forceinline__ unsigned xb_xcc_id() { return (unsigned)__builtin_amdgcn_s_getreg((3 << 11) | 20) & 0xFu; }
#define XB_SPIN(cond, bar) do { unsigned _sp = 0; while (cond) { __builtin_amdgcn_s_sleep(1); \
    if ((++_sp & 255u) == 0u) { if (xb_ld(&(bar)[XB_TMO])) break; if (_sp > XB_SPIN_CAP) { atomicAdd(&(bar)[XB_TMO], 1u); break; } } } } while (0)

struct XcdBarrier {
    unsigned* bar; unsigned x;
    volatile LAS unsigned* st;
};

__device__ __forceinline__ XcdBarrier xcd_barrier_post(unsigned* bar, volatile LAS unsigned* st) {
    XcdBarrier b; b.bar = bar; b.x = xb_xcc_id(); b.st = st;
    if (threadIdx.x == 0) (void)xb_add(&bar[XB_XCNT(b.x)], 1u);
    return b;
}
__device__ __forceinline__ void xcd_barrier_complete(unsigned* bar, unsigned x, unsigned& nloc, unsigned& nx) {
    const unsigned G = gridDim.x * gridDim.y * gridDim.z;
    unsigned sum, cnt, mine, sp = 0u;
    for (;;) {
        sum = 0u; cnt = 0u; mine = 0u;
#pragma unroll
        for (unsigned j = 0; j < 16; ++j) { const unsigned c = xb_ld(&bar[XB_XCNT(j)]); sum += c; cnt += (c > 0u) ? 1u : 0u; mine = (j == x) ? c : mine; }
        if (sum == G) break;
        __builtin_amdgcn_s_sleep(1);
        if ((++sp & 255u) == 0u) { if (xb_ld(&bar[XB_TMO])) break; if (sp > XB_SPIN_CAP) { atomicAdd(&bar[XB_TMO], 1u); break; } }
    }
    nloc = mine > 0u ? mine : 1u; nx = cnt > 0u ? cnt : 1u;
}

__device__ __forceinline__ void xcd_barrier(const XcdBarrier& b) {
    asm volatile("s_waitcnt vmcnt(0)" ::: "memory");
    __syncthreads();
    if (threadIdx.x == 0) {
        unsigned* bar = b.bar;
        __builtin_amdgcn_s_waitcnt(0);
        unsigned nloc = b.st[0], nx = b.st[1];
        if (nloc == 0u) { xcd_barrier_complete(bar, b.x, nloc, nx); b.st[0] = nloc; b.st[1] = nx; }
        const unsigned old = xb_add(&bar[XB_XSUB(b.x)], 1u);
        const unsigned gen = old / nloc;
        if (old + 1u == (gen + 1u) * nloc) {
            __builtin_amdgcn_fence(__ATOMIC_RELEASE, "agent");
            asm volatile("s_waitcnt vmcnt(0)" ::: "memory");
            const unsigned og = xb_add(&bar[XB_TOP], 1u);
            const unsigned tg = og / nx;
            if (og + 1u == (tg + 1u) * nx) xb_add(&bar[XB_TOPGEN], 1u);
            else XB_SPIN(xb_ld(&bar[XB_TOPGEN]) == tg, bar);
            __builtin_amdgcn_fence(__ATOMIC_ACQUIRE, "agent");
            xb_add(&bar[XB_XGEN(b.x)], 1u);
            asm volatile("s_waitcnt vmcnt(0)" ::: "memory");
        } else {
            XB_SPIN(xb_ld(&bar[XB_XGEN(b.x)]) == gen, bar);
            __builtin_amdgcn_fence(__ATOMIC_ACQUIRE, "agent");
            asm volatile("s_waitcnt vmcnt(0)" ::: "memory");
        }
    }
    __syncthreads();
}
#ifndef MK_REP_PHASE
#define MK_REP_PHASE -1
#endif
#define REPK(k) for (int rep_ = 0; rep_ < ((k) == MK_REP_PHASE ? 2 : 1); ++rep_)
#ifndef MK_ML_WARM
#define MK_ML_WARM 0
#endif
#ifndef MK_GLOG_CMP
#define MK_GLOG_CMP 0
#endif
#ifndef MK_ML_PROBE
#define MK_ML_PROBE 0
#endif
#ifndef MK_ML_REFILL
#define MK_ML_REFILL 0
#endif
#ifndef MK_NSA_V1
#define MK_NSA_V1 0
#endif
#ifndef MK_MLSTM_NAIVE
#define MK_MLSTM_NAIVE 0
#endif
#ifndef MK_NSA_CMP
#define MK_NSA_CMP 0
#endif

typedef unsigned short bf16;
typedef float f32x4 __attribute__((ext_vector_type(4)));
typedef short bf16x8 __attribute__((ext_vector_type(8)));
typedef unsigned u32x4 __attribute__((ext_vector_type(4)));
typedef unsigned u32x2 __attribute__((ext_vector_type(2)));
constexpr int NWAVES = 8;
constexpr int TOK = 16384, DM = 4096, SEQ = 8192;
constexpr int AB_N = 7168, AB_W = 7240, C_N = 12288, C_W = 12304;
constexpr int DFF = 10944, FFP = 11008, F1N = 22016, F1W = 21888;
constexpr float RMS_EPS = 1e-6f;
constexpr float NEGF = -1e30f;
constexpr size_t MiB = 1u << 20;
constexpr size_t WS_CTL = 0, CTL_ZERO_BYTES = 1 * MiB;
constexpr size_t WS_WAB = 1 * MiB, WS_WABG = 57 * MiB  , WS_WOAB = 60 * MiB, WS_WC = 92 * MiB, WS_WCG = 188 * MiB, WS_WOC = 189 * MiB;
constexpr size_t WS_WF1 = 221 * MiB, WF1_BYTES = 172 * MiB, WS_WF2 = 565 * MiB, WF2_BYTES = 86 * MiB;
constexpr size_t WS_R0 = 737 * MiB, WS_R1 = 1425 * MiB, WS_R2 = 1769 * MiB, WS_HB = 1969 * MiB  , WS_END = 2097 * MiB;
constexpr size_t WS_PROJ = WS_R0, WS_G = WS_R0, WS_U2 = WS_R0 + 344 * MiB, WS_Y = WS_R0 + 384 * MiB, WS_HOUT = WS_R0 + 384 * MiB;
constexpr size_t WS_SIDE = WS_R0 + 640 * MiB;
constexpr size_t WS_U = WS_R1, WS_YMIX = WS_R1 + 128 * MiB, WS_ACT = WS_R0;
constexpr size_t WS_QF = WS_R2 + 120 * MiB;
constexpr size_t WS_WQ = WS_R2 + 100 * MiB;
constexpr size_t WS_LSC = WS_R2 + 20 * MiB;
constexpr size_t WS_SCAL = WS_R2 + 16 * MiB, WS_KT = WS_R2 + 32 * MiB, WS_VT = WS_R1;
constexpr int GLOG_P2 = TOK * 72;
constexpr size_t WS_GLOG = WS_R2, WS_GIF = WS_R2 + 8 * MiB, WS_KCMP = WS_R2 + 10 * MiB, WS_VCMP = WS_R2 + 11 * MiB, WS_VCT = WS_R2 + 12 * MiB, WS_VTS = WS_R2 + 16 * MiB, WS_VTW = WS_R2 + 32 * MiB, WS_YMIX2 = WS_R0 + 256 * MiB,
    WS_POOLED = WS_R2 + 48 * MiB, WS_KCR = WS_R2 + 80 * MiB, WS_PCMP = WS_R2 + 112 * MiB, WS_WCMP = WS_R2 + 128 * MiB, WS_WPOOL = WS_R2 + 132 * MiB, WS_CPART = WS_R2 + 133 * MiB, WS_KFS = WS_R2 + 134 * MiB, WS_KFW = WS_R2 + 150 * MiB, WS_KCF = WS_R2 + 166 * MiB;
static_assert((size_t)F1N * DM * 2 == WF1_BYTES && (size_t)DM * FFP * 2 == WF2_BYTES, "weight copy sizes");
constexpr int CW_BAR = 4096;
constexpr int LDS_BYTES = 163840, MISC_OFF = LDS_BYTES - 256;

#define LDS_WAIT() asm volatile("s_waitcnt lgkmcnt(0)" ::: "memory")
__device__ __forceinline__ int opaque_tid() { int t = threadIdx.x; asm volatile("" : "+v"(t)); return t; }
__device__ __forceinline__ float bf2f(unsigned v) { return __uint_as_float(v << 16); }
__device__ __forceinline__ unsigned f2bf(float f) { unsigned u = __float_as_uint(f); return (u + 0x7fffu + ((u >> 16) & 1u)) >> 16; }
__device__ __forceinline__ unsigned pk2(float lo, float hi) { return f2bf(lo) | (f2bf(hi) << 16); }
__device__ __forceinline__ float wave_sum(float v) {
#pragma unroll
    for (int o = 32; o >= 1; o >>= 1) v += __shfl_xor(v, o);
    return v;
}
__device__ __forceinline__ float wave_max(float v) {
#pragma unroll
    for (int o = 32; o >= 1; o >>= 1) v = fmaxf(v, __shfl_xor(v, o));
    return v;
}
__device__ __forceinline__ void unpack8(const u32x4 w, float (&f)[8]) {
    f[0] = __uint_as_float(w.x << 16); f[1] = __uint_as_float(w.x & 0xffff0000u); f[2] = __uint_as_float(w.y << 16); f[3] = __uint_as_float(w.y & 0xffff0000u);
    f[4] = __uint_as_float(w.z << 16); f[5] = __uint_as_float(w.z & 0xffff0000u); f[6] = __uint_as_float(w.w << 16); f[7] = __uint_as_float(w.w & 0xffff0000u);
}
__device__ __forceinline__ float sigmoidf_(float x) { return 1.0f / (1.0f + __expf(-x)); }

__device__ __forceinline__ void tr_item(const float* W, int ldw, int k0, int n0, bf16* WT, size_t ldk, int dst_row0, LAS float* scr, int lane, int kd0 = -1) {
    if (kd0 < 0) kd0 = k0;
#pragma unroll
    for (int i = 0; i < 8; ++i) { const int kk = 8 * i + (lane >> 3), c4 = (lane & 7) * 4; const f32x4 v = *(const f32x4*)(W + (size_t)(k0 + kk) * ldw + n0 + c4);
        LAS float* d = scr + kk * 33 + c4; d[0] = v.x; d[1] = v.y; d[2] = v.z; d[3] = v.w; }
    LDS_WAIT();
    const int c = lane & 7;
#pragma unroll
    for (int j = 0; j < 4; ++j) { const int n = (lane >> 3) + 8 * j; const LAS float* s = scr + (8 * c) * 33 + n;
        u32x4 o; o.x = pk2(s[0 * 33], s[1 * 33]); o.y = pk2(s[2 * 33], s[3 * 33]); o.z = pk2(s[4 * 33], s[5 * 33]); o.w = pk2(s[6 * 33], s[7 * 33]);
        *(u32x4*)(WT + (size_t)(dst_row0 + n) * ldk + kd0 + 8 * c) = o; }
    LDS_WAIT();
}
__device__ __forceinline__ void rms_row_bf16(const float* xrow, const float* gain, bf16* orow, int lane) {
    const f32x4* xr = (const f32x4*)xrow + lane; const f32x4* gr = (const f32x4*)gain + lane;
    f32x4 v[16]; float ss = 0.f;
#pragma unroll
    for (int j = 0; j < 16; ++j) { v[j] = xr[64 * j]; ss += (v[j].x * v[j].x + v[j].y * v[j].y) + (v[j].z * v[j].z + v[j].w * v[j].w); }
    const float rstd = rsqrtf(wave_sum(ss) * (1.f / DM) + RMS_EPS);
    u32x2* o8 = (u32x2*)orow + lane;
#pragma unroll
    for (int j = 0; j < 16; ++j) { const f32x4 g = gr[64 * j]; u32x2 w; w.x = pk2(v[j].x * rstd * g.x, v[j].y * rstd * g.y); w.y = pk2(v[j].z * rstd * g.z, v[j].w * rstd * g.w); o8[64 * j] = w; }
}
template <bool HIN_BF, bool HOUT_BF>
__device__ __forceinline__ void post_row(const bf16* yrow, const float* gpost, const void* hin, void* hout, const float* gpre, bf16* urow, int lane) {
    const u32x2* yr = (const u32x2*)yrow + lane; const f32x4* gr = (const f32x4*)gpost + lane;
    f32x4 v[16]; float ss = 0.f;
#pragma unroll
    for (int j = 0; j < 16; ++j) { const u32x2 w = yr[64 * j]; v[j].x = __uint_as_float(w.x << 16); v[j].y = __uint_as_float(w.x & 0xffff0000u); v[j].z = __uint_as_float(w.y << 16); v[j].w = __uint_as_float(w.y & 0xffff0000u);
        ss += (v[j].x * v[j].x + v[j].y * v[j].y) + (v[j].z * v[j].z + v[j].w * v[j].w); }
    const float rstd = rsqrtf(wave_sum(ss) * (1.f / DM) + RMS_EPS);
    float s2 = 0.f;
#pragma unroll
    for (int j = 0; j < 16; ++j) { const f32x4 g = gr[64 * j]; f32x4 h0;
        if constexpr (HIN_BF) { const u32x2 w = __builtin_nontemporal_load((const u32x2*)hin + lane + 64 * j);
            h0.x = __uint_as_float(w.x << 16); h0.y = __uint_as_float(w.x & 0xffff0000u); h0.z = __uint_as_float(w.y << 16); h0.w = __uint_as_float(w.y & 0xffff0000u); }
        else h0 = __builtin_nontemporal_load((const f32x4*)hin + lane + 64 * j);
        f32x4 h; h.x = h0.x + v[j].x * rstd * g.x; h.y = h0.y + v[j].y * rstd * g.y; h.z = h0.z + v[j].z * rstd * g.z; h.w = h0.w + v[j].w * rstd * g.w;
        v[j] = h; s2 += (h.x * h.x + h.y * h.y) + (h.z * h.z + h.w * h.w);
        if constexpr (HOUT_BF) { u32x2 w; w.x = pk2(h.x, h.y); w.y = pk2(h.z, h.w); __builtin_nontemporal_store(w, (u32x2*)hout + lane + 64 * j); }
        else __builtin_nontemporal_store(h, (f32x4*)hout + lane + 64 * j); }
    if (gpre) {
        const float r2 = rsqrtf(wave_sum(s2) * (1.f / DM) + RMS_EPS); const f32x4* pr = (const f32x4*)gpre + lane; u32x2* o8 = (u32x2*)urow + lane;
#pragma unroll
        for (int j = 0; j < 16; ++j) { const f32x4 g = pr[64 * j]; u32x2 w; w.x = pk2(v[j].x * r2 * g.x, v[j].y * r2 * g.y); w.y = pk2(v[j].z * r2 * g.z, v[j].w * r2 * g.w); o8[64 * j] = w; }
    }
}
template <bool HIN_BF, bool HOUT_BF>
__device__ __forceinline__ void post_phase(const bf16* y, const float* gpost, const void* hin, void* hout, const float* gpre, bf16* u) {
    const int tx_ = opaque_tid();
    const int lane = tx_ & 63, gw = blockIdx.x * NWAVES + __builtin_amdgcn_readfirstlane(tx_ >> 6), NGW = gridDim.x * NWAVES;
    const bool own = gridDim.x == 256; const int r0 = 2048 * (int)(blockIdx.x & 7) + 8 * (int)(blockIdx.x >> 3) + (gw & 7);
    for (int m0 = gw, k = 0; m0 < TOK; m0 += NGW, ++k) { const int m = own ? r0 + 256 * k : m0; post_row<HIN_BF, HOUT_BF>(y + (size_t)m * DM, gpost, (const char*)hin + (size_t)m * DM * (HIN_BF ? 2 : 4), (char*)hout + (size_t)m * DM * (HOUT_BF ? 2 : 4), gpre, u + (size_t)m * DM, lane); }
}

struct Ptrs {
    const float* in[22]; float* out; unsigned char* ws;
};

__device__ __forceinline__ void prologue_phase(const Ptrs& P, LAS unsigned char* lds) {
    const int tx_ = opaque_tid();
    const int tid = tx_, lane = tid & 63, wave = __builtin_amdgcn_readfirstlane(tid >> 6);
    LAS float* scr = (LAS float*)(lds + wave * 16384);
    const int gw = blockIdx.x * NWAVES + wave, NGW = gridDim.x * NWAVES;
    constexpr int IT_AB = 64 * 224, IT_OAB = 64 * 128, IT_C = 64 * 384, IT_OC = 64 * 128, IT_F1 = 64 * 684, IT_F2 = 171 * 128;
    constexpr int NITEMS = IT_AB + IT_OAB + IT_C + IT_OC + 2 * IT_F1 + 2 * IT_F2;
    unsigned char* ws = P.ws;
    constexpr int NITEMS_P = NITEMS - 2 * IT_F2;
    for (int it = gw; it < NITEMS_P; it += NGW) {
        int r = NITEMS_P - 1 - it;
        if (r < IT_AB) { const int kb = r / 224, nb = r % 224; tr_item(P.in[3], AB_W, 64 * kb, 32 * nb, (bf16*)(ws + WS_WAB), DM, 32 * nb, scr, lane); continue; } r -= IT_AB;
        if (r < IT_OAB) { const int kb = r / 128, nb = r % 128; tr_item(P.in[11], DM, 64 * kb, 32 * nb, (bf16*)(ws + WS_WOAB), DM, 32 * nb, scr, lane); continue; } r -= IT_OAB;
        if (r < IT_C) { const int kb = r / 384, nb = r % 384; tr_item(P.in[12], C_W, 64 * kb, 32 * nb, (bf16*)(ws + WS_WC), DM, 32 * nb, scr, lane); continue; } r -= IT_C;
        if (r < IT_OC) { const int kb = r / 128, nb = r % 128; tr_item(P.in[15], DM, 64 * kb, 32 * nb, (bf16*)(ws + WS_WOC), DM, 32 * nb, scr, lane); continue; } r -= IT_OC;
        if (r < 2 * IT_F1) { const int l = r / IT_F1; r -= l * IT_F1; const int kb = r / 684, nb = r % 684, n0 = 32 * nb, part = n0 >= DFF ? 1 : 0, ff = n0 - part * DFF;
            tr_item(P.in[18] + (size_t)l * DM * F1W, F1W, 64 * kb, n0, (bf16*)(ws + WS_WF1 + l * WF1_BYTES), DM, 256 * (ff >> 7) + 128 * part + (ff & 127), scr, lane); continue; } r -= 2 * IT_F1;
        { const int l = r / IT_F2; r -= l * IT_F2; const int kb = r / 128, nb = r % 128;
            tr_item(P.in[21] + (size_t)l * DFF * DM, DM, 64 * kb, 32 * nb, (bf16*)(ws + WS_WF2 + l * WF2_BYTES), FFP, 32 * nb, scr, lane); }
    }
    for (int it = gw; it < 2 * 64 * 8 + 4 * 4 * 8; it += NGW) {
        if (it < 1024) { const int which = it >> 9, r = it & 511, kb = r >> 3, nb = r & 7, p = kb >> 5;
            tr_item(P.in[which ? 9 : 7], 256, 64 * kb, 32 * nb, (bf16*)(ws + WS_WCMP), 2048, which * 512 + p * 256 + 32 * nb, scr, lane, 64 * kb - 2048 * p); }
        else { const int r = it - 1024, g = r >> 5, kb = (r >> 3) & 3, nb = r & 7;
            tr_item(P.in[4] + (size_t)g * 65536, 256, 64 * kb, 32 * nb, (bf16*)(ws + WS_WPOOL), 256, g * 256 + 32 * nb, scr, lane); }
    }
    for (int task = gw; task < 128; task += NGW) { const int which = task >> 6, jg = (task >> 4) & 3, ic = task & 15; const float* w1 = P.in[which ? 9 : 7] + (size_t)(ic * 256) * 256 + jg * 64 + lane; const float* pp = P.in[6] + ic * 256;
        float a = 0.f;
#pragma unroll 8
        for (int i = 0; i < 256; ++i) a += pp[i] * w1[(size_t)i * 256];
        ((float*)(ws + WS_CPART))[(ic * 2 + which) * 256 + jg * 64 + lane] = a; }
    const size_t gt = (size_t)blockIdx.x * 512 + tid, NT = (size_t)gridDim.x * 512;
    for (size_t i = gt; i < (size_t)2 * 128 * (DM / 8); i += NT) {
        const int l = (int)(i / (128 * 512)); const int rr = (int)(i % (128 * 512)); const int row = rr >> 9, ch = rr & 511;
        const int drow = 85 * 256 + (row >> 6) * 128 + 64 + (row & 63);
        *(u32x4*)((bf16*)(ws + WS_WF1 + l * WF1_BYTES) + (size_t)drow * DM + ch * 8) = (u32x4){0u, 0u, 0u, 0u}; }
    for (size_t i = gt; i < (size_t)2 * DM * 8; i += NT) {
        const int l = (int)(i / (DM * 8)); const int rr = (int)(i % (DM * 8)); const int row = rr >> 3, ch = rr & 7;
        *(u32x4*)((bf16*)(ws + WS_WF2 + l * WF2_BYTES) + (size_t)row * FFP + DFF + ch * 8) = (u32x4){0u, 0u, 0u, 0u}; }
    for (size_t i = gt; i < (size_t)256 * DM; i += NT) { const int rrow = (int)(i / DM), k = (int)(i % DM);
        ((bf16*)(ws + WS_WABG))[i] = rrow < 72 ? (bf16)f2bf(P.in[3][(size_t)k * AB_W + AB_N + rrow]) : (bf16)0; }
    for (size_t i = gt; i < (size_t)16 * DM; i += NT) { const int rrow = (int)(i / DM), k = (int)(i % DM);
        ((bf16*)(ws + WS_WCG))[i] = (bf16)f2bf(P.in[12][(size_t)k * C_W + C_N + rrow]); }
    for (int m = gw; m < TOK; m += NGW) rms_row_bf16(P.in[0] + (size_t)m * DM, P.in[1], (bf16*)(ws + WS_U) + (size_t)m * DM, lane);
}

template <int NT> __device__ __forceinline__ void skinny_phase(const bf16* A, const bf16* Wt, float* out, int ldo, int ncols) {
    const int tx_ = opaque_tid();
    const int lane = tx_ & 63, gw = blockIdx.x * NWAVES + __builtin_amdgcn_readfirstlane(tx_ >> 6), NGW = gridDim.x * NWAVES;
    const int fr = lane & 15, fq = lane >> 4;
    for (int task = gw; task < TOK / 16; task += NGW) {
        const int t0 = task * 16;
        f32x4 acc[NT];
#pragma unroll
        for (int n = 0; n < NT; ++n) acc[n] = (f32x4){0.f, 0.f, 0.f, 0.f};
        const bf16* ap = A + (size_t)(t0 + fr) * DM + 8 * fq; const bf16* bp = Wt + (size_t)fr * DM + 8 * fq;
#pragma unroll 4
        for (int k0 = 0; k0 < DM; k0 += 32) {
            const bf16x8 a = *(const bf16x8*)(ap + k0);
#pragma unroll
            for (int n = 0; n < NT; ++n) { const bf16x8 b = *(const bf16x8*)(bp + (size_t)n * 16 * DM + k0); acc[n] = __builtin_amdgcn_mfma_f32_16x16x32_bf16(a, b, acc[n], 0, 0, 0); }
        }
#pragma unroll
        for (int n = 0; n < NT; ++n) { const int col = n * 16 + fr; if (col < ncols) {
#pragma unroll
            for (int r = 0; r < 4; ++r) out[(size_t)(t0 + 4 * fq + r) * ldo + col] = acc[n][r]; } }
    }
}

__device__ __forceinline__ void f2_convert_tail(const Ptrs& P, int l, int bidx, int nblk, LAS unsigned char* lds) {
    const int tx_ = opaque_tid();
    const int lane = tx_ & 63, wave = __builtin_amdgcn_readfirstlane(tx_ >> 6);
    LAS float* scr = (LAS float*)(lds + wave * 16384);
    constexpr int IT_F2 = 171 * 128;
    for (int r = bidx * NWAVES + wave; r < IT_F2; r += nblk * NWAVES) { const int kb = r / 128, nb = r % 128;
        tr_item(P.in[21] + (size_t)l * DFF * DM, DM, 64 * kb, 32 * nb, (bf16*)(P.ws + WS_WF2 + l * WF2_BYTES), FFP, 32 * nb, scr, lane); }
}

__device__ __forceinline__ void pool_naive_phase(const bf16* proj, const float* pool_w, const float* pool_scale, bf16* ymix, LAS unsigned char* lds) {
    const int tx_ = opaque_tid();
    const int tid = tx_; LAS float* pl = (LAS float*)lds;
    for (int unit = blockIdx.x; unit < 4096; unit += gridDim.x) {
        const int tt = unit >> 2, g = unit & 3, tok0 = tt * 16, w = 2 << g;
        { const int ti = tid >> 5, c8 = (tid & 31) * 8, tok = tok0 + ti, tpos = tok & (SEQ - 1), cnt = (tpos + 1 < w) ? tpos + 1 : w;
          float sum[8], cur[8];
#pragma unroll
          for (int j = 0; j < 8; ++j) sum[j] = 0.f;
          for (int j = 0; j < cnt; ++j) { float f[8]; unpack8(*(const u32x4*)(proj + (size_t)(tok - j) * AB_N + g * 256 + c8), f);
#pragma unroll
              for (int q = 0; q < 8; ++q) { sum[q] += f[q]; if (j == 0) cur[q] = f[q]; } }
          const float inv = 1.0f / (float)cnt;
#pragma unroll
          for (int q = 0; q < 8; ++q) pl[ti * 256 + c8 + q] = sum[q] * inv - cur[q]; }
        __syncthreads();
        { const int d = tid & 255, half = tid >> 8; float acc[8];
#pragma unroll
          for (int i = 0; i < 8; ++i) acc[i] = 0.f;
          const float* wp = pool_w + (size_t)g * 65536 + d;
          for (int c = 0; c < 256; ++c) { const float wv = wp[(size_t)c * 256];
#pragma unroll
              for (int i = 0; i < 8; ++i) acc[i] += pl[(half * 8 + i) * 256 + c] * wv; }
          const float sc = pool_scale[g * 256 + d];
#pragma unroll
          for (int i = 0; i < 8; ++i) ymix[(size_t)(tok0 + half * 8 + i) * DM + g * 256 + d] = (bf16)f2bf(acc[i] * sc); }
        __syncthreads();
    }
}
__device__ __forceinline__ float gelu_tanh(float x) { const float u = 0.7978845608028654f * (x + 0.044715f * x * x * x); return 0.5f * x * (1.0f + tanhf(u)); }
__device__ __forceinline__ void compress_naive_phase(const bf16* proj, const float* pos, const float* kw1, const float* kw2, const float* vw1, const float* vw2, bf16* kcmp, bf16* vcmp, bf16* vct, LAS unsigned char* lds) {
    const int tx_ = opaque_tid();
    const int tid = tx_;
    LAS float* flat = (LAS float*)lds;
    LAS float* part = flat + 4 * 4096;
    LAS float* hid = part + 2 * 4 * 256;
    for (int unit = blockIdx.x; unit < 2048; unit += gridDim.x) {
        const int which = unit >> 10, b = (unit >> 9) & 1, g = (unit >> 7) & 3, ng = unit & 127;
        const float* w1 = which ? vw1 : kw1; const float* w2 = which ? vw2 : kw2; bf16* outp = which ? vcmp : kcmp;
        const int col0 = (which ? 4608 : 4096) + g * 128;
        for (int i = tid; i < 4 * 4096; i += 512) { const int nn = i >> 12, r = i & 4095, l = r >> 7, d = r & 127, n = 4 * ng + nn;
            float v = 0.f; if (n <= 510) v = bf2f(proj[(size_t)(b * SEQ + 16 * n + l) * AB_N + col0 + d]) + pos[l * 128 + d];
            flat[i] = v; }
        __syncthreads();
        { const int j = tid & 255, ih = tid >> 8; float a0 = 0.f, a1 = 0.f, a2 = 0.f, a3 = 0.f;
          const float* wp = w1 + (size_t)(ih * 2048) * 256 + j; const LAS float* fp = flat + ih * 2048;
          for (int i = 0; i < 2048; ++i) { const float wv = wp[(size_t)i * 256]; a0 += fp[i] * wv; a1 += fp[4096 + i] * wv; a2 += fp[8192 + i] * wv; a3 += fp[12288 + i] * wv; }
          part[(ih * 4 + 0) * 256 + j] = a0; part[(ih * 4 + 1) * 256 + j] = a1; part[(ih * 4 + 2) * 256 + j] = a2; part[(ih * 4 + 3) * 256 + j] = a3; }
        __syncthreads();
        for (int i = tid; i < 1024; i += 512) hid[i] = gelu_tanh(part[i] + part[1024 + i]);
        __syncthreads();
        { const int dd = tid & 127, nn = tid >> 7, n = 4 * ng + nn; float o = 0.f;
          for (int j = 0; j < 256; ++j) o += hid[nn * 256 + j] * w2[j * 128 + dd];
          const bf16 ob = (n <= 510) ? (bf16)f2bf(o) : (bf16)0;
          outp[((size_t)(b * 4 + g) * 512 + n) * 128 + dd] = ob;
          if (which) { const int kap = n & 31, ppos = 8 * ((kap & 15) >> 2) + (kap & 3) + 4 * (kap >> 4); vct[((((size_t)(b * 4 + g) * 16 + (n >> 5)) * 128 + dd) << 5) + ppos] = ob; } }
        __syncthreads();
    }
}

__device__ __forceinline__ void dot6(const bf16* krow, const LAS float* qs, float (&s)[6]) {
#pragma unroll
    for (int h = 0; h < 6; ++h) s[h] = 0.f;
#pragma unroll 4
    for (int c = 0; c < 16; ++c) { float kf[8]; unpack8(*(const u32x4*)(krow + 8 * c), kf);
#pragma unroll
        for (int h = 0; h < 6; ++h) { const f32x4 qa = *(const LAS f32x4*)(qs + h * 128 + 8 * c), qb = *(const LAS f32x4*)(qs + h * 128 + 8 * c + 4);
            s[h] += (kf[0] * qa.x + kf[1] * qa.y) + (kf[2] * qa.z + kf[3] * qa.w) + (kf[4] * qb.x + kf[5] * qb.y) + (kf[6] * qb.z + kf[7] * qb.w); } }
}
__device__ __forceinline__ void attn_block(const bf16* kbase, const bf16* vbase, int pos0, int lo, int hi, const LAS float* qs, LAS float* pb, int lane, float (&m)[6], float (&l)[6], float (&o)[6][2]) {
    const int pos = pos0 + lane; const bool valid = (pos >= lo && pos <= hi);
    float s[6];
    if (valid) dot6(kbase + (size_t)pos * AB_N, qs, s);
#pragma unroll
    for (int h = 0; h < 6; ++h) { const float sv = valid ? s[h] : NEGF; const float bm = wave_max(sv), mn = fmaxf(m[h], bm), alpha = __expf(m[h] - mn), p = valid ? __expf(sv - mn) : 0.f;
        l[h] = l[h] * alpha + wave_sum(p); m[h] = mn; o[h][0] *= alpha; o[h][1] *= alpha; pb[h * 64 + lane] = p; }
    LDS_WAIT();
    const int kmin = (lo - pos0) > 0 ? (lo - pos0) : 0, kmax = (hi - pos0) < 63 ? (hi - pos0) : 63;
    for (int k = kmin; k <= kmax; ++k) { const unsigned v2 = *(const unsigned*)(vbase + (size_t)(pos0 + k) * AB_N + 2 * lane); const float v0 = bf2f(v2 & 0xffffu), v1 = __uint_as_float(v2 & 0xffff0000u);
#pragma unroll
        for (int h = 0; h < 6; ++h) { const float p = pb[h * 64 + k]; o[h][0] += p * v0; o[h][1] += p * v1; } }
    LDS_WAIT();
}
__device__ __forceinline__ void nsa_naive_phase(const bf16* proj, const bf16* kcmp, const bf16* vcmp, const float* glog, bf16* ymix, LAS unsigned char* lds) {
    const int tx_ = opaque_tid();
    const int lane = tx_ & 63, wave = __builtin_amdgcn_readfirstlane(tx_ >> 6);
    LAS float* qs = (LAS float*)(lds + wave * 17536);
    LAS float* sc = qs + 768;
    LAS float* imp = sc + 3072;
    LAS float* pb = imp + 128;
    LAS int* sel = (LAS int*)(pb + 384);
    const int gw = blockIdx.x * NWAVES + wave, NGW = gridDim.x * NWAVES;
    for (int item = gw; item < 65536; item += NGW) {
        const int t = item >> 3, b = (item >> 2) & 1, g = item & 3;
        const size_t tok = (size_t)b * SEQ + t;
        const bf16* prow = proj + tok * AB_N;
#pragma unroll
        for (int j = 0; j < 12; ++j) { const int idx = lane + 64 * j, h = idx >> 7, d = idx & 127; qs[idx] = bf2f(prow[1024 + (g * 6 + h) * 128 + d]) * 0.08838834764831845f; }
        imp[lane] = 0.f; imp[lane + 64] = 0.f;
        LDS_WAIT();
        float oc[6][2];
#pragma unroll
        for (int h = 0; h < 6; ++h) { oc[h][0] = 0.f; oc[h][1] = 0.f; }
        const int ncv = (t >= 31) ? ((t - 31) >> 4) + 1 : 0;
        if (ncv > 0) {
            const bf16* kc = kcmp + (size_t)(b * 4 + g) * 512 * 128; const bf16* vc = vcmp + (size_t)(b * 4 + g) * 512 * 128;
            float mx[6], sm[6];
#pragma unroll
            for (int h = 0; h < 6; ++h) { mx[h] = NEGF; sm[h] = 0.f; }
            for (int n0 = 0; n0 < ncv; n0 += 64) { const int n = n0 + lane; if (n < ncv) { float s[6]; dot6(kc + (size_t)n * 128, qs, s);
#pragma unroll
                for (int h = 0; h < 6; ++h) { sc[h * 512 + n] = s[h]; mx[h] = fmaxf(mx[h], s[h]); } } }
#pragma unroll
            for (int h = 0; h < 6; ++h) mx[h] = wave_max(mx[h]);
            LDS_WAIT();
            for (int n0 = 0; n0 < ncv; n0 += 64) { const int n = n0 + lane; if (n < ncv) {
#pragma unroll
                for (int h = 0; h < 6; ++h) { const float e = __expf(sc[h * 512 + n] - mx[h]); sc[h * 512 + n] = e; sm[h] += e; } } }
#pragma unroll
            for (int h = 0; h < 6; ++h) sm[h] = 1.0f / wave_sum(sm[h]);
            LDS_WAIT();
            for (int n0 = 0; n0 < ncv; n0 += 64) { const int n = n0 + lane; if (n < ncv) {
#pragma unroll
                for (int h = 0; h < 6; ++h) sc[h * 512 + n] *= sm[h]; } }
            LDS_WAIT();
#pragma unroll
            for (int jj = 0; jj < 2; ++jj) { const int j = lane + 64 * jj; float a = 0.f;
#pragma unroll
                for (int i = 0; i < 5; ++i) { const int n = 4 * j - 1 + i; if (n >= 0 && n < ncv) { const float wgt = (i == 0 || i == 4) ? 1.0f : 2.0f;
#pragma unroll
                    for (int h = 0; h < 6; ++h) a += wgt * sc[h * 512 + n]; } }
                imp[j] = a; }
            for (int n = 0; n < ncv; ++n) { const unsigned v2 = *(const unsigned*)(vc + (size_t)n * 128 + 2 * lane); const float v0 = bf2f(v2 & 0xffffu), v1 = __uint_as_float(v2 & 0xffff0000u);
#pragma unroll
                for (int h = 0; h < 6; ++h) { const float p = sc[h * 512 + n]; oc[h][0] += p * v0; oc[h][1] += p * v1; } }
            LDS_WAIT();
        }
        const int cur = t >> 6; int nsel;
        if (cur < 16) { nsel = cur + 1; if (lane < nsel) sel[lane] = lane; }
        else {
            if (lane == 0) { sel[0] = 0; sel[1] = cur - 1; sel[2] = cur; }
            int cnt = 3;
#pragma unroll
            for (int jj = 0; jj < 2; ++jj) { const int j = lane + 64 * jj; const bool cand = (j >= 1 && j <= cur - 2); const float mv = cand ? imp[j] : 0.f; int rank = 0;
                for (int k = 1; k <= cur - 2; ++k) { const float ov = imp[k]; rank += ((ov > mv) || (ov == mv && k < j)) ? 1 : 0; }
                const bool pick = cand && rank < 13;
                const unsigned long long bm = __ballot(pick); const int posi = cnt + __popcll(bm & ((1ull << lane) - 1ull)); if (pick) sel[posi] = j; cnt += __popcll(bm); }
            nsel = cnt;
        }
        LDS_WAIT();
        const bf16* seqbase = proj + (size_t)b * SEQ * AB_N;
        float ms[6], ls[6], os[6][2];
#pragma unroll
        for (int h = 0; h < 6; ++h) { ms[h] = NEGF; ls[h] = 0.f; os[h][0] = 0.f; os[h][1] = 0.f; }
        for (int i = 0; i < nsel; ++i) { const int j = sel[i]; attn_block(seqbase + 5120 + g * 128, seqbase + 5632 + g * 128, 64 * j, 0, t, qs, pb, lane, ms, ls, os); }
        float mw[6], lw[6], ow[6][2];
#pragma unroll
        for (int h = 0; h < 6; ++h) { mw[h] = NEGF; lw[h] = 0.f; ow[h][0] = 0.f; ow[h][1] = 0.f; }
        const int lo = (t - 511) > 0 ? (t - 511) : 0;
        for (int p0 = lo & ~63; p0 <= t; p0 += 64) attn_block(seqbase + 6144 + g * 128, seqbase + 6656 + g * 128, p0, lo, t, qs, pb, lane, mw, lw, ow);
#pragma unroll
        for (int h = 0; h < 6; ++h) { const float* gl = glog + tok * 72 + (g * 6 + h) * 3; const float g0 = sigmoidf_(gl[0] + gl[GLOG_P2]), g1 = sigmoidf_(gl[1] + gl[GLOG_P2 + 1]) / ls[h], g2 = sigmoidf_(gl[2] + gl[GLOG_P2 + 2]) / lw[h];
            const float r0 = g0 * oc[h][0] + g1 * os[h][0] + g2 * ow[h][0], r1 = g0 * oc[h][1] + g1 * os[h][1] + g2 * ow[h][1];
            *(unsigned*)(ymix + tok * DM + 1024 + (g * 6 + h) * 128 + 2 * lane) = pk2(r0, r1); }
    }
}


__device__ __forceinline__ void p2a_phase(const bf16* proj, bf16* pooled, bf16* kcr) {
    const int tx_ = opaque_tid();
    const size_t gt = (size_t)blockIdx.x * 512 + tx_, NT = (size_t)gridDim.x * 512;
    for (size_t it = gt; it < (size_t)TOK * 128; it += NT) {
        const int tok = (int)(it >> 7), chk = (int)(it & 127), g = chk >> 5, c8 = (chk & 31) * 8, w = 2 << g, tpos = tok & (SEQ - 1), cnt = (tpos + 1 < w) ? tpos + 1 : w;
        float sum[8], cur[8];
#pragma unroll
        for (int q = 0; q < 8; ++q) { sum[q] = 0.f; cur[q] = 0.f; }
        for (int j = 0; j < cnt; ++j) { float f[8]; unpack8(*(const u32x4*)(proj + (size_t)(tok - j) * AB_N + g * 256 + c8), f);
#pragma unroll
            for (int q = 0; q < 8; ++q) { sum[q] += f[q]; if (j == 0) cur[q] = f[q]; } }
        const float inv = 1.0f / (float)cnt; u32x4 o;
        o.x = pk2(sum[0] * inv - cur[0], sum[1] * inv - cur[1]); o.y = pk2(sum[2] * inv - cur[2], sum[3] * inv - cur[3]); o.z = pk2(sum[4] * inv - cur[4], sum[5] * inv - cur[5]); o.w = pk2(sum[6] * inv - cur[6], sum[7] * inv - cur[7]);
        *(u32x4*)(pooled + ((size_t)g * TOK + tok) * 256 + c8) = o; }
    for (size_t it = gt; it < (size_t)2 * TOK * 4 * 16; it += NT) {
        const int ch = (int)(it & 15), g = (int)((it >> 4) & 3), tok = (int)((it >> 6) & (TOK - 1)), which = (int)(it >> 20), b = tok >> 13, t = tok & (SEQ - 1);
        *(u32x4*)(kcr + (((size_t)which * 8 + b * 4 + g) * SEQ + t) * 128 + ch * 8) = *(const u32x4*)(proj + (size_t)tok * AB_N + 4096 + which * 512 + g * 128 + ch * 8); }
}
__device__ __forceinline__ void p2c_phase(const float* pcmp, const float* cpart, const float* kw2, const float* vw2, bf16* kcmp, bf16* vct, bf16* kcf, bf16* vcmp_dbg, LAS unsigned char* lds) {
    const int tx_ = opaque_tid();
    const int tid = tx_, G = gridDim.x, half = G >> 1; const bool own = G == 256;
    const int which = own ? (int)(blockIdx.x >> 7) : ((int)blockIdx.x >= half ? 1 : 0), lb = own ? (int)(blockIdx.x >> 3) & 15 : (int)blockIdx.x - which * half;
    const int ustep = own ? 16 : half, uend = own ? 128 : 1022, bgo = (int)(blockIdx.x & 7);
    LAS float* w2s = (LAS float*)lds;
    LAS float* hid = w2s + 256 * 128;
    LAS float* cs = hid + 1024;
    const float* w2 = which ? vw2 : kw2;
    for (int i = tid; i < 256 * 128; i += 512) w2s[i] = w2[i];
    if (tid < 256) { float a = 0.f;
#pragma unroll
        for (int ic = 0; ic < 16; ++ic) a += cpart[(ic * 2 + which) * 256 + tid];
        cs[tid] = a; }
    __syncthreads();
    for (int u = lb; u < uend; u += ustep) {
        for (int i = tid; i < 1024; i += 512) { const int nn = i >> 8, j = i & 255, R = 4 * u + nn, bg = own ? bgo : R / 511, n0 = own ? R : R - bg * 511, n = n0 < 511 ? n0 : 510; const size_t row = (size_t)which * 4096 + bg * 512 + n;
            hid[i] = gelu_tanh(cs[j] + pcmp[row * 512 + j] + pcmp[(row + 1) * 512 + 256 + j]); }
        __syncthreads();
        { const int dd = tid & 127, nn = tid >> 7, R = 4 * u + nn, bg = own ? bgo : R / 511, n = own ? R : R - bg * 511; float o = 0.f;
#pragma unroll 8
          for (int j = 0; j < 256; ++j) o += hid[nn * 256 + j] * w2s[j * 128 + dd];
          const bf16 ob = (bf16)f2bf(o);
          if (n >= 511) { }
          else if (which == 0) { kcmp[((size_t)bg * 512 + n) * 128 + dd] = ob; kcf[((((size_t)(bg * 16 + (n >> 5)) * 2 + ((n >> 4) & 1)) * 4 + (dd >> 5)) * 64 + ((dd >> 3) & 3) * 16 + (n & 15)) * 8 + (dd & 7)] = ob; }
          else { const int kap = n & 31, ppos = 8 * ((kap & 15) >> 2) + (kap & 3) + 4 * (kap >> 4); vct[((((size_t)bg * 16 + (n >> 5)) * 128 + dd) << 5) + ppos] = ob;
              if (vcmp_dbg) vcmp_dbg[((size_t)bg * 512 + n) * 128 + dd] = ob; } }
        __syncthreads();
    }
    if (lb == 0) for (int i = tid; i < (own ? 128 : 8 * 128); i += 512) { const int bg = own ? bgo : i >> 7, dd = i & 127;
        if (which == 0) { kcmp[((size_t)bg * 512 + 511) * 128 + dd] = (bf16)0; kcf[((((size_t)(bg * 16 + 15) * 2 + 1) * 4 + (dd >> 5)) * 64 + ((dd >> 3) & 3) * 16 + 15) * 8 + (dd & 7)] = (bf16)0; } else vct[((((size_t)bg * 16 + 15) * 128 + dd) << 5) + 31] = (bf16)0; }
}

__device__ __forceinline__ void vt_relayout_phase(const bf16* proj, bf16* vts, bf16* vtw, bf16* kfs, bf16* kfw, LAS unsigned char* lds) {
    const int tx_ = opaque_tid();
    const int lane = tx_ & 63, wave = __builtin_amdgcn_readfirstlane(tx_ >> 6);
    LAS bf16* tile = (LAS bf16*)(lds + wave * 8704);
    const int gw = blockIdx.x * NWAVES + wave, NGW = gridDim.x * NWAVES;
    for (int task = gw; task < 4096; task += NGW) {
        const int which = task >> 11, b = (task >> 10) & 1, g = (task >> 8) & 3, step = task & 255;
        const bf16* src = proj + (size_t)(b * SEQ + step * 32) * AB_N + (which ? 6656 : 5632) + g * 128;
#pragma unroll
        for (int i = 0; i < 8; ++i) { const int idx = lane + 64 * i, r = idx >> 4, ch = idx & 15; *(LAS u32x4*)(tile + r * 136 + ch * 8) = *(const u32x4*)(src + (size_t)r * AB_N + ch * 8); }
        LDS_WAIT();
        bf16* dst = (which ? vtw : vts) + (((size_t)(b * 4 + g) * 256 + step) * 128) * 32;
#pragma unroll
        for (int dd = 0; dd < 2; ++dd) { const int d = lane + 64 * dd; unsigned w[16];
#pragma unroll
            for (int pp = 0; pp < 16; ++pp) { const int p0 = 2 * pp, q = p0 >> 3, j = p0 & 7, k0 = (j < 4) ? 4 * q + j : 16 + 4 * q + j - 4;
                w[pp] = (unsigned)tile[k0 * 136 + d] | ((unsigned)tile[(k0 + 1) * 136 + d] << 16); }
#pragma unroll
            for (int c4 = 0; c4 < 4; ++c4) *(u32x4*)(dst + (size_t)d * 32 + c4 * 8) = (u32x4){w[4 * c4], w[4 * c4 + 1], w[4 * c4 + 2], w[4 * c4 + 3]}; }
        LDS_WAIT();
        const bf16* ksrc = proj + (size_t)(b * SEQ + step * 32) * AB_N + (which ? 6144 : 5120) + g * 128;
        bf16* kdst = (which ? kfw : kfs) + ((size_t)(b * 4 + g) * 256 + step) * 4096;
#pragma unroll
        for (int tl = 0; tl < 2; ++tl)
#pragma unroll
            for (int sk = 0; sk < 4; ++sk) *(u32x4*)(kdst + ((tl * 4 + sk) * 64 + lane) * 8) = *(const u32x4*)(ksrc + (size_t)(16 * tl + (lane & 15)) * AB_N + 32 * sk + 8 * (lane >> 4));
    }
}

#define MFMA16(a, b, c) __builtin_amdgcn_mfma_f32_16x16x32_bf16((a), (b), (c), 0, 0, 0)
__device__ __forceinline__ void nsa_qk32(const bf16* k0, size_t tile_stride, const bf16x8 (&qf)[4], int qd, f32x4& s0, f32x4& s1) {
    bf16x8 a0[4], a1[4];
#pragma unroll
    for (int s = 0; s < 4; ++s) { a0[s] = *(const bf16x8*)(k0 + 32 * s + 8 * qd); a1[s] = *(const bf16x8*)(k0 + tile_stride + 32 * s + 8 * qd); }
    s0 = (f32x4){0.f, 0.f, 0.f, 0.f}; s1 = (f32x4){0.f, 0.f, 0.f, 0.f};
#pragma unroll
    for (int s = 0; s < 4; ++s) { s0 = MFMA16(a0[s], qf[s], s0); s1 = MFMA16(a1[s], qf[s], s1); }
}
__device__ __forceinline__ void nsa_pv32(const bf16* vt, int fr, int qd, const bf16x8 pf, f32x4 (&O)[8]) {
#pragma unroll
    for (int dt = 0; dt < 8; ++dt) { const bf16x8 a = *(const bf16x8*)(vt + (size_t)(16 * dt + fr) * 32 + 8 * qd); O[dt] = MFMA16(a, pf, O[dt]); }
}
__device__ __forceinline__ bf16x8 nsa_pack(const float (&p)[8]) {
    u32x4 w; w.x = pg8::cvt_pk_bf16(p[0], p[1]); w.y = pg8::cvt_pk_bf16(p[2], p[3]); w.z = pg8::cvt_pk_bf16(p[4], p[5]); w.w = pg8::cvt_pk_bf16(p[6], p[7]);
    return __builtin_bit_cast(bf16x8, w);
}
__device__ __forceinline__ void nsa_step(const bf16* k0, size_t tile_stride, const bf16* vt, const bf16x8 (&qf)[4], int fr, int qd, int pos0, int lo, int hi, bool en, float& m, float& l, f32x4 (&O)[8]) {
    constexpr float SC = 0.08838834764831845f * 1.4426950408889634f;
    f32x4 s0, s1; nsa_qk32(k0, tile_stride, qf, qd, s0, s1);
    float x[8]; bool v[8]; float lm = NEGF;
#pragma unroll
    for (int i = 0; i < 8; ++i) { const int pos = pos0 + 16 * (i >> 2) + 4 * qd + (i & 3); v[i] = en && pos >= lo && pos <= hi; x[i] = ((i < 4) ? s0[i & 3] : s1[i & 3]) * SC; lm = v[i] ? fmaxf(lm, x[i]) : lm; }
    lm = fmaxf(lm, __shfl_xor(lm, 16)); lm = fmaxf(lm, __shfl_xor(lm, 32));
    if (__any(lm > m + 8.0f)) { const float mn = fmaxf(m, lm), alpha = __builtin_amdgcn_exp2f(m - mn); l *= alpha; m = mn;
#pragma unroll
        for (int dt = 0; dt < 8; ++dt) O[dt] *= alpha; }
    float p[8]; float ps = 0.f;
#pragma unroll
    for (int i = 0; i < 8; ++i) { p[i] = v[i] ? __builtin_amdgcn_exp2f(x[i] - m) : 0.f; ps += p[i]; }
    l += ps;
    nsa_pv32(vt, fr, qd, nsa_pack(p), O);
}
__device__ __forceinline__ void nsa_fast_phase(const bf16* proj, const bf16* kcmp, const bf16* vct, const bf16* vts, const bf16* vtw, const float* glog, bf16* ymix, LAS unsigned char* lds) {
    const int tx_ = opaque_tid();
    constexpr float SC = 0.08838834764831845f * 1.4426950408889634f;
    const int lane = tx_ & 63, wave = __builtin_amdgcn_readfirstlane(tx_ >> 6), fr = lane & 15, qd = lane >> 4;
    LAS float* imp = (LAS float*)(lds + wave * 2048);
    const int gw = blockIdx.x * NWAVES + wave, NGW = gridDim.x * NWAVES;
    const int qi = fr >= 6 ? 1 : 0, hd = fr - 6 * qi; const bool cv = fr < 12;
    for (int item = gw; item < 32768; item += NGW) {
        const int tp = item >> 3, b = (item >> 2) & 1, g = item & 3, tA = 2 * tp, tB = tA + 1, tq = tA + qi;
        const size_t tokq = (size_t)b * SEQ + tq; const int bg = b * 4 + g;
        bf16x8 qf[4];
#pragma unroll
        for (int s = 0; s < 4; ++s) qf[s] = cv ? *(const bf16x8*)(proj + tokq * AB_N + 1024 + (g * 6 + hd) * 128 + 32 * s + 8 * qd) : (bf16x8){0, 0, 0, 0, 0, 0, 0, 0};
        float gt0 = 0.f, gt1 = 0.f, gt2 = 0.f;
        if (cv) { const float* gl = glog + tokq * 72 + (g * 6 + hd) * 3; gt0 = sigmoidf_(gl[0] + gl[GLOG_P2]); gt1 = sigmoidf_(gl[1] + gl[GLOG_P2 + 1]); gt2 = sigmoidf_(gl[2] + gl[GLOG_P2 + 2]); }
        f32x4 outacc[8];
#pragma unroll
        for (int dt = 0; dt < 8; ++dt) outacc[dt] = (f32x4){0.f, 0.f, 0.f, 0.f};
        for (int i = lane; i < 272; i += 64) imp[i] = 0.f;
        LDS_WAIT();
        const int ncvB = (tB >= 31) ? ((tB - 31) >> 4) + 1 : 0;
        const int ncvq = cv ? ((tq >= 31) ? ((tq - 31) >> 4) + 1 : 0) : 0;
        if (ncvB > 0) {
            const bf16* kc = kcmp + (size_t)bg * 512 * 128 + (size_t)fr * 128;
            float m = NEGF, l = 0.f;
            for (int n0 = 0; n0 < ncvB; n0 += 32) {
                f32x4 s0, s1; nsa_qk32(kc + (size_t)n0 * 128, 16 * 128, qf, qd, s0, s1);
                float x[8]; bool v[8]; float lm = NEGF;
#pragma unroll
                for (int i = 0; i < 8; ++i) { const int n = n0 + 16 * (i >> 2) + 4 * qd + (i & 3); v[i] = n < ncvq; x[i] = ((i < 4) ? s0[i & 3] : s1[i & 3]) * SC; lm = v[i] ? fmaxf(lm, x[i]) : lm; }
                lm = fmaxf(lm, __shfl_xor(lm, 16)); lm = fmaxf(lm, __shfl_xor(lm, 32));
                if (__any(lm > m + 8.0f)) { const float mn = fmaxf(m, lm); l *= __builtin_amdgcn_exp2f(m - mn); m = mn; }
#pragma unroll
                for (int i = 0; i < 8; ++i) l += v[i] ? __builtin_amdgcn_exp2f(x[i] - m) : 0.f;
            }
            l += __shfl_xor(l, 16); l += __shfl_xor(l, 32);
            const float invl = l > 0.f ? 1.0f / l : 0.f;
            f32x4 O[8];
#pragma unroll
            for (int dt = 0; dt < 8; ++dt) O[dt] = (f32x4){0.f, 0.f, 0.f, 0.f};
            for (int n0 = 0; n0 < ncvB; n0 += 32) {
                f32x4 s0, s1; nsa_qk32(kc + (size_t)n0 * 128, 16 * 128, qf, qd, s0, s1);
                float p[8];
#pragma unroll
                for (int i = 0; i < 8; ++i) { const int n = n0 + 16 * (i >> 2) + 4 * qd + (i & 3); const float xv = ((i < 4) ? s0[i & 3] : s1[i & 3]) * SC; p[i] = (n < ncvq) ? __builtin_amdgcn_exp2f(xv - m) * invl : 0.f; }
                if (cv) {
#pragma unroll
                    for (int tl = 0; tl < 2; ++tl) { const int j = ((n0 + 16 * tl) >> 2) + qd; const float a = 2.0f * (p[4 * tl] + p[4 * tl + 1] + p[4 * tl + 2]) + p[4 * tl + 3];
                        __hip_atomic_fetch_add(imp + qi * 136 + j, a, __ATOMIC_RELAXED, __HIP_MEMORY_SCOPE_WORKGROUP); __hip_atomic_fetch_add(imp + qi * 136 + j + 1, p[4 * tl + 3], __ATOMIC_RELAXED, __HIP_MEMORY_SCOPE_WORKGROUP); } }
                nsa_pv32(vct + (((size_t)bg * 16 + (n0 >> 5)) * 128) * 32, fr, qd, nsa_pack(p), O);
            }
#pragma unroll
            for (int dt = 0; dt < 8; ++dt) outacc[dt] += gt0 * O[dt];
        }
        LDS_WAIT();
        unsigned long long mA0, mA1, mB0, mB1;
#pragma unroll
        for (int qq = 0; qq < 2; ++qq) { const int t = tA + qq, cur = t >> 6; unsigned long long s0m, s1m;
            if (cur < 16) { s0m = (2ull << cur) - 1ull; s1m = 0ull; }
            else { const LAS float* im = imp + qq * 136; const int j0 = lane, j1 = lane + 64; const bool c0 = (j0 >= 1 && j0 <= cur - 2), c1 = (j1 <= cur - 2);
                const float v0 = im[j0], v1 = im[j1]; int r0 = 0, r1 = 0;
                for (int k = 1; k <= cur - 2; ++k) { const float ov = im[k]; r0 += ((ov > v0) || (ov == v0 && k < j0)) ? 1 : 0; r1 += ((ov > v1) || (ov == v1 && k < j1)) ? 1 : 0; }
                s0m = __ballot(c0 && r0 < 13); s1m = __ballot(c1 && r1 < 13);
                s0m |= 1ull; { const int f1 = cur - 1; if (f1 < 64) s0m |= 1ull << f1; else s1m |= 1ull << (f1 - 64); if (cur < 64) s0m |= 1ull << cur; else s1m |= 1ull << (cur - 64); } }
            if (qq == 0) { mA0 = s0m; mA1 = s1m; } else { mB0 = s0m; mB1 = s1m; } }
        const unsigned long long my0 = qi ? mB0 : mA0, my1 = qi ? mB1 : mA1;
        const bf16* seqk = proj + (size_t)b * SEQ * AB_N + (size_t)fr * AB_N + g * 128;
        { float m = NEGF, l = 0.f; f32x4 O[8];
#pragma unroll
          for (int dt = 0; dt < 8; ++dt) O[dt] = (f32x4){0.f, 0.f, 0.f, 0.f};
          const int hiq = cv ? tq : -1;
#pragma unroll
          for (int w = 0; w < 2; ++w) { unsigned long long u = w ? (mA1 | mB1) : (mA0 | mB0); const unsigned long long mine = w ? my1 : my0;
              while (u) { const int bit = __ffsll((long long)u) - 1; u &= u - 1ull; const int j = 64 * w + bit; const bool en = (mine >> bit) & 1ull;
#pragma unroll
                  for (int hf = 0; hf < 2; ++hf) { const int pos0 = 64 * j + 32 * hf; if (pos0 > tB) break;
                      nsa_step(seqk + (size_t)pos0 * AB_N + 5120, (size_t)16 * AB_N, vts + (((size_t)bg * 256 + (pos0 >> 5)) * 128) * 32, qf, fr, qd, pos0, 0, hiq, en, m, l, O); } } }
          l += __shfl_xor(l, 16); l += __shfl_xor(l, 32);
          const float cf = l > 0.f ? gt1 / l : 0.f;
#pragma unroll
          for (int dt = 0; dt < 8; ++dt) outacc[dt] += cf * O[dt]; }
        { float m = NEGF, l = 0.f; f32x4 O[8];
#pragma unroll
          for (int dt = 0; dt < 8; ++dt) O[dt] = (f32x4){0.f, 0.f, 0.f, 0.f};
          const int hiq = cv ? tq : -1, loq = tq - 511; const int lo0 = (tA - 511) > 0 ? (tA - 511) : 0;
          for (int pos0 = lo0 & ~31; pos0 <= tB; pos0 += 32)
              nsa_step(seqk + (size_t)pos0 * AB_N + 6144, (size_t)16 * AB_N, vtw + (((size_t)bg * 256 + (pos0 >> 5)) * 128) * 32, qf, fr, qd, pos0, loq, hiq, true, m, l, O);
          l += __shfl_xor(l, 16); l += __shfl_xor(l, 32);
          const float cf = l > 0.f ? gt2 / l : 0.f;
#pragma unroll
          for (int dt = 0; dt < 8; ++dt) outacc[dt] += cf * O[dt]; }
        if (cv) { bf16* op = ymix + tokq * DM + 1024 + (g * 6 + hd) * 128 + 4 * qd;
#pragma unroll
            for (int dt = 0; dt < 8; ++dt) { u32x2 w; w.x = pk2(outacc[dt][0], outacc[dt][1]); w.y = pk2(outacc[dt][2], outacc[dt][3]); *(u32x2*)(op + 16 * dt) = w; } }
    }
}

struct NsaCtx { const bf16* kb; const bf16* vb; int klane, vlane, p0, lo, hi, qi; const LAS int* list; };
template <int BR> __device__ __forceinline__ void nsa_desc(const NsaCtx& X, int i, int& pos0, bool& en) {
    if (BR == 2) { const int e = __builtin_amdgcn_readfirstlane(X.list[i]); pos0 = e & 0xffff; en = ((e >> (30 + X.qi)) & 1) != 0; } else { pos0 = X.p0 + 32 * i; en = true; }
}
template <int BR> __device__ __forceinline__ void nsa_load(const NsaCtx& X, int i, int n, bf16x8 (&k0)[4], bf16x8 (&k1)[4], bf16x8 (&vf)[8]) {
    int pos0; bool en; nsa_desc<BR>(X, i < n ? i : n - 1, pos0, en);
    int kl = X.klane, vl = X.vlane; asm volatile("" : "+v"(kl), "+v"(vl));
    const bf16* kp = X.kb + (size_t)(pos0 >> 5) * 4096;
    const int kl1 = kl + 2048;
#pragma unroll
    for (int s = 0; s < 4; ++s) { k0[s] = *(const bf16x8*)(kp + (kl + 512 * s)); k1[s] = *(const bf16x8*)(kp + (kl1 + 512 * s)); }
    if (BR != 0) { const bf16* vp = X.vb + (size_t)(pos0 >> 5) * 4096;
        const int vl1 = vl + 2048;
#pragma unroll
        for (int dt = 0; dt < 4; ++dt) { vf[dt] = *(const bf16x8*)(vp + (vl + dt * 512)); vf[dt + 4] = *(const bf16x8*)(vp + (vl1 + dt * 512)); } }
}
template <int BR> __device__ __forceinline__ void nsa_compute(const NsaCtx& X, int i, int n, int fr, int qd, bool cv, const LAS bf16x8* qfl, const bf16x8 (&k0)[4], const bf16x8 (&k1)[4], const bf16x8 (&vf)[8],
                                                             float& m, float& l, f32x4 (&O)[8], LAS float* imp) {
    constexpr float SC = 0.08838834764831845f * 1.4426950408889634f;
    int pos0; bool en; nsa_desc<BR>(X, i < n ? i : n - 1, pos0, en); en = en && (i < n);
    f32x4 s0 = (f32x4){0.f, 0.f, 0.f, 0.f}, s1 = (f32x4){0.f, 0.f, 0.f, 0.f};
#pragma unroll
    for (int s = 0; s < 4; ++s) { const bf16x8 qv = qfl[s * 64]; s0 = MFMA16(k0[s], qv, s0); s1 = MFMA16(k1[s], qv, s1); }
    float x[8]; bool v[8]; float lm = NEGF;
#pragma unroll
    for (int e = 0; e < 8; ++e) { const int pos = pos0 + 16 * (e >> 2) + 4 * qd + (e & 3); v[e] = en && pos >= X.lo && pos <= X.hi; x[e] = ((e < 4) ? s0[e & 3] : s1[e & 3]) * SC; lm = v[e] ? fmaxf(lm, x[e]) : lm; }
    float p[8];
    if (BR == 1) {
#pragma unroll
        for (int e = 0; e < 8; ++e) p[e] = v[e] ? __builtin_amdgcn_exp2f(x[e] - m) * l : 0.f;
        if (cv) {
#pragma unroll
            for (int tl = 0; tl < 2; ++tl) { const int j = ((pos0 + 16 * tl) >> 2) + qd; const float a = 2.0f * (p[4 * tl] + p[4 * tl + 1] + p[4 * tl + 2]) + p[4 * tl + 3];
                __hip_atomic_fetch_add(imp + X.qi * 136 + j, a, __ATOMIC_RELAXED, __HIP_MEMORY_SCOPE_WORKGROUP); __hip_atomic_fetch_add(imp + X.qi * 136 + j + 1, p[4 * tl + 3], __ATOMIC_RELAXED, __HIP_MEMORY_SCOPE_WORKGROUP); } }
    } else {
        lm = fmaxf(lm, __shfl_xor(lm, 16)); lm = fmaxf(lm, __shfl_xor(lm, 32));
        if (__any(lm > m + 8.0f)) { const float mn = fmaxf(m, lm), alpha = __builtin_amdgcn_exp2f(m - mn); l *= alpha; m = mn;
            if (BR != 0) {
#pragma unroll
                for (int dt = 0; dt < 8; ++dt) O[dt] *= alpha; } }
        float ps = 0.f;
#pragma unroll
        for (int e = 0; e < 8; ++e) { p[e] = v[e] ? __builtin_amdgcn_exp2f(x[e] - m) : 0.f; ps += p[e]; }
        l += ps;
    }
    if (BR != 0) { const bf16x8 pf = nsa_pack(p);
#pragma unroll
        for (int dt = 0; dt < 8; ++dt) O[dt] = MFMA16(vf[dt], pf, O[dt]); }
}
template <int BR> __device__ __forceinline__ void nsa_run(const NsaCtx& X, int n, int fr, int qd, bool cv, const LAS bf16x8* qfl, float& m, float& l, f32x4 (&O)[8], LAS float* imp) {
    bf16x8 ka[2][4], kb[2][4], vf[2][8];
    if (n <= 0) return;
    nsa_load<BR>(X, 0, n, ka[0], kb[0], vf[0]);
#pragma unroll 1
    for (int i0 = 0; i0 < n; i0 += 2) {
        nsa_load<BR>(X, i0 + 1, n, ka[1], kb[1], vf[1]);
        nsa_compute<BR>(X, i0, n, fr, qd, cv, qfl, ka[0], kb[0], vf[0], m, l, O, imp);
        nsa_load<BR>(X, i0 + 2, n, ka[0], kb[0], vf[0]);
        nsa_compute<BR>(X, i0 + 1, n, fr, qd, cv, qfl, ka[1], kb[1], vf[1], m, l, O, imp);
    }
}
__device__ __forceinline__ void nsa_acc_out(LAS float* ol, int fr, int qd, const f32x4 (&O)[8], float cf, bool first) {
#pragma unroll
    for (int dt = 0; dt < 8; ++dt) { LAS f32x4* pp = (LAS f32x4*)(ol + fr * 132 + 16 * dt + 4 * qd); f32x4 vv = O[dt] * cf; if (!first) vv += *pp; *pp = vv; }
}
__device__ __forceinline__ void nsa_fast2_phase(const bf16* proj, const bf16* kcf, const bf16* vct, const bf16* kfs, const bf16* vts, const bf16* kfw, const bf16* vtw, const float* glog, bf16* ymix, LAS unsigned char* lds) {
    const int tx_ = opaque_tid();
    const int lane = tx_ & 63, wave = __builtin_amdgcn_readfirstlane(tx_ >> 6), fr = lane & 15, qd = lane >> 4;
    LAS float* imp = (LAS float*)(lds + wave * 14592);
    LAS int* list = (LAS int*)(imp + 272);
    LAS float* ol = imp + 512;
    LAS bf16x8* qfl = (LAS bf16x8*)(lds + wave * 14592 + 10496) + lane;
    const int gw = blockIdx.x * NWAVES + wave, NGW = gridDim.x * NWAVES;
    const int qi = fr >= 6 ? 1 : 0, hd = fr - 6 * qi; const bool cv = fr < 12;
    const bool xmap = (gridDim.x & 7) == 0;
    const int nI = xmap ? 4096 : 32768, i_lo = xmap ? (int)(blockIdx.x >> 3) * NWAVES + wave : gw, i_st = xmap ? (int)(gridDim.x >> 3) * NWAVES : NGW;
    for (int item = i_lo; item < nI; item += i_st) {
        const int tp = xmap ? item : (item >> 3), bgi = xmap ? (int)(blockIdx.x & 7) : (item & 7), b = bgi >> 2, g = bgi & 3, tA = 2 * tp, tB = tA + 1, tq = tA + qi;
        if (xmap) { asm volatile("s_waitcnt lgkmcnt(0)" ::: "memory"); __builtin_amdgcn_s_barrier(); }
        const size_t tokq = (size_t)b * SEQ + tq; const int bg = b * 4 + g;
#pragma unroll
        for (int s = 0; s < 4; ++s) qfl[s * 64] = cv ? *(const bf16x8*)(proj + tokq * AB_N + 1024 + (g * 6 + hd) * 128 + 32 * s + 8 * qd) : (bf16x8){0, 0, 0, 0, 0, 0, 0, 0};
        float gt0 = 0.f, gt1 = 0.f, gt2 = 0.f;
        if (cv) { const float* gl = glog + tokq * 72 + (g * 6 + hd) * 3; gt0 = sigmoidf_(gl[0] + gl[GLOG_P2]); gt1 = sigmoidf_(gl[1] + gl[GLOG_P2 + 1]); gt2 = sigmoidf_(gl[2] + gl[GLOG_P2 + 2]); }
        for (int i = lane; i < 272; i += 64) imp[i] = 0.f;
        LDS_WAIT();
        NsaCtx X; X.qi = qi; X.list = list; X.vlane = fr * 32 + 8 * qd; X.klane = lane * 8;
        const int ncvB = (tB >= 31) ? ((tB - 31) >> 4) + 1 : 0;
        const int ncvq = cv ? ((tq >= 31) ? ((tq - 31) >> 4) + 1 : 0) : 0;
        { f32x4 O[8];
#pragma unroll
          for (int dt = 0; dt < 8; ++dt) O[dt] = (f32x4){0.f, 0.f, 0.f, 0.f};
          if (ncvB > 0) {
              X.kb = kcf + (size_t)bg * 16 * 4096; X.vb = vct + (size_t)bg * 16 * 4096; X.p0 = 0; X.lo = 0; X.hi = ncvq - 1;
              const int nst = (ncvB + 31) >> 5;
              float m = NEGF, l = 0.f;
              nsa_run<0>(X, nst, fr, qd, cv, qfl, m, l, O, imp);
              l += __shfl_xor(l, 16); l += __shfl_xor(l, 32);
              float invl = l > 0.f ? 1.0f / l : 0.f;
              nsa_run<1>(X, nst, fr, qd, cv, qfl, m, invl, O, imp);
          }
          nsa_acc_out(ol, fr, qd, O, gt0, true); }
        LDS_WAIT();
        { float m = NEGF, l = 0.f; f32x4 O[8];
#pragma unroll
          for (int dt = 0; dt < 8; ++dt) O[dt] = (f32x4){0.f, 0.f, 0.f, 0.f};
          const int lo0 = (tA - 511) > 0 ? (tA - 511) : 0, st0 = lo0 & ~31;
          X.kb = kfw + (size_t)bg * 256 * 4096; X.vb = vtw + (size_t)bg * 256 * 4096; X.p0 = st0; X.lo = tq - 511; X.hi = cv ? tq : -1;
          nsa_run<3>(X, ((tB - st0) >> 5) + 1, fr, qd, cv, qfl, m, l, O, imp);
          l += __shfl_xor(l, 16); l += __shfl_xor(l, 32);
          nsa_acc_out(ol, fr, qd, O, l > 0.f ? gt2 / l : 0.f, false); }
        LDS_WAIT();
        unsigned long long mA0, mA1, mB0, mB1;
#pragma unroll
        for (int qq = 0; qq < 2; ++qq) { const int t = tA + qq, cur = t >> 6; unsigned long long s0m, s1m;
            if (cur < 16) { s0m = (2ull << cur) - 1ull; s1m = 0ull; }
            else { LAS float* im = imp + qq * 136; const int j0 = lane, j1 = lane + 64; const bool c0 = (j0 >= 1 && j0 <= cur - 2), c1 = (j1 <= cur - 2);
                const float v0 = im[j0], v1 = im[j1]; int r0 = 0, r1 = 0;
                LDS_WAIT();
                if (lane == 0) im[0] = 0.f;
                if (lane == 1) { im[cur - 1] = 0.f; im[cur] = 0.f; }
                LDS_WAIT();
                { const unsigned b0 = c0 ? __float_as_uint(v0) : 0xffffffffu, b1 = c1 ? __float_as_uint(v1) : 0xffffffffu;
#pragma unroll 2
                  for (int k = 0; k <= cur - 2; k += 8) { const u32x4 a = *(const LAS u32x4*)(im + k), b = *(const LAS u32x4*)(im + k + 4);
                      r0 += (a.x > b0 ? 1 : 0) + (a.y > b0 ? 1 : 0) + (a.z > b0 ? 1 : 0) + (a.w > b0 ? 1 : 0) + (b.x > b0 ? 1 : 0) + (b.y > b0 ? 1 : 0) + (b.z > b0 ? 1 : 0) + (b.w > b0 ? 1 : 0);
                      r1 += (a.x > b1 ? 1 : 0) + (a.y > b1 ? 1 : 0) + (a.z > b1 ? 1 : 0) + (a.w > b1 ? 1 : 0) + (b.x > b1 ? 1 : 0) + (b.y > b1 ? 1 : 0) + (b.z > b1 ? 1 : 0) + (b.w > b1 ? 1 : 0); } }
                s0m = __ballot(c0 && r0 < 13); s1m = __ballot(c1 && r1 < 13);
                const int ncand = cur - 2;
                if (__popcll(s0m) + __popcll(s1m) != (ncand < 13 ? ncand : 13)) { r0 = 0; r1 = 0;
                    for (int k = 1; k <= cur - 2; ++k) { const float ov = im[k]; r0 += ((ov > v0) || (ov == v0 && k < j0)) ? 1 : 0; r1 += ((ov > v1) || (ov == v1 && k < j1)) ? 1 : 0; }
                    s0m = __ballot(c0 && r0 < 13); s1m = __ballot(c1 && r1 < 13); }
                s0m |= 1ull; { const int f1 = cur - 1; if (f1 < 64) s0m |= 1ull << f1; else s1m |= 1ull << (f1 - 64); if (cur < 64) s0m |= 1ull << cur; else s1m |= 1ull << (cur - 64); } }
            if (qq == 0) { mA0 = s0m; mA1 = s1m; } else { mB0 = s0m; mB1 = s1m; } }
        const unsigned long long U0 = mA0 | mB0, U1 = mA1 | mB1; const int nU0 = __popcll(U0), nsel = 2 * (nU0 + __popcll(U1));
#pragma unroll
        for (int w = 0; w < 2; ++w) { const unsigned long long U = w ? U1 : U0, mAw = w ? mA1 : mA0, mBw = w ? mB1 : mB0;
            if ((U >> lane) & 1ull) { const int idx = (w ? nU0 : 0) + __popcll(U & ((1ull << lane) - 1ull)), j = 64 * w + lane;
                const int fl = (int)(((mAw >> lane) & 1ull) << 30) | (int)(((mBw >> lane) & 1ull) << 31);
                list[2 * idx] = (64 * j) | fl; list[2 * idx + 1] = (64 * j + 32) | ((64 * j + 32 <= tB) ? fl : 0); } }
        LDS_WAIT();
        { float m = NEGF, l = 0.f; f32x4 O[8];
#pragma unroll
          for (int dt = 0; dt < 8; ++dt) O[dt] = (f32x4){0.f, 0.f, 0.f, 0.f};
          X.kb = kfs + (size_t)bg * 256 * 4096; X.vb = vts + (size_t)bg * 256 * 4096; X.p0 = 0; X.lo = 0; X.hi = cv ? tq : -1;
          nsa_run<2>(X, nsel, fr, qd, cv, qfl, m, l, O, imp);
          l += __shfl_xor(l, 16); l += __shfl_xor(l, 32);
          nsa_acc_out(ol, fr, qd, O, l > 0.f ? gt1 / l : 0.f, false); }
        if (cv) { bf16* op = ymix + tokq * DM + 1024 + (g * 6 + hd) * 128 + 4 * qd;
#pragma unroll
            for (int dt = 0; dt < 8; ++dt) { const f32x4 o = *(const LAS f32x4*)(ol + fr * 132 + 16 * dt + 4 * qd); u32x2 w; w.x = pk2(o[0], o[1]); w.y = pk2(o[2], o[3]); *(u32x2*)(op + 16 * dt) = w; } }
    }
}

__device__ __forceinline__ void act_phase(const bf16* G, const bf16* U2, const float* cw, const float* cb, bf16* act) {
    const int tx_ = opaque_tid();
    constexpr int CPR = FFP / 8, RB = 16, NRB = TOK / RB;
    const int gt = blockIdx.x * 512 + tx_, NT = gridDim.x * 512;
    for (int item = gt; item < NRB * CPR; item += NT) {
        const int rb = item / CPR, ch = item - rb * CPR, f8 = ch * 8, row0 = rb * RB; size_t off = (size_t)row0 * FFP + f8;
        if (f8 >= DFF) {
#pragma unroll
            for (int r = 0; r < RB; ++r) *(u32x4*)(act + off + (size_t)r * FFP) = (u32x4){0u, 0u, 0u, 0u};
            continue; }
        float w0[8], w1[8], w2[8], bb[8];
        { const f32x4 a0 = *(const f32x4*)(cw + f8), a1 = *(const f32x4*)(cw + f8 + 4), b0 = *(const f32x4*)(cw + DFF + f8), b1 = *(const f32x4*)(cw + DFF + f8 + 4), c0 = *(const f32x4*)(cw + 2 * DFF + f8), c1 = *(const f32x4*)(cw + 2 * DFF + f8 + 4), d0 = *(const f32x4*)(cb + f8), d1 = *(const f32x4*)(cb + f8 + 4);
#pragma unroll
          for (int j = 0; j < 4; ++j) { w0[j] = a0[j]; w0[j + 4] = a1[j]; w1[j] = b0[j]; w1[j + 4] = b1[j]; w2[j] = c0[j]; w2[j + 4] = c1[j]; bb[j] = d0[j]; bb[j + 4] = d1[j]; } }
        float g1[8], g2[8];
        const int tpos0 = row0 & (SEQ - 1);
        if (tpos0 >= 2) { unpack8(*(const u32x4*)(G + off - FFP), g1); unpack8(*(const u32x4*)(G + off - 2 * FFP), g2); }
        else {
#pragma unroll
            for (int j = 0; j < 8; ++j) { g1[j] = 0.f; g2[j] = 0.f; } }
#pragma unroll 4
        for (int r = 0; r < RB; ++r) {
            float g0[8], up[8]; unpack8(*(const u32x4*)(G + off), g0); unpack8(*(const u32x4*)(U2 + off), up);
            float o[8];
#pragma unroll
            for (int j = 0; j < 8; ++j) { const float x = bb[j] + w0[j] * g0[j] + w1[j] * g1[j] + w2[j] * g2[j]; o[j] = x * sigmoidf_(x) * up[j]; g2[j] = g1[j]; g1[j] = g0[j]; }
            u32x4 w; w.x = pk2(o[0], o[1]); w.y = pk2(o[2], o[3]); w.z = pk2(o[4], o[5]); w.w = pk2(o[6], o[7]);
            *(u32x4*)(act + off) = w; off += FFP;
        }
    }
}


__device__ __forceinline__ void act_fix_phase(const bf16* side, const float* cw, const float* cb, bf16* act) {
    const int tx_ = opaque_tid();
    constexpr int CPR = FFP / 8;
    const int gt = blockIdx.x * 512 + tx_, NT = gridDim.x * 512;
    const bool own = gridDim.x == 256; const int lt = (int)(blockIdx.x >> 3) * 512 + tx_, kx = 32 * (int)(blockIdx.x & 7);
    for (int item0 = own ? lt : gt; item0 < (own ? 32 : 256) * 2 * CPR; item0 += own ? 32 * 512 : NT) {
        const int ch = item0 % CPR, kr = item0 / CPR, rho = kr & 1, k = (kr >> 1) + (own ? kx : 0), f8 = ch * 8, t = 64 * k + rho, tpos = t & (SEQ - 1);
        const size_t off = (size_t)t * FFP + f8;
        if (f8 >= DFF) { *(u32x4*)(act + off) = (u32x4){0u, 0u, 0u, 0u}; continue; }
        float g0[8], g1[8], g2[8], up[8];
        const bf16* sk = side + ((size_t)(k * 4) * 2) * FFP + f8;
        unpack8(*(const u32x4*)(sk + (size_t)(rho * 2) * FFP), g0); unpack8(*(const u32x4*)(sk + (size_t)(rho * 2 + 1) * FFP), up);
        const bool hasprev = tpos >= 2 || (rho == 1);
#pragma unroll
        for (int j = 0; j < 8; ++j) { g1[j] = 0.f; g2[j] = 0.f; }
        if (rho == 1) { unpack8(*(const u32x4*)sk, g1); if (tpos >= 2) unpack8(*(const u32x4*)(sk - (size_t)8 * FFP + (size_t)(3 * 2) * FFP), g2); }
        else if (tpos >= 2) { unpack8(*(const u32x4*)(sk - (size_t)8 * FFP + (size_t)(3 * 2) * FFP), g1); unpack8(*(const u32x4*)(sk - (size_t)8 * FFP + (size_t)(2 * 2) * FFP), g2); }
        (void)hasprev;
        float r[8];
#pragma unroll
        for (int j = 0; j < 8; ++j) { const int f = f8 + j; const float x = cb[f] + cw[f] * g0[j] + cw[DFF + f] * g1[j] + cw[2 * DFF + f] * g2[j]; r[j] = x * sigmoidf_(x) * up[j]; }
        u32x4 w; w.x = pk2(r[0], r[1]); w.y = pk2(r[2], r[3]); w.z = pk2(r[4], r[5]); w.w = pk2(r[6], r[7]);
        *(u32x4*)(act + off) = w;
    }
}

__device__ __forceinline__ void mlstm_naive_phase(const bf16* projc, const float* gif, const float* bif, float* hout, LAS unsigned char* lds) {
    const int tx_ = opaque_tid();
    constexpr int QS = 264;
    const int tid = tx_, lane = tid & 63;
    LAS bf16* qs = (LAS bf16*)lds;
    LAS bf16* ks = qs + 64 * QS;
    LAS float* vsl = (LAS float*)(lds + 67584);
    LAS float* Cs = vsl + 2048;
    LAS float* ns = Cs + 256 * 36;
    LAS float* wq = ns + 256;
    LAS float* bb = wq + 64 * 65; LAS float* gi = bb + 64; LAS float* mt = gi + 64; LAS float* inter = mt + 64; LAS float* ksc = inter + 64; LAS float* dd = ksc + 64; LAS float* sca = dd + 64;
    for (int unit = blockIdx.x; unit < 256; unit += gridDim.x) {
        const int b = unit >> 7, h = (unit >> 4) & 7, es = unit & 15;
        for (int i = tid; i < 256 * 36; i += 512) Cs[i] = 0.f;
        if (tid < 256) ns[tid] = 0.f;
        if (tid == 0) sca[0] = 0.f;
        __syncthreads();
        for (int c = 0; c < 128; ++c) {
            const size_t tok0 = (size_t)b * SEQ + 64 * c;
#pragma unroll
            for (int i = 0; i < 4; ++i) { const int idx = tid + 512 * i, r = idx >> 5, ch = idx & 31; const bf16* src = projc + (tok0 + r) * C_N + h * 256 + ch * 8;
                *(LAS u32x4*)(qs + r * QS + ch * 8) = *(const u32x4*)src; *(LAS u32x4*)(ks + r * QS + ch * 8) = *(const u32x4*)(src + 2048); }
            if (tid < 256) { const int r = tid >> 2, q4 = tid & 3; float f[8]; unpack8(*(const u32x4*)(projc + (tok0 + r) * C_N + 4096 + h * 512 + es * 32 + q4 * 8), f);
#pragma unroll
                for (int j = 0; j < 8; ++j) vsl[r * 32 + q4 * 8 + j] = f[j]; }
            if (tid >= 448) {
                const int s = lane; const float ig = gif[(tok0 + s) * 16 + h] + bif[h], fg = gif[(tok0 + s) * 16 + 8 + h] + bif[8 + h];
                const float lf = fg >= 0.f ? -log1pf(__expf(-fg)) : fg - log1pf(__expf(fg));
                float bsum = lf;
#pragma unroll
                for (int o = 1; o < 64; o <<= 1) { const float tv = __shfl_up(bsum, o); if (lane >= o) bsum += tv; }
                float pm = ig - bsum;
#pragma unroll
                for (int o = 1; o < 64; o <<= 1) { const float tv = __shfl_up(pm, o); if (lane >= o) pm = fmaxf(pm, tv); }
                const float m_prev = sca[0]; const float mts = bsum + fmaxf(m_prev, pm);
                const float b_last = __shfl(bsum, 63), m_new = __shfl(mts, 63);
                bb[s] = bsum; gi[s] = ig; mt[s] = mts; inter[s] = __expf(bsum + m_prev - mts); ksc[s] = __expf(b_last - bsum + ig - m_new);
                if (s == 0) { sca[1] = __expf(b_last + m_prev - m_new); sca[2] = m_new; }
            }
            __syncthreads();
            {
                const int t = tid >> 3, sg = tid & 7; float acc[8];
#pragma unroll
                for (int i = 0; i < 8; ++i) acc[i] = 0.f;
                for (int ch = 0; ch < 32; ++ch) { float qv[8]; unpack8(*(const LAS u32x4*)(qs + t * QS + ch * 8), qv);
#pragma unroll
                    for (int i = 0; i < 8; ++i) { const int s = sg + 8 * i; if (s <= t) { float kv[8]; unpack8(*(const LAS u32x4*)(ks + s * QS + ch * 8), kv);
                        acc[i] += (qv[0] * kv[0] + qv[1] * kv[1]) + (qv[2] * kv[2] + qv[3] * kv[3]) + (qv[4] * kv[4] + qv[5] * kv[5]) + (qv[6] * kv[6] + qv[7] * kv[7]); } } }
                const float bt = bb[t], mtt = mt[t];
#pragma unroll
                for (int i = 0; i < 8; ++i) { const int s = sg + 8 * i; wq[t * 65 + s] = (s <= t) ? acc[i] * 0.0625f * __expf(bt - bb[s] + gi[s] - mtt) : 0.f; }
            }
            __syncthreads();
            if (tid < 64) { const int t = tid; float rs = 0.f, qn = 0.f;
                for (int s = 0; s < 64; ++s) rs += wq[t * 65 + s];
                for (int d = 0; d < 256; ++d) qn += bf2f(qs[t * QS + d]) * ns[d];
                const float den = inter[t] * qn * 0.0625f + rs; dd[t] = fmaxf(fabsf(den), __expf(-mt[t])); }
            f32x4 a = (f32x4){0.f, 0.f, 0.f, 0.f};
            const int t4 = tid >> 3, e0 = 4 * (tid & 7);
            { for (int ch = 0; ch < 32; ++ch) { float qv[8]; unpack8(*(const LAS u32x4*)(qs + t4 * QS + ch * 8), qv);
#pragma unroll
                    for (int j = 0; j < 8; ++j) { const f32x4 cv = *(const LAS f32x4*)(Cs + (ch * 8 + j) * 36 + e0); a += qv[j] * cv; } }
              a *= inter[t4] * 0.0625f;
              for (int s = 0; s <= t4; ++s) { const float w = wq[t4 * 65 + s]; const f32x4 vv = *(const LAS f32x4*)(vsl + s * 32 + e0); a += w * vv; } }
            __syncthreads();
            { const float inv = 1.0f / dd[t4]; *(f32x4*)(hout + (tok0 + t4) * DM + h * 512 + es * 32 + e0) = a * inv; }
            {
                const int d = tid >> 1, eh = tid & 1, eo = 16 * eh; float u[16]; float un = 0.f;
#pragma unroll
                for (int j = 0; j < 16; ++j) u[j] = 0.f;
                for (int s = 0; s < 64; ++s) { const float kk = bf2f(ks[s * QS + d]) * ksc[s]; un += kk;
#pragma unroll
                    for (int j = 0; j < 16; ++j) u[j] += kk * vsl[s * 32 + eo + j]; }
                const float decay = sca[1];
#pragma unroll
                for (int j = 0; j < 16; ++j) Cs[d * 36 + eo + j] = decay * Cs[d * 36 + eo + j] + u[j];
                if (eh == 0) ns[d] = decay * ns[d] + un;
            }
            __syncthreads();
            if (tid == 0) sca[0] = sca[2];
            __syncthreads();
        }
    }
}

__device__ __forceinline__ void mlstm_scalars(const float* gif, const float* bif, float* scal, int bh, int lane) {
    constexpr float L2E = 1.4426950408889634f; constexpr size_t AS = (size_t)16 * SEQ;
    const int b = bh >> 3, h = bh & 7; float m_prev = 0.f;
    const float bi = bif[h], bf = bif[8 + h];
    for (int c = 0; c < 128; ++c) {
        const size_t tok = (size_t)b * SEQ + 64 * c + lane; const float ig = gif[tok * 16 + h] + bi, fg = gif[tok * 16 + 8 + h] + bf;
        const float lf = fg >= 0.f ? -log1pf(__expf(-fg)) : fg - log1pf(__expf(fg));
        float bsum = lf;
#pragma unroll
        for (int o = 1; o < 64; o <<= 1) { const float tv = __shfl_up(bsum, o); if (lane >= o) bsum += tv; }
        float pm = ig - bsum;
#pragma unroll
        for (int o = 1; o < 64; o <<= 1) { const float tv = __shfl_up(pm, o); if (lane >= o) pm = fmaxf(pm, tv); }
        const float mts = bsum + fmaxf(m_prev, pm); const float b_last = __shfl(bsum, 63), m_new = __shfl(mts, 63);
        float* sp = scal + (size_t)bh * SEQ + 64 * c + lane;
        sp[0] = (bsum - mts) * L2E; sp[AS] = (ig - bsum) * L2E; sp[2 * AS] = __expf(bsum + m_prev - mts); sp[3 * AS] = __expf(b_last - bsum + ig - m_new); sp[4 * AS] = __expf(-mts); sp[5 * AS] = __expf(b_last + m_prev - m_new);
        m_prev = m_new;
    }
}

__device__ __forceinline__ void cgates_phase(const bf16* A, const bf16* Wt, const float* bif, float* lsc, LAS unsigned char* lds) {
    const int tx_ = opaque_tid();
    const int lane = tx_ & 63, wave = __builtin_amdgcn_readfirstlane(tx_ >> 6), gw = blockIdx.x * NWAVES + wave, NGW = gridDim.x * NWAVES;
    const int fr = lane & 15, fq = lane >> 4;
    LAS float* gl = (LAS float*)(lds + wave * 4608);
    constexpr size_t AS = (size_t)16 * SEQ;
    const bool own = gridDim.x == 256;
    if (own) {
        const int task = 32 * (int)(blockIdx.x & 7) + (int)(blockIdx.x >> 3), tok0 = task * 64, b = task >> 7, c = task & 127;
        f32x4 acc[4];
#pragma unroll
        for (int r = 0; r < 4; ++r) acc[r] = (f32x4){0.f, 0.f, 0.f, 0.f};
        const bf16* ap = A + (size_t)(tok0 + fr) * DM + 8 * fq + 512 * wave; const bf16* bp = Wt + (size_t)fr * DM + 8 * fq + 512 * wave;
#pragma unroll 4
        for (int k0 = 0; k0 < 512; k0 += 32) { const bf16x8 bv = *(const bf16x8*)(bp + k0);
#pragma unroll
            for (int r = 0; r < 4; ++r) { const bf16x8 av = *(const bf16x8*)(ap + (size_t)r * 16 * DM + k0); acc[r] = __builtin_amdgcn_mfma_f32_16x16x32_bf16(av, bv, acc[r], 0, 0, 0); } }
#pragma unroll
        for (int r = 0; r < 4; ++r)
#pragma unroll
            for (int q = 0; q < 4; ++q) gl[(16 * r + 4 * fq + q) * 17 + fr] = acc[r][q];
        __syncthreads();
        { const int h = wave, bh = b * 8 + h; float ig = bif[h], fg = bif[8 + h];
#pragma unroll
          for (int w8 = 0; w8 < 8; ++w8) { const LAS float* g8 = (const LAS float*)(lds + w8 * 4608); ig += g8[lane * 17 + h]; fg += g8[lane * 17 + 8 + h]; }
          const float lf = fg >= 0.f ? -log1pf(__expf(-fg)) : fg - log1pf(__expf(fg));
          float bsum = lf;
#pragma unroll
          for (int o = 1; o < 64; o <<= 1) { const float tv = __shfl_up(bsum, o); if (lane >= o) bsum += tv; }
          float pm = ig - bsum;
#pragma unroll
          for (int o = 1; o < 64; o <<= 1) { const float tv = __shfl_up(pm, o); if (lane >= o) pm = fmaxf(pm, tv); }
          float* sp = lsc + (size_t)bh * SEQ + 64 * c + lane; sp[0] = bsum; sp[AS] = pm; sp[2 * AS] = ig;
          if (lane == 63) { lsc[3 * AS + bh * 128 + c] = bsum; lsc[3 * AS + 2048 + bh * 128 + c] = pm; } }
        __syncthreads();
        return;
    }
    for (int task0 = gw; task0 < TOK / 64; task0 += NGW) {
        const int task = task0;
        const int tok0 = task * 64, b = task >> 7, c = task & 127;
        f32x4 acc[4];
#pragma unroll
        for (int r = 0; r < 4; ++r) acc[r] = (f32x4){0.f, 0.f, 0.f, 0.f};
        const bf16* ap = A + (size_t)(tok0 + fr) * DM + 8 * fq; const bf16* bp = Wt + (size_t)fr * DM + 8 * fq;
#pragma unroll 4
        for (int k0 = 0; k0 < DM; k0 += 32) { const bf16x8 bv = *(const bf16x8*)(bp + k0);
#pragma unroll
            for (int r = 0; r < 4; ++r) { const bf16x8 av = *(const bf16x8*)(ap + (size_t)r * 16 * DM + k0); acc[r] = __builtin_amdgcn_mfma_f32_16x16x32_bf16(av, bv, acc[r], 0, 0, 0); } }
#pragma unroll
        for (int r = 0; r < 4; ++r)
#pragma unroll
            for (int q = 0; q < 4; ++q) gl[(16 * r + 4 * fq + q) * 17 + fr] = acc[r][q];
        LDS_WAIT();
        for (int h = 0; h < 8; ++h) { const int bh = b * 8 + h; const float ig = gl[lane * 17 + h] + bif[h], fg = gl[lane * 17 + 8 + h] + bif[8 + h];
            const float lf = fg >= 0.f ? -log1pf(__expf(-fg)) : fg - log1pf(__expf(fg));
            float bsum = lf;
#pragma unroll
            for (int o = 1; o < 64; o <<= 1) { const float tv = __shfl_up(bsum, o); if (lane >= o) bsum += tv; }
            float pm = ig - bsum;
#pragma unroll
            for (int o = 1; o < 64; o <<= 1) { const float tv = __shfl_up(pm, o); if (lane >= o) pm = fmaxf(pm, tv); }
            float* sp = lsc + (size_t)bh * SEQ + 64 * c + lane; sp[0] = bsum; sp[AS] = pm; sp[2 * AS] = ig;
            if (lane == 63) { lsc[3 * AS + bh * 128 + c] = bsum; lsc[3 * AS + 2048 + bh * 128 + c] = pm; } }
        LDS_WAIT();
    }
}
__device__ __forceinline__ void mlstm_scalars2(const float* lsc, float* scal, int bh, int c, int lane) {
    constexpr float L2E = 1.4426950408889634f; constexpr size_t AS = (size_t)16 * SEQ;
    const float cb0 = lsc[3 * AS + bh * 128 + lane], cb1 = lsc[3 * AS + bh * 128 + 64 + lane], cp0 = lsc[3 * AS + 2048 + bh * 128 + lane], cp1 = lsc[3 * AS + 2048 + bh * 128 + 64 + lane];
    float m_prev = 0.f;
    for (int k = 0; k < c; ++k) { const float cbk = __shfl(k < 64 ? cb0 : cb1, k & 63), cpk = __shfl(k < 64 ? cp0 : cp1, k & 63); m_prev = cbk + fmaxf(m_prev, cpk); }
    const float b_last = __shfl(c < 64 ? cb0 : cb1, c & 63), pm_last = __shfl(c < 64 ? cp0 : cp1, c & 63), m_new = b_last + fmaxf(m_prev, pm_last);
    const float* lp = lsc + (size_t)bh * SEQ + 64 * c + lane; const float bsum = lp[0], pm = lp[AS], ig = lp[2 * AS];
    const float mts = bsum + fmaxf(m_prev, pm);
    float* sp = scal + (size_t)bh * SEQ + 64 * c + lane;
    sp[0] = (bsum - mts) * L2E; sp[AS] = (ig - bsum) * L2E; sp[2 * AS] = __expf(bsum + m_prev - mts); sp[3 * AS] = __expf(b_last - bsum + ig - m_new); sp[4 * AS] = __expf(-mts); sp[5 * AS] = __expf(b_last + m_prev - m_new);
}
__device__ __forceinline__ void mlstm_relayout(const bf16* projc, bf16* kT, bf16* vT, LAS unsigned char* lds, int task_lo, int task_step, bool v_only = false) {
    const int tx_ = opaque_tid();
    const int lane = tx_ & 63, wave = __builtin_amdgcn_readfirstlane(tx_ >> 6);
    LAS bf16* tile = (LAS bf16*)(lds + wave * 9216);
    (void)kT; (void)v_only;
    for (int task = task_lo; task < 2048 * 2; task += task_step) {
        const int bc = task >> 1, hf = task & 1, bh = bc >> 7, c = bc & 127, b = bh >> 3, h = bh & 7;
        u32x4 raw[4][8];
#pragma unroll
        for (int q4 = 0; q4 < 4; ++q4) { const bf16* src = projc + (size_t)(b * SEQ + 64 * c) * C_N + 4096 + h * 512 + (hf * 4 + q4) * 64;
#pragma unroll
            for (int i = 0; i < 8; ++i) { const int idx = lane + 64 * i, r = idx >> 3, ch = idx & 7; raw[q4][i] = *(const u32x4*)(src + (size_t)r * C_N + ch * 8); } }
#pragma unroll
        for (int q4 = 0; q4 < 4; ++q4) {
#pragma unroll
            for (int i = 0; i < 8; ++i) { const int idx = lane + 64 * i, r = idx >> 3, ch = idx & 7; *(LAS u32x4*)(tile + r * 72 + ch * 8) = raw[q4][i]; }
            LDS_WAIT();
            const int eg = (hf * 4 + q4) * 64 + lane;
            bf16* dst = vT + ((size_t)bh * 128 + c) * 32768 + (size_t)(((eg >> 5) * 2 + ((eg >> 4) & 1)) * 2) * 512 + (eg & 15) * 8;
#pragma unroll
            for (int c8 = 0; c8 < 8; ++c8) { u32x4 w;
                w.x = (unsigned)tile[(8 * c8 + 0) * 72 + lane] | ((unsigned)tile[(8 * c8 + 1) * 72 + lane] << 16); w.y = (unsigned)tile[(8 * c8 + 2) * 72 + lane] | ((unsigned)tile[(8 * c8 + 3) * 72 + lane] << 16);
                w.z = (unsigned)tile[(8 * c8 + 4) * 72 + lane] | ((unsigned)tile[(8 * c8 + 5) * 72 + lane] << 16); w.w = (unsigned)tile[(8 * c8 + 6) * 72 + lane] | ((unsigned)tile[(8 * c8 + 7) * 72 + lane] << 16);
                *(u32x4*)(dst + (c8 >> 2) * 512 + (c8 & 3) * 128) = w; }
            LDS_WAIT();
        }
    }
}
__device__ __forceinline__ void mlstm_pre_phase(const bf16* projc, const float* lsc, float* scal, bf16* kT, bf16* vT, LAS unsigned char* lds) {
    const int tx_ = opaque_tid();
    const int gw = blockIdx.x * NWAVES + __builtin_amdgcn_readfirstlane(tx_ >> 6), NGW = gridDim.x * NWAVES;
    for (int task = gw; task < 2048; task += NGW) mlstm_scalars2(lsc, scal, task >> 7, task & 127, tx_ & 63);
    mlstm_relayout(projc, kT, vT, lds, gw, NGW);
}
__device__ __forceinline__ void mlstm_wq(const bf16* projc, const float* scal, int b, int h, int bh, int c, int tt, int sp, int fr, int qd, LAS bf16* buf, bf16x8 (&qf)[8]) {
    constexpr size_t AS = (size_t)16 * SEQ;
    const size_t tok0 = (size_t)b * SEQ + 64 * c;
    const bf16* qp = projc + (tok0 + 16 * tt + fr) * C_N + h * 256 + 8 * qd;
#pragma unroll
    for (int i = 0; i < 8; ++i) qf[i] = *(const bf16x8*)(qp + 32 * i);
    const int t = 16 * tt + fr; const float ra = scal[(size_t)bh * SEQ + 64 * c + t];
#pragma unroll
    for (int ss = 0; ss < 2; ++ss) { const int st = 2 * sp + ss;
        u32x2 w = (u32x2){0u, 0u};
        if (st <= tt) {
            const bf16* kp = projc + (tok0 + 16 * st + fr) * C_N + 2048 + h * 256 + 8 * qd;
            f32x4 acc = (f32x4){0.f, 0.f, 0.f, 0.f};
#pragma unroll
            for (int i = 0; i < 8; ++i) { const bf16x8 kf = *(const bf16x8*)(kp + 32 * i); acc = MFMA16(kf, qf[i], acc); }
            const f32x4 cb = *(const f32x4*)(scal + AS + (size_t)bh * SEQ + 64 * c + 16 * st + 4 * qd);
            float wv[4];
#pragma unroll
            for (int r = 0; r < 4; ++r) { const int sidx = 16 * st + 4 * qd + r; wv[r] = (sidx <= t) ? acc[r] * 0.0625f * __builtin_amdgcn_exp2f(ra + cb[r]) : 0.f; }
            w.x = pk2(wv[0], wv[1]); w.y = pk2(wv[2], wv[3]);
        }
        *(LAS u32x2*)(buf + t * 72 + 16 * st + 4 * qd) = w;
    }
}
__device__ __forceinline__ void mlstm_fast_phase(const bf16* projc, const bf16* kT, const bf16* vT, const float* scal, float* hout, LAS unsigned char* lds) {
    const int tx_ = opaque_tid();
    constexpr size_t AS = (size_t)16 * SEQ;
    const int tid = tx_, lane = tid & 63, w = __builtin_amdgcn_readfirstlane(tid >> 6), fr = lane & 15, qd = lane >> 4;
    const int tt = w & 3, sp = w >> 2, et = w >> 2;
    for (int unit = blockIdx.x; unit < 256; unit += gridDim.x) {
        const int b = unit >> 7, h = (unit >> 4) & 7, es = unit & 15, bh = b * 8 + h;
        LAS bf16* wqb0 = (LAS bf16*)lds; LAS bf16* wqb1 = wqb0 + 64 * 72; LAS bf16* ctb0 = wqb1 + 64 * 72; LAS bf16* ctb1 = ctb0 + 48 * 264;
        for (int i = tid; i < 48 * 264 / 2; i += 512) ((LAS unsigned*)ctb0)[i] = 0u;
        f32x4 C[2][3];
#pragma unroll
        for (int a = 0; a < 2; ++a)
#pragma unroll
            for (int e3 = 0; e3 < 3; ++e3) C[a][e3] = (f32x4){0.f, 0.f, 0.f, 0.f};
        bf16x8 qf[8];
        mlstm_wq(projc, scal, b, h, bh, 0, tt, sp, fr, qd, wqb0, qf);
        for (int c = 0; c < 128; ++c) {
            LAS bf16* wqc = (c & 1) ? wqb1 : wqb0; LAS bf16* ctc = (c & 1) ? ctb1 : ctb0; LAS bf16* ctn = (c & 1) ? ctb0 : ctb1;
            __syncthreads();
            const size_t tok0 = (size_t)b * SEQ + 64 * c; const float* sc0 = scal + (size_t)bh * SEQ + 64 * c;
            const bf16* vbase = vT + (((size_t)bh * 128 + c) * 512 + es * 32 + fr) * 64 + 8 * qd;
            bf16x8 vf[2][2];
#pragma unroll
            for (int e2 = 0; e2 < 2; ++e2)
#pragma unroll
                for (int i = 0; i < 2; ++i) vf[e2][i] = *(const bf16x8*)(vbase + (size_t)e2 * 16 * 64 + 32 * i);
            f32x4 ae = (f32x4){0.f, 0.f, 0.f, 0.f}, an = (f32x4){0.f, 0.f, 0.f, 0.f};
#pragma unroll
            for (int i = 0; i < 8; ++i) { const bf16x8 b0 = *(const LAS bf16x8*)(ctc + (16 * et + fr) * 264 + 32 * i + 8 * qd), b2 = *(const LAS bf16x8*)(ctc + (32 + fr) * 264 + 32 * i + 8 * qd);
                ae = MFMA16(qf[i], b0, ae); an = MFMA16(qf[i], b2, an); }
            { const f32x4 it = *(const f32x4*)(sc0 + 2 * AS + 16 * tt + 4 * qd);
#pragma unroll
              for (int r = 0; r < 4; ++r) { ae[r] *= it[r] * 0.0625f; an[r] *= it[r] * 0.0625f; } }
            const bf16x8 ones = (fr == 0) ? (bf16x8){0x3F80, 0x3F80, 0x3F80, 0x3F80, 0x3F80, 0x3F80, 0x3F80, 0x3F80} : (bf16x8){0, 0, 0, 0, 0, 0, 0, 0};
#pragma unroll
            for (int i = 0; i < 2; ++i) { const bf16x8 a = *(const LAS bf16x8*)(wqc + (16 * tt + fr) * 72 + 32 * i + 8 * qd);
                ae = MFMA16(a, (et ? vf[1][i] : vf[0][i]), ae); an = MFMA16(a, ones, an); }
            { const f32x4 em = *(const f32x4*)(sc0 + 4 * AS + 16 * tt + 4 * qd); f32x4 hv;
#pragma unroll
              for (int r = 0; r < 4; ++r) { const float dn = __shfl(an[r], lane & 48); hv[r] = ae[r] / fmaxf(fabsf(dn), em[r]); }
              float* hp = hout + (tok0 + 16 * tt + 4 * qd) * DM + h * 512 + es * 32 + 16 * et + fr;
#pragma unroll
              for (int r = 0; r < 4; ++r) hp[(size_t)r * DM] = hv[r]; }
            { const float decay = sc0[5 * AS];
#pragma unroll
              for (int a = 0; a < 2; ++a)
#pragma unroll
                  for (int e3 = 0; e3 < 3; ++e3) C[a][e3] *= decay;
              const bf16* kb = kT + (((size_t)bh * 128 + c) * 256 + 32 * w + fr) * 64 + 8 * qd;
#pragma unroll
              for (int i = 0; i < 2; ++i) { const bf16x8 a0 = *(const bf16x8*)(kb + 32 * i), a1 = *(const bf16x8*)(kb + 16 * 64 + 32 * i);
                  const f32x4 k0 = *(const f32x4*)(sc0 + 3 * AS + 32 * i + 8 * qd), k1 = *(const f32x4*)(sc0 + 3 * AS + 32 * i + 8 * qd + 4);
                  const float ks[8] = {k0[0], k0[1], k0[2], k0[3], k1[0], k1[1], k1[2], k1[3]};
                  bf16x8 vs[2];
#pragma unroll
                  for (int e2 = 0; e2 < 2; ++e2) { float f[8]; unpack8(__builtin_bit_cast(u32x4, vf[e2][i]), f); u32x4 p; p.x = pk2(f[0] * ks[0], f[1] * ks[1]); p.y = pk2(f[2] * ks[2], f[3] * ks[3]); p.z = pk2(f[4] * ks[4], f[5] * ks[5]); p.w = pk2(f[6] * ks[6], f[7] * ks[7]); vs[e2] = __builtin_bit_cast(bf16x8, p); }
                  u32x4 pn = (u32x4){0u, 0u, 0u, 0u}; if (fr == 0) { pn.x = pk2(ks[0], ks[1]); pn.y = pk2(ks[2], ks[3]); pn.z = pk2(ks[4], ks[5]); pn.w = pk2(ks[6], ks[7]); }
                  const bf16x8 vn = __builtin_bit_cast(bf16x8, pn);
                  C[0][0] = MFMA16(a0, vs[0], C[0][0]); C[0][1] = MFMA16(a0, vs[1], C[0][1]); C[0][2] = MFMA16(a0, vn, C[0][2]);
                  C[1][0] = MFMA16(a1, vs[0], C[1][0]); C[1][1] = MFMA16(a1, vs[1], C[1][1]); C[1][2] = MFMA16(a1, vn, C[1][2]); }
#pragma unroll
              for (int a = 0; a < 2; ++a)
#pragma unroll
                  for (int e3 = 0; e3 < 3; ++e3) { u32x2 p; p.x = pk2(C[a][e3][0], C[a][e3][1]); p.y = pk2(C[a][e3][2], C[a][e3][3]); *(LAS u32x2*)(ctn + (16 * e3 + fr) * 264 + 32 * w + 16 * a + 4 * qd) = p; } }
            if (c + 1 < 128) mlstm_wq(projc, scal, b, h, bh, c + 1, tt, sp, fr, qd, (c & 1) ? wqb0 : wqb1, qf);
        }
        __syncthreads();
    }
}


__device__ __forceinline__ void mlstm_chunk_task(const bf16* projc, const float* lsc, float* scal, bf16* wqg, bf16* kT, bf16* qF, LAS unsigned char* ldsw, int bh, int c, int lane) {
    constexpr float L2E = 1.4426950408889634f; constexpr size_t AS = (size_t)16 * SEQ;
    const int b = bh >> 3, h = bh & 7, fr = lane & 15, qd = lane >> 4;
    const float cb0 = lsc[3 * AS + bh * 128 + lane], cb1 = lsc[3 * AS + bh * 128 + 64 + lane], cp0 = lsc[3 * AS + 2048 + bh * 128 + lane], cp1 = lsc[3 * AS + 2048 + bh * 128 + 64 + lane];
    float m_prev = 0.f;
    for (int k = 0; k < c; ++k) { const float cbk = __shfl(k < 64 ? cb0 : cb1, k & 63), cpk = __shfl(k < 64 ? cp0 : cp1, k & 63); m_prev = cbk + fmaxf(m_prev, cpk); }
    const float b_last = __shfl(c < 64 ? cb0 : cb1, c & 63), pm_last = __shfl(c < 64 ? cp0 : cp1, c & 63), m_new = b_last + fmaxf(m_prev, pm_last);
    const float* lp = lsc + (size_t)bh * SEQ + 64 * c + lane; const float bsum = lp[0], pm = lp[AS], ig = lp[2 * AS];
    const float mts = bsum + fmaxf(m_prev, pm);
    const float rowA = (bsum - mts) * L2E, colB = (ig - bsum) * L2E;
    float* sp = scal + (size_t)bh * SEQ + 64 * c + lane;
    sp[2 * AS] = __expf(bsum + m_prev - mts); sp[3 * AS] = __expf(b_last - bsum + ig - m_new); sp[4 * AS] = __expf(-mts); sp[5 * AS] = __expf(b_last + m_prev - m_new);
    const size_t tok0 = (size_t)b * SEQ + 64 * c; bf16* wq = wqg + ((size_t)bh * 128 + c) * 4096;
#pragma unroll
    for (int tt = 0; tt < 4; ++tt) {
        int lq = lane * 8; asm volatile("" : "+v"(lq));
        const bf16* qp = projc + (tok0 + 16 * tt + fr) * C_N + h * 256 + 8 * qd; bf16x8 qf[8], kf[4][8];
#pragma unroll
        for (int i = 0; i < 8; ++i) { qf[i] = *(const bf16x8*)(qp + 32 * i); *(bf16x8*)(qF + (((size_t)bh * 128 + c) * 32 + tt * 8 + i) * 512 + lq) = qf[i]; }
#pragma unroll
        for (int st = 0; st < 4; ++st) if (st <= tt) { const bf16* kp = projc + (tok0 + 16 * st + fr) * C_N + 2048 + h * 256 + 8 * qd;
#pragma unroll
            for (int i = 0; i < 8; ++i) kf[st][i] = *(const bf16x8*)(kp + 32 * i); }
        const int t = 16 * tt + fr; const float ra = __shfl(rowA, t);
#pragma unroll
        for (int st = 0; st < 4; ++st) { u32x2 w = (u32x2){0u, 0u};
            if (st <= tt) { f32x4 acc = (f32x4){0.f, 0.f, 0.f, 0.f};
#pragma unroll
                for (int i = 0; i < 8; ++i) acc = MFMA16(kf[st][i], qf[i], acc);
                float wv[4];
#pragma unroll
                for (int r = 0; r < 4; ++r) { const int sidx = 16 * st + 4 * qd + r; const float cb = __shfl(colB, sidx); wv[r] = (sidx <= t) ? acc[r] * 0.0625f * __builtin_amdgcn_exp2f(ra + cb) : 0.f; }
                w.x = pk2(wv[0], wv[1]); w.y = pk2(wv[2], wv[3]); }
            *(u32x2*)(wq + ((tt * 2 + (st >> 1)) * 64 + (2 * (st & 1) + (qd >> 1)) * 16 + fr) * 8 + 4 * (qd & 1)) = w; }
    }
    { const float kscv = __expf(b_last - bsum + ig - m_new);
      LAS float* kl = (LAS float*)ldsw; LAS bf16* tile = (LAS bf16*)(ldsw + 256);
      kl[lane] = kscv; LDS_WAIT();
      u32x4 raw[4][8];
#pragma unroll
      for (int sub = 0; sub < 4; ++sub) { const bf16* src = projc + tok0 * C_N + 2048 + h * 256 + sub * 64;
#pragma unroll
          for (int i = 0; i < 8; ++i) { const int idx = lane + 64 * i, r = idx >> 3, ch = idx & 7; raw[sub][i] = *(const u32x4*)(src + (size_t)r * C_N + ch * 8); } }
#pragma unroll
      for (int sub = 0; sub < 4; ++sub) {
#pragma unroll
          for (int i = 0; i < 8; ++i) { const int idx = lane + 64 * i, r = idx >> 3, ch = idx & 7; float f[8]; unpack8(raw[sub][i], f); const float sc = kl[r];
              u32x4 o; o.x = pg8::cvt_pk_bf16(f[0] * sc, f[1] * sc); o.y = pg8::cvt_pk_bf16(f[2] * sc, f[3] * sc); o.z = pg8::cvt_pk_bf16(f[4] * sc, f[5] * sc); o.w = pg8::cvt_pk_bf16(f[6] * sc, f[7] * sc);
              *(LAS u32x4*)(tile + r * 72 + ch * 8) = o; }
          LDS_WAIT();
          bf16* dst = kT + ((size_t)bh * 128 + c) * 16384 + (size_t)((sub * 2 + (lane >> 5)) * 2 + ((lane >> 4) & 1)) * 1024 + (lane & 15) * 8;
#pragma unroll
          for (int c8 = 0; c8 < 8; ++c8) { u32x4 w;
              w.x = (unsigned)tile[(8 * c8 + 0) * 72 + lane] | ((unsigned)tile[(8 * c8 + 1) * 72 + lane] << 16); w.y = (unsigned)tile[(8 * c8 + 2) * 72 + lane] | ((unsigned)tile[(8 * c8 + 3) * 72 + lane] << 16);
              w.z = (unsigned)tile[(8 * c8 + 4) * 72 + lane] | ((unsigned)tile[(8 * c8 + 5) * 72 + lane] << 16); w.w = (unsigned)tile[(8 * c8 + 6) * 72 + lane] | ((unsigned)tile[(8 * c8 + 7) * 72 + lane] << 16);
              *(u32x4*)(dst + (c8 >> 2) * 512 + (c8 & 3) * 128) = w; }
          LDS_WAIT();
      } }
}
__device__ __forceinline__ void mlstm_pre2_phase(const bf16* projc, const float* lsc, float* scal, bf16* wqg, bf16* kT, bf16* vT, bf16* qF, LAS unsigned char* lds) {
    const int tx_ = opaque_tid();
    const int wave = __builtin_amdgcn_readfirstlane(tx_ >> 6), gw = blockIdx.x * NWAVES + wave, NGW = gridDim.x * NWAVES;
    for (int task = gw; task < 2048; task += NGW) mlstm_chunk_task(projc, lsc, scal, wqg, kT, qF, lds + wave * 9728, task >> 7, task & 127, tx_ & 63);
    __syncthreads();
    mlstm_relayout(projc, kT, vT, lds, gw, NGW, true);
}
struct MlSet { bf16x8 wa[2], qf[8], vf[2][2], ka[2][2]; f32x4 it, em; float decay; };
struct MlOff { int ow, oq, ov, os; };
__device__ __forceinline__ void mlstm_load_set(MlSet& S, const MlOff& Of, const bf16* qF, const bf16* wqg, const bf16* kT, const bf16* vT, const float* scal, int b, int h, int bh, int es, int c, int w, int tt) {
    constexpr size_t AS = (size_t)16 * SEQ;
    int ol = Of.ow, os = Of.os; asm volatile("" : "+v"(ol), "+v"(os));
    const size_t cb = (size_t)bh * 128 + c;
    const bf16* wp = wqg + cb * 4096 + tt * 1024;
    const bf16* qp = qF + cb * 16384 + tt * 4096;
    const bf16* vp = vT + cb * 32768 + es * 2048;
    const bf16* kp = kT + cb * 16384 + w * 2048;
    const float* sc0 = scal + (size_t)bh * SEQ + 64 * c + 16 * tt;
    S.wa[0] = *(const bf16x8*)(wp + ol); S.wa[1] = *(const bf16x8*)(wp + (ol + 512));
#pragma unroll
    for (int i = 0; i < 8; ++i) S.qf[i] = *(const bf16x8*)(qp + (ol + 512 * i));
#pragma unroll
    for (int e2 = 0; e2 < 2; ++e2)
#pragma unroll
        for (int i = 0; i < 2; ++i) { S.vf[e2][i] = *(const bf16x8*)(vp + (ol + (e2 * 2 + i) * 512)); S.ka[e2][i] = *(const bf16x8*)(kp + (ol + (e2 * 2 + i) * 512)); }
    S.it = *(const f32x4*)(sc0 + 2 * AS + os); S.em = *(const f32x4*)(sc0 + 4 * AS + os);
    S.decay = scal[(size_t)bh * SEQ + 64 * c + 5 * AS];
}
template <bool STORE = true> __device__ __forceinline__ void mlstm_step(const MlSet& S, f32x4 (&C)[2][3], const LAS bf16* ctc, LAS bf16* ctn, float* hout, int b, int h, int es, int c, int w, int tt, int et, int lane) {
    const int fr = lane & 15, qd = lane >> 4;
    f32x4 ae = (f32x4){0.f, 0.f, 0.f, 0.f}, an = (f32x4){0.f, 0.f, 0.f, 0.f};
#pragma unroll
    for (int i = 0; i < 8; ++i) { const bf16x8 b0 = *(const LAS bf16x8*)(ctc + (16 * et + fr) * 264 + 32 * i + 8 * qd), b2 = *(const LAS bf16x8*)(ctc + (32 + fr) * 264 + 32 * i + 8 * qd);
        ae = MFMA16(S.qf[i], b0, ae); an = MFMA16(S.qf[i], b2, an); }
#pragma unroll
    for (int r = 0; r < 4; ++r) { const float sc = S.it[r] * 0.0625f; ae[r] *= sc; an[r] *= sc; }
    const bf16x8 ones = (fr == 0) ? (bf16x8){0x3F80, 0x3F80, 0x3F80, 0x3F80, 0x3F80, 0x3F80, 0x3F80, 0x3F80} : (bf16x8){0, 0, 0, 0, 0, 0, 0, 0};
#pragma unroll
    for (int i = 0; i < 2; ++i) { ae = MFMA16(S.wa[i], (et ? S.vf[1][i] : S.vf[0][i]), ae); an = MFMA16(S.wa[i], ones, an); }
    { f32x4 hv;
#pragma unroll
      for (int r = 0; r < 4; ++r) { const float dn = __shfl(an[r], lane & 48); hv[r] = ae[r] * __builtin_amdgcn_rcpf(fmaxf(fabsf(dn), S.em[r])); }
      float* hp = hout + ((size_t)b * SEQ + 64 * c + 16 * tt + 4 * qd) * DM + h * 512 + es * 32 + 16 * et + fr;
      if (STORE) {
#pragma unroll
      for (int r = 0; r < 4; ++r) hp[(size_t)r * DM] = hv[r]; } else asm volatile("" :: "v"(hv[0]), "v"(hv[1]), "v"(hv[2]), "v"(hv[3])); }
#pragma unroll
    for (int a = 0; a < 2; ++a)
#pragma unroll
        for (int e3 = 0; e3 < 3; ++e3) C[a][e3] *= S.decay;
#pragma unroll
    for (int i = 0; i < 2; ++i) {
        C[0][0] = MFMA16(S.ka[0][i], S.vf[0][i], C[0][0]); C[0][1] = MFMA16(S.ka[0][i], S.vf[1][i], C[0][1]); C[0][2] = MFMA16(S.ka[0][i], ones, C[0][2]);
        C[1][0] = MFMA16(S.ka[1][i], S.vf[0][i], C[1][0]); C[1][1] = MFMA16(S.ka[1][i], S.vf[1][i], C[1][1]); C[1][2] = MFMA16(S.ka[1][i], ones, C[1][2]); }
    asm volatile("s_nop 15\n\ts_nop 15" : "+v"(C[0][0]), "+v"(C[0][1]), "+v"(C[0][2]), "+v"(C[1][0]), "+v"(C[1][1]), "+v"(C[1][2]));
#pragma unroll
    for (int a = 0; a < 2; ++a)
#pragma unroll
        for (int e3 = 0; e3 < 3; ++e3) { u32x2 pc; pc.x = pg8::cvt_pk_bf16(C[a][e3][0], C[a][e3][1]); pc.y = pg8::cvt_pk_bf16(C[a][e3][2], C[a][e3][3]); *(LAS u32x2*)(ctn + (16 * e3 + fr) * 264 + 32 * w + 16 * a + 4 * qd) = pc; }
}
struct MlAddr { const bf16 *wp, *qp, *vp, *kp; const float* sc0; const float* dcp; };
__device__ __forceinline__ MlAddr mlstm_addr(const bf16* qF, const bf16* wqg, const bf16* kT, const bf16* vT, const float* scal, int bh, int es, int c, int w, int tt) {
    constexpr size_t AS = (size_t)16 * SEQ; const size_t cb = (size_t)bh * 128 + c; MlAddr A;
    A.wp = wqg + cb * 4096 + tt * 1024; A.qp = qF + cb * 16384 + tt * 4096; A.vp = vT + cb * 32768 + es * 2048; A.kp = kT + cb * 16384 + w * 2048;
    A.sc0 = scal + (size_t)bh * SEQ + 64 * c + 16 * tt; A.dcp = scal + (size_t)bh * SEQ + 64 * c + 5 * AS; return A;
}
__device__ __forceinline__ void mlstm_load_q(MlSet& S, const MlOff& Of, const MlAddr& A) {
    int ol = Of.ow; asm volatile("" : "+v"(ol));
#pragma unroll
    for (int i = 0; i < 8; ++i) S.qf[i] = *(const bf16x8*)(A.qp + (ol + 512 * i));
}
__device__ __forceinline__ void mlstm_load_w(MlSet& S, const MlOff& Of, const MlAddr& A) {
    int ol = Of.ow; asm volatile("" : "+v"(ol));
    S.wa[0] = *(const bf16x8*)(A.wp + ol); S.wa[1] = *(const bf16x8*)(A.wp + (ol + 512));
}
__device__ __forceinline__ void mlstm_load_r(MlSet& S, const MlOff& Of, const MlAddr& A) {
    constexpr size_t AS = (size_t)16 * SEQ;
    int ol = Of.ow, os = Of.os; asm volatile("" : "+v"(ol), "+v"(os));
#pragma unroll
    for (int e2 = 0; e2 < 2; ++e2)
#pragma unroll
        for (int i = 0; i < 2; ++i) { S.vf[e2][i] = *(const bf16x8*)(A.vp + (ol + (e2 * 2 + i) * 512)); S.ka[e2][i] = *(const bf16x8*)(A.kp + (ol + (e2 * 2 + i) * 512)); }
    S.it = *(const f32x4*)(A.sc0 + 2 * AS + os); S.em = *(const f32x4*)(A.sc0 + 4 * AS + os);
    S.decay = *A.dcp;
}
__device__ __forceinline__ void mlstm_step2(MlSet& S, const MlOff& Of, const MlAddr& A2, f32x4 (&C)[2][3], const LAS bf16* ctc, LAS bf16* ctn, float* hout, int b, int h, int es, int c, int w, int tt, int et, int lane) {
    const int fr = lane & 15, qd = lane >> 4;
    f32x4 ae = (f32x4){0.f, 0.f, 0.f, 0.f}, an = (f32x4){0.f, 0.f, 0.f, 0.f};
#pragma unroll
    for (int i = 0; i < 8; ++i) { const bf16x8 b0 = *(const LAS bf16x8*)(ctc + (16 * et + fr) * 264 + 32 * i + 8 * qd), b2 = *(const LAS bf16x8*)(ctc + (32 + fr) * 264 + 32 * i + 8 * qd);
        ae = MFMA16(S.qf[i], b0, ae); an = MFMA16(S.qf[i], b2, an); }
    __builtin_amdgcn_sched_barrier(0);
    mlstm_load_q(S, Of, A2);
#pragma unroll
    for (int r = 0; r < 4; ++r) { const float sc = S.it[r] * 0.0625f; ae[r] *= sc; an[r] *= sc; }
    const bf16x8 ones = (fr == 0) ? (bf16x8){0x3F80, 0x3F80, 0x3F80, 0x3F80, 0x3F80, 0x3F80, 0x3F80, 0x3F80} : (bf16x8){0, 0, 0, 0, 0, 0, 0, 0};
#pragma unroll
    for (int i = 0; i < 2; ++i) { ae = MFMA16(S.wa[i], (et ? S.vf[1][i] : S.vf[0][i]), ae); an = MFMA16(S.wa[i], ones, an); }
    __builtin_amdgcn_sched_barrier(0);
    mlstm_load_w(S, Of, A2);
    { f32x4 hv;
#pragma unroll
      for (int r = 0; r < 4; ++r) { const float dn = __shfl(an[r], lane & 48); hv[r] = ae[r] * __builtin_amdgcn_rcpf(fmaxf(fabsf(dn), S.em[r])); }
      float* hp = hout + ((size_t)b * SEQ + 64 * c + 16 * tt + 4 * qd) * DM + h * 512 + es * 32 + 16 * et + fr;
#pragma unroll
      for (int r = 0; r < 4; ++r) hp[(size_t)r * DM] = hv[r]; }
#pragma unroll
    for (int a = 0; a < 2; ++a)
#pragma unroll
        for (int e3 = 0; e3 < 3; ++e3) C[a][e3] *= S.decay;
#pragma unroll
    for (int i = 0; i < 2; ++i) {
        C[0][0] = MFMA16(S.ka[0][i], S.vf[0][i], C[0][0]); C[0][1] = MFMA16(S.ka[0][i], S.vf[1][i], C[0][1]); C[0][2] = MFMA16(S.ka[0][i], ones, C[0][2]);
        C[1][0] = MFMA16(S.ka[1][i], S.vf[0][i], C[1][0]); C[1][1] = MFMA16(S.ka[1][i], S.vf[1][i], C[1][1]); C[1][2] = MFMA16(S.ka[1][i], ones, C[1][2]); }
    __builtin_amdgcn_sched_barrier(0);
    mlstm_load_r(S, Of, A2);
    __builtin_amdgcn_sched_barrier(0);
    asm volatile("s_nop 15\n\ts_nop 15" : "+v"(C[0][0]), "+v"(C[0][1]), "+v"(C[0][2]), "+v"(C[1][0]), "+v"(C[1][1]), "+v"(C[1][2]));
#pragma unroll
    for (int a = 0; a < 2; ++a)
#pragma unroll
        for (int e3 = 0; e3 < 3; ++e3) { u32x2 pc; pc.x = pg8::cvt_pk_bf16(C[a][e3][0], C[a][e3][1]); pc.y = pg8::cvt_pk_bf16(C[a][e3][2], C[a][e3][3]); *(LAS u32x2*)(ctn + (16 * e3 + fr) * 264 + 32 * w + 16 * a + 4 * qd) = pc; }
}
struct MlWarm { unsigned a, b, c; };
__device__ __forceinline__ void mlstm_warm(MlWarm& W, const bf16* projc, const bf16* wqg, const bf16* kT, const bf16* vT, const float* scal, int b, int h, int bh, int es, int c, int w, int tt, int lane) {
    constexpr size_t AS = (size_t)16 * SEQ;
    int lo = lane; asm volatile("" : "+v"(lo));
    const size_t tok0 = (size_t)b * SEQ + 64 * c;
    W.a = *(const unsigned*)(projc + (tok0 + 16 * tt + (lo & 15)) * C_N + h * 256 + (lo >> 4) * 64);
    const bf16* p1 = (lo < 32) ? kT + (((size_t)bh * 128 + c) * 256 + 32 * w + lo) * 64 : vT + (((size_t)bh * 128 + c) * 512 + es * 32 + (lo - 32)) * 64;
    W.b = *(const unsigned*)p1;
    const float* sc0 = scal + (size_t)bh * SEQ + 64 * c; const int si = lo - 16;
    const void* p2 = (lo < 16) ? (const void*)(wqg + ((size_t)bh * 128 + c) * 4096 + (16 * tt + lo) * 64)
                   : (si < 6) ? (const void*)(sc0 + (size_t)(2 + (si >> 1)) * AS + (si & 1) * 32) : (const void*)(sc0 + 5 * AS);
    W.c = *(const unsigned*)p2;
}
#define ML_WARM_USE(W) asm volatile("" :: "v"((W).a), "v"((W).b), "v"((W).c))
#define ML_BAR() do { asm volatile("s_waitcnt lgkmcnt(0)" ::: "memory"); __builtin_amdgcn_s_barrier(); asm volatile("" ::: "memory"); } while (0)
__device__ __forceinline__ void mlstm_fast2_phase(const bf16* qF, const bf16* wqg, const bf16* kT, const bf16* vT, const float* scal, float* hout, LAS unsigned char* lds) {
    const int tid = opaque_tid();
    const int lane = tid & 63, w = __builtin_amdgcn_readfirstlane(tid >> 6), tt = w & 3, et = w >> 2, fr = lane & 15, qd = lane >> 4;
    MlOff Of; Of.ow = lane * 8; Of.oq = 0; Of.ov = 0; Of.os = 4 * qd; (void)fr;
    for (int unit0 = blockIdx.x; unit0 < 256; unit0 += gridDim.x) {
        const int unit = unit0;
        const int b = unit >> 7, h = (unit >> 4) & 7, es = unit & 15, bh = b * 8 + h;
        LAS bf16* ctb0 = (LAS bf16*)lds; LAS bf16* ctb1 = ctb0 + 48 * 264;
        for (int i = tid; i < 48 * 264 / 2; i += 512) ((LAS unsigned*)ctb0)[i] = 0u;
        f32x4 C[2][3];
#pragma unroll
        for (int a = 0; a < 2; ++a)
#pragma unroll
            for (int e3 = 0; e3 < 3; ++e3) C[a][e3] = (f32x4){0.f, 0.f, 0.f, 0.f};
        MlSet S0, S1;
        mlstm_load_set(S0, Of, qF, wqg, kT, vT, scal, b, h, bh, es, 0, w, tt);
#if MK_ML_REFILL
        mlstm_load_set(S1, Of, qF, wqg, kT, vT, scal, b, h, bh, es, 1, w, tt);
#pragma unroll 1
        for (int c = 0; c < 128; c += 2) {
            const MlAddr A2 = mlstm_addr(qF, wqg, kT, vT, scal, bh, es, (c + 2 < 128) ? c + 2 : 127, w, tt), A3 = mlstm_addr(qF, wqg, kT, vT, scal, bh, es, (c + 3 < 128) ? c + 3 : 127, w, tt);
            ML_BAR();
            mlstm_step2(S0, Of, A2, C, ctb0, ctb1, hout, b, h, es, c, w, tt, et, lane);
            ML_BAR();
            mlstm_step2(S1, Of, A3, C, ctb1, ctb0, hout, b, h, es, c + 1, w, tt, et, lane);
        }
#else
#pragma unroll 1
        for (int c = 0; c < 128; c += 2) {
            ML_BAR();
            mlstm_load_set(S1, Of, qF, wqg, kT, vT, scal, b, h, bh, es, c + 1, w, tt);
            mlstm_step(S0, C, ctb0, ctb1, hout, b, h, es, c, w, tt, et, lane);
            ML_BAR();
            mlstm_load_set(S0, Of, qF, wqg, kT, vT, scal, b, h, bh, es, (c + 2 < 128) ? c + 2 : 127, w, tt);
            mlstm_step(S1, C, ctb1, ctb0, hout, b, h, es, c + 1, w, tt, et, lane);
        }
#endif
#if MK_ML_PROBE == 1
        __syncthreads();
#pragma unroll 1
        for (int c = 0; c < 128; c += 2) {
            ML_BAR(); mlstm_step<false>(S0, C, ctb0, ctb1, hout, b, h, es, c, w, tt, et, lane);
            ML_BAR(); mlstm_step<false>(S1, C, ctb1, ctb0, hout, b, h, es, c + 1, w, tt, et, lane);
        }
#elif MK_ML_PROBE == 2
        __syncthreads();
#pragma unroll 1
        for (int c = 0; c < 128; c += 2) {
            ML_BAR(); mlstm_load_set(S1, Of, qF, wqg, kT, vT, scal, b, h, bh, es, c + 1, w, tt); asm volatile("" :: "v"(S0.qf[0]), "v"(S0.ka[1][1]), "v"(S0.vf[1][1]), "v"(S0.wa[1]), "v"(S0.em), "v"(S0.decay));
            ML_BAR(); mlstm_load_set(S0, Of, qF, wqg, kT, vT, scal, b, h, bh, es, (c + 2 < 128) ? c + 2 : 127, w, tt); asm volatile("" :: "v"(S1.qf[0]), "v"(S1.ka[1][1]), "v"(S1.vf[1][1]), "v"(S1.wa[1]), "v"(S1.em), "v"(S1.decay));
        }
#endif
        __syncthreads();
    }
}

__device__ __forceinline__ void cgate_phase(const float* hout, const bf16* projc, const float* hnorm, bf16* ymix) {
    const int tx_ = opaque_tid();
    const int lane = tx_ & 63, gw = blockIdx.x * NWAVES + __builtin_amdgcn_readfirstlane(tx_ >> 6), NGW = gridDim.x * NWAVES;
    const bool own = gridDim.x == 256; const int j0 = 8 * (int)(blockIdx.x >> 3) + (gw & 7), t0 = 2048 * (int)(blockIdx.x & 7);
    for (int item0 = gw, k = 0; item0 < TOK * 8; item0 += NGW, ++k) {
        const int jj = j0 + 256 * k; const int tok = own ? t0 + (jj >> 3) : item0 >> 3, h = own ? jj & 7 : item0 & 7; const size_t off = (size_t)tok * DM + h * 512 + lane * 8;
        const f32x4 a = *(const f32x4*)(hout + off), c = *(const f32x4*)(hout + off + 4);
        const float ss = wave_sum((a.x * a.x + a.y * a.y) + (a.z * a.z + a.w * a.w) + (c.x * c.x + c.y * c.y) + (c.z * c.z + c.w * c.w));
        const float rstd = rsqrtf(ss * (1.f / 512.f) + RMS_EPS);
        float og[8]; unpack8(*(const u32x4*)(projc + (size_t)tok * C_N + 8192 + h * 512 + lane * 8), og);
        const f32x4 n0 = *(const f32x4*)(hnorm + h * 512 + lane * 8), n1 = *(const f32x4*)(hnorm + h * 512 + lane * 8 + 4);
        u32x4 w; w.x = pk2(sigmoidf_(og[0]) * a.x * rstd * n0.x, sigmoidf_(og[1]) * a.y * rstd * n0.y); w.y = pk2(sigmoidf_(og[2]) * a.z * rstd * n0.z, sigmoidf_(og[3]) * a.w * rstd * n0.w);
        w.z = pk2(sigmoidf_(og[4]) * c.x * rstd * n1.x, sigmoidf_(og[5]) * c.y * rstd * n1.y); w.w = pk2(sigmoidf_(og[6]) * c.z * rstd * n1.z, sigmoidf_(og[7]) * c.w * rstd * n1.w);
        *(u32x4*)(ymix + off) = w;
    }
}


#if MK_GLOG_CMP
__device__ __forceinline__ void cmpf_phase(const float* ref, const float* tst, size_t n, unsigned long long* ctl64) {
    const size_t gt = (size_t)blockIdx.x * 512 + threadIdx.x, NT = (size_t)gridDim.x * 512; unsigned long long cnt = 0, sd = 0, sr = 0;
    for (size_t i = gt; i < n; i += NT) { const float a = ref[i], d = (tst[i] + tst[i + GLOG_P2]) - a;   if (!(fabsf(d) <= 0.004f + 0.02f * fabsf(a))) ++cnt; sd += (unsigned long long)(fminf(d * d, 1e6f) * 16777216.0f); sr += (unsigned long long)(fminf(a * a, 1e6f) * 16777216.0f); }
    for (int o = 32; o >= 1; o >>= 1) { cnt += __shfl_xor(cnt, o); sd += __shfl_xor(sd, o); sr += __shfl_xor(sr, o); }
    if ((threadIdx.x & 63) == 0) { atomicAdd(ctl64, cnt); atomicAdd(ctl64 + 1, sd); atomicAdd(ctl64 + 2, sr); }
}
#endif
#if MK_NSA_CMP
__device__ __forceinline__ void cmp_phase(const bf16* ref, const bf16* tst, int c0, int c1, unsigned long long* ctl64) {
    const int tx_ = opaque_tid();
    const size_t gt = (size_t)blockIdx.x * 512 + tx_, NT = (size_t)gridDim.x * 512; const int cpr = (c1 - c0) / 8;
    unsigned long long cnt = 0, sd = 0, sr = 0;
    for (size_t it = gt; it < (size_t)TOK * cpr; it += NT) { const size_t off = (it / cpr) * DM + c0 + (it % cpr) * 8; float a[8], b[8]; unpack8(*(const u32x4*)(ref + off), a); unpack8(*(const u32x4*)(tst + off), b);
#pragma unroll
        for (int j = 0; j < 8; ++j) { const float d = b[j] - a[j]; if (!(fabsf(d) <= 0.004f + 0.02f * fabsf(a[j]))) ++cnt; sd += (unsigned long long)(fminf(d * d, 1e6f) * 16777216.0f); sr += (unsigned long long)(fminf(a[j] * a[j], 1e6f) * 16777216.0f); } }
    for (int o = 32; o >= 1; o >>= 1) { cnt += __shfl_xor(cnt, o); sd += __shfl_xor(sd, o); sr += __shfl_xor(sr, o); }
    if ((tx_ & 63) == 0) { atomicAdd(ctl64, cnt); atomicAdd(ctl64 + 1, sd); atomicAdd(ctl64 + 2, sr); }
}
#endif

__device__ __forceinline__ void xcd_barrier_rowlocal(const XcdBarrier& b, unsigned* mis) {
    asm volatile("s_waitcnt vmcnt(0)" ::: "memory");
    __syncthreads();
    if (threadIdx.x == 0) {
        unsigned* bar = b.bar;
        __builtin_amdgcn_s_waitcnt(0);
        unsigned nloc = b.st[0], nx = b.st[1];
        if (nloc == 0u) { xcd_barrier_complete(bar, b.x, nloc, nx); b.st[0] = nloc; b.st[1] = nx; }
        const bool local = (xb_ld(mis) == 0u) && (nx == 8u) && (nloc == 32u) && (gridDim.x == 256u);
        const unsigned old = xb_add(&bar[XB_XSUB(b.x)], 1u);
        const unsigned gen = old / nloc;
        if (old + 1u == (gen + 1u) * nloc) {
            if (!local) {
                __builtin_amdgcn_fence(__ATOMIC_RELEASE, "agent");
                asm volatile("s_waitcnt vmcnt(0)" ::: "memory");
                const unsigned og = xb_add(&bar[XB_TOP], 1u);
                const unsigned tg = og / nx;
                if (og + 1u == (tg + 1u) * nx) xb_add(&bar[XB_TOPGEN], 1u);
                else XB_SPIN(xb_ld(&bar[XB_TOPGEN]) == tg, bar);
            }
            __builtin_amdgcn_fence(__ATOMIC_ACQUIRE, "agent");
            xb_add(&bar[XB_XGEN(b.x)], 1u);
            asm volatile("s_waitcnt vmcnt(0)" ::: "memory");
        } else {
            XB_SPIN(xb_ld(&bar[XB_XGEN(b.x)]) == gen, bar);
            __builtin_amdgcn_fence(__ATOMIC_ACQUIRE, "agent");
            asm volatile("s_waitcnt vmcnt(0)" ::: "memory");
        }
    }
    __syncthreads();
}

#ifndef MK_PROBE
#define MK_PROBE 0
#define MK_PROBE_A 3
#define MK_PROBE_B 11
#endif
#ifndef MK_PER_PHASE
#define MK_PER_PHASE 0
#endif
constexpr int NPHASE = 19;
struct Args { const float* in[22]; float* out; unsigned char* ws; int ph_lo, ph_hi; };
__global__ void __launch_bounds__(NWAVES * 64, 2) mk_fwd(Args args) {
    extern __shared__ __attribute__((aligned(16))) unsigned char lds_raw[];
    LAS unsigned char* lds = (LAS unsigned char*)lds_raw;
    volatile LAS unsigned* MISC = (volatile LAS unsigned*)(lds + MISC_OFF);
    const int tid = threadIdx.x;
    if (tid < 64) MISC[tid] = 0u;
    __syncthreads();
    unsigned char* ws = args.ws;
    unsigned* ctl = (unsigned*)(ws + WS_CTL);
    XcdBarrier bar; bar.bar = ctl + CW_BAR; bar.x = 0; bar.st = nullptr;
    if (!MK_PER_PHASE) bar = xcd_barrier_post(ctl + CW_BAR, MISC + 8);
    unsigned* const mis = ctl + 8000;
    if (!MK_PER_PHASE && tid == 0 && bar.x != (blockIdx.x & 7u)) atomicAdd(mis, 1u);
    Ptrs P;
#pragma unroll
    for (int i = 0; i < 22; ++i) P.in[i] = args.in[i];
    P.out = args.out; P.ws = ws;
    const int lo = args.ph_lo, hi = args.ph_hi;
#define IN(k) (lo <= (k) && (k) < hi)
#define GRIDBAR() xcd_barrier(bar)
#define SEAM(k) do { if (IN(k) && IN((k) + 1)) xcd_barrier(bar); STAMP((k) + 1); } while (0)
#define SEAML(k) do { if (IN(k) && IN((k) + 1)) xcd_barrier_rowlocal(bar, mis); STAMP((k) + 1); } while (0)
    bf16* const U = (bf16*)(ws + WS_U); bf16* const PROJ = (bf16*)(ws + WS_PROJ); bf16* const YMIX = (bf16*)(ws + WS_YMIX); bf16* const Y = (bf16*)(ws + WS_Y);
    bf16* const Gb = (bf16*)(ws + WS_G); bf16* const U2 = (bf16*)(ws + WS_U2); bf16* const ACT = (bf16*)(ws + WS_ACT);
    float* const GLOG = (float*)(ws + WS_GLOG); float* const GIF = (float*)(ws + WS_GIF); bf16* const KCMP = (bf16*)(ws + WS_KCMP); bf16* const VCMP = (bf16*)(ws + WS_VCMP);
    float* const HOUT = (float*)(ws + WS_HOUT);
    const int G = gridDim.x, bx = blockIdx.x;

#if MK_PROBE
    unsigned long long* const tsb = (unsigned long long*)(ctl + 2048);
#define STAMP(k) do { if (blockIdx.x == 0 && tid == 0) tsb[k] = wall_clock64(); } while (0)
#else
#define STAMP(k) do { } while (0)
#endif
    STAMP(0);
    if (IN(0)) REPK(0) { prologue_phase(P, lds); __syncthreads(); } SEAM(0);
    if (IN(1)) {
        pg8::Gemm g{U, (const bf16*)(ws + WS_WAB), TOK, AB_N, DM}; pg8::StaticOrder S; S.init(TOK, AB_N, G, bx);
        pg8::EpiBf16P E{PROJ, AB_N};
        pg8::gemm_phase<pg8::EpiBf16P, pg8::StaticOrder, true, true>(lds, g, S, E);
#if MK_GLOG_CMP
        skinny_phase<5>(U, (const bf16*)(ws + WS_WABG), (float*)(ws + WS_R0 + 256 * MiB), 72, 72);
#endif
    } SEAM(1);
    if (IN(2)) {
        REPK(201) p2a_phase(PROJ, (bf16*)(ws + WS_POOLED), (bf16*)(ws + WS_KCR));
        REPK(202) vt_relayout_phase(PROJ, (bf16*)(ws + WS_VTS), (bf16*)(ws + WS_VTW), (bf16*)(ws + WS_KFS), (bf16*)(ws + WS_KFW), lds);
        GRIDBAR();
        { int kpool = 256; asm volatile("" : "+s"(kpool));
          pg8::Gemm g{(const bf16*)(ws + WS_POOLED), (const bf16*)(ws + WS_WPOOL), 4 * TOK, 1024, kpool}; pg8::PoolOrder S; S.c = bx; S.G = G;
          pg8::EpiPool E{YMIX, P.in[5]};
          pg8::gemm_phase<pg8::EpiPool, pg8::PoolOrder, true, true>(lds, g, S, E); }
        { pg8::Gemm g{(const bf16*)(ws + WS_KCR), (const bf16*)(ws + WS_WCMP), 8192, 1024, 2048}; pg8::CmpOrder S; S.c = bx; S.G = G;
          pg8::EpiCmp E{(float*)(ws + WS_PCMP)};
          pg8::gemm_phase<pg8::EpiCmp, pg8::CmpOrder, true, true>(lds, g, S, E); }
        {
          const bool gsplit = (G == 256); const int ks = gsplit ? (bx & 1) : 0;
          pg8::Gemm g{U + ks * 2048, (const bf16*)(ws + WS_WABG) + ks * 2048, TOK, 256, gsplit ? 2048 : DM, DM}; pg8::GateOrder S; S.c = bx; S.first = gsplit ? 128 : ((G >= 128) ? 64 : 0); S.n = gsplit ? 128 : 64; S.sh = gsplit ? 1 : 0;
          pg8::EpiGate E{GLOG + (size_t)ks * GLOG_P2};
          pg8::gemm_phase<pg8::EpiGate, pg8::GateOrder, true, true>(lds, g, S, E);
          if (!gsplit) for (size_t i = (size_t)bx * 512 + tid; i < (size_t)GLOG_P2; i += (size_t)G * 512) GLOG[GLOG_P2 + i] = 0.f; }
        GRIDBAR();
        REPK(203) p2c_phase((const float*)(ws + WS_PCMP), (const float*)(ws + WS_CPART), P.in[8], P.in[10], KCMP, (bf16*)(ws + WS_VCT), (bf16*)(ws + WS_KCF), MK_NSA_CMP ? VCMP : (bf16*)nullptr, lds);
#if MK_NSA_CMP
    } SEAM(2);
#else
    } SEAML(2);
#endif
    if (IN(3)) {
#if MK_GLOG_CMP
        cmpf_phase((const float*)(ws + WS_R0 + 256 * MiB), GLOG, (size_t)TOK * 72, (unsigned long long*)(ctl + 3072));
#endif
#if MK_NSA_CMP
        nsa_naive_phase(PROJ, KCMP, VCMP, GLOG, (bf16*)(ws + WS_YMIX2), lds); __syncthreads();
#endif
#if MK_NSA_V1
        nsa_fast_phase(PROJ, KCMP, (const bf16*)(ws + WS_VCT), (const bf16*)(ws + WS_VTS), (const bf16*)(ws + WS_VTW), GLOG, YMIX, lds);
#else
        nsa_fast2_phase(PROJ, (const bf16*)(ws + WS_KCF), (const bf16*)(ws + WS_VCT), (const bf16*)(ws + WS_KFS), (const bf16*)(ws + WS_VTS), (const bf16*)(ws + WS_KFW), (const bf16*)(ws + WS_VTW), GLOG, YMIX, lds);
#endif
    } SEAM(3);
    if (IN(4)) {
#if MK_NSA_CMP
        cmp_phase((const bf16*)(ws + WS_YMIX2), YMIX, 1024, 4096, (unsigned long long*)(ctl + 3072));
#endif
        pg8::Gemm g{YMIX, (const bf16*)(ws + WS_WOAB), TOK, DM, DM}; pg8::StaticOrder S; S.init(TOK, DM, G, bx);
        pg8::EpiBf16P E{Y, DM};
        pg8::gemm_phase<pg8::EpiBf16P, pg8::StaticOrder, true, true>(lds, g, S, E);
    } SEAML(4);
    if (IN(5)) REPK(5) { post_phase<false, true>(Y, P.in[2], P.in[0], ws + WS_HB, P.in[16], U); } SEAML(5);
    if (IN(6)) {
        pg8::Gemm g{U, (const bf16*)(ws + WS_WF1), TOK, F1N, DM}; LAS unsigned char* wl = lds + pg8::STAGE_BYTES + __builtin_amdgcn_readfirstlane((int)(threadIdx.x >> 6)) * 2048;
        pg8::ActOrder S; S.S.init(TOK, F1N, G, bx); S.cw = P.in[19]; S.cb = P.in[20]; S.dff = DFF; S.wl = wl;
        pg8::EpiAct E{ACT, (bf16*)(ws + WS_SIDE), wl, FFP, DFF};
        pg8::gemm_phase<pg8::EpiAct, pg8::ActOrder, true, true>(lds, g, S, E);
        { const int full = S.S.nwg / G, left = S.S.nwg - full * G;
          __syncthreads(); if (left == 0) f2_convert_tail(P, 0, bx, G, lds); else if (bx >= left) f2_convert_tail(P, 0, bx - left, G - left, lds); }
    } SEAM(6);
    if (IN(7)) REPK(7) { act_fix_phase((const bf16*)(ws + WS_SIDE), P.in[19], P.in[20], ACT); } SEAML(7);
    if (IN(8)) {
        pg8::Gemm g{ACT, (const bf16*)(ws + WS_WF2), TOK, DM, FFP}; pg8::StaticOrder S; S.init(TOK, DM, G, bx);
        pg8::EpiBf16P E{Y, DM};
        pg8::gemm_phase<pg8::EpiBf16P, pg8::StaticOrder, true, true>(lds, g, S, E);
    } SEAML(8);
    if (IN(9)) { post_phase<true, true>(Y, P.in[17], ws + WS_HB, ws + WS_HB, P.in[1] + DM, U); } SEAML(9);
    if (IN(10)) {
        pg8::Gemm g{U, (const bf16*)(ws + WS_WC), TOK, C_N, DM}; pg8::StaticOrder S; S.init(TOK, C_N, G, bx);
        pg8::EpiBf16P E{PROJ, C_N};
        pg8::gemm_phase<pg8::EpiBf16P, pg8::StaticOrder, true, true>(lds, g, S, E);
#if MK_MLSTM_NAIVE
        skinny_phase<1>(U, (const bf16*)(ws + WS_WCG), GIF, 16, 16);
#else
        REPK(110) cgates_phase(U, (const bf16*)(ws + WS_WCG), P.in[13], (float*)(ws + WS_LSC), lds);
#endif
    } SEAM(10);
    if (IN(11)) {
#if MK_MLSTM_NAIVE
        mlstm_naive_phase(PROJ, GIF, P.in[13], HOUT, lds);
#else
        REPK(111) mlstm_pre2_phase(PROJ, (const float*)(ws + WS_LSC), (float*)(ws + WS_SCAL), (bf16*)(ws + WS_WQ), (bf16*)(ws + WS_KT), (bf16*)(ws + WS_VT), (bf16*)(ws + WS_QF), lds);
        GRIDBAR();
        REPK(11) mlstm_fast2_phase((const bf16*)(ws + WS_QF), (const bf16*)(ws + WS_WQ), (const bf16*)(ws + WS_KT), (const bf16*)(ws + WS_VT), (const float*)(ws + WS_SCAL), HOUT, lds);
#endif
    } SEAM(11);
    if (IN(12)) REPK(12) { cgate_phase(HOUT, PROJ, P.in[14], YMIX); } SEAML(12);
    if (IN(13)) {
        pg8::Gemm g{YMIX, (const bf16*)(ws + WS_WOC), TOK, DM, DM}; pg8::StaticOrder S; S.init(TOK, DM, G, bx);
        pg8::EpiBf16P E{Y, DM};
        pg8::gemm_phase<pg8::EpiBf16P, pg8::StaticOrder, true, true>(lds, g, S, E);
    } SEAML(13);
    if (IN(14)) { post_phase<true, true>(Y, P.in[2] + DM, ws + WS_HB, ws + WS_HB, P.in[16] + DM, U); } SEAML(14);
    if (IN(15)) {
        pg8::Gemm g{U, (const bf16*)(ws + WS_WF1 + WF1_BYTES), TOK, F1N, DM}; LAS unsigned char* wl = lds + pg8::STAGE_BYTES + __builtin_amdgcn_readfirstlane((int)(threadIdx.x >> 6)) * 2048;
        pg8::ActOrder S; S.S.init(TOK, F1N, G, bx); S.cw = P.in[19] + 3 * DFF; S.cb = P.in[20] + DFF; S.dff = DFF; S.wl = wl;
        pg8::EpiAct E{ACT, (bf16*)(ws + WS_SIDE), wl, FFP, DFF};
        pg8::gemm_phase<pg8::EpiAct, pg8::ActOrder, true, true>(lds, g, S, E);
        { const int full = S.S.nwg / G, left = S.S.nwg - full * G;
          __syncthreads(); if (left == 0) f2_convert_tail(P, 1, bx, G, lds); else if (bx >= left) f2_convert_tail(P, 1, bx - left, G - left, lds); }
    } SEAM(15);
    if (IN(16)) { act_fix_phase((const bf16*)(ws + WS_SIDE), P.in[19] + 3 * DFF, P.in[20] + DFF, ACT); } SEAML(16);
    if (IN(17)) {
        pg8::Gemm g{ACT, (const bf16*)(ws + WS_WF2 + WF2_BYTES), TOK, DM, FFP}; pg8::StaticOrder S; S.init(TOK, DM, G, bx);
        pg8::EpiBf16P E{Y, DM};
        pg8::gemm_phase<pg8::EpiBf16P, pg8::StaticOrder, true, true>(lds, g, S, E);
    } SEAML(17);
    if (IN(18)) { post_phase<true, false>(Y, P.in[17] + DM, ws + WS_HB, P.out, nullptr, U); }
#if MK_NSA_CMP || MK_GLOG_CMP
    xcd_barrier(bar);
    if (blockIdx.x == 0 && tid == 0) { const unsigned long long* c64 = (const unsigned long long*)(ctl + 3072);
        const double cnt = (double)__hip_atomic_load(c64, __ATOMIC_RELAXED, __HIP_MEMORY_SCOPE_AGENT), sd = (double)__hip_atomic_load(c64 + 1, __ATOMIC_RELAXED, __HIP_MEMORY_SCOPE_AGENT), sr = (double)__hip_atomic_load(c64 + 2, __ATOMIC_RELAXED, __HIP_MEMORY_SCOPE_AGENT);
        P.out[0] = (float)(sqrt(sd / (sr + 1.0)) * 1e4);
        P.out[1] = (float)(sqrt(cnt) * 30.0);
    }
#endif
#if MK_PROBE
    xcd_barrier(bar); STAMP(19); xcd_barrier(bar);
    {
        const float c1 = (float)((double)(__hip_atomic_load(tsb + MK_PROBE_A + 1, __ATOMIC_RELAXED, __HIP_MEMORY_SCOPE_AGENT) - __hip_atomic_load(tsb + MK_PROBE_A, __ATOMIC_RELAXED, __HIP_MEMORY_SCOPE_AGENT)) * 0.01);
        const float c2 = (float)((double)(__hip_atomic_load(tsb + MK_PROBE_B + 1, __ATOMIC_RELAXED, __HIP_MEMORY_SCOPE_AGENT) - __hip_atomic_load(tsb + MK_PROBE_B, __ATOMIC_RELAXED, __HIP_MEMORY_SCOPE_AGENT)) * 0.0001);
        for (size_t i = (size_t)blockIdx.x * 512 + tid; i < (size_t)TOK * DM; i += (size_t)gridDim.x * 512) P.out[i] = (i == 0) ? c1 : c2;
    }
#endif
#undef IN
#undef SEAM
}

extern "C" void kernel_launch(void* const* d_in, const int* in_sizes, int n_in, void* d_out, int out_size, void* d_ws, size_t ws_size, hipStream_t stream) {
    static int grid = 0;
    if (grid == 0) {
        if (n_in != 22 || in_sizes[0] != TOK * DM || out_size != TOK * DM || ws_size < WS_END) { fprintf(stderr, "kernel_launch: unexpected problem shape or workspace (n_in %d, ws %zu < %zu); nothing launched\n", n_in, ws_size, (size_t)WS_END); grid = -1; return; }
        int dev = 0, cus = 0, per_cu = 0;
        if (hipGetDevice(&dev) != hipSuccess || hipDeviceGetAttribute(&cus, hipDeviceAttributeMultiprocessorCount, dev) != hipSuccess) { grid = -1; return; }
        if (hipFuncSetAttribute((const void*)mk_fwd, hipFuncAttributeMaxDynamicSharedMemorySize, LDS_BYTES) != hipSuccess) { fprintf(stderr, "kernel_launch: hipFuncSetAttribute failed\n"); grid = -1; return; }
        if (hipOccupancyMaxActiveBlocksPerMultiprocessor(&per_cu, (const void*)mk_fwd, NWAVES * 64, LDS_BYTES) != hipSuccess || per_cu < 1)
            fprintf(stderr, "kernel_launch: note: occupancy query reports %d workgroups per CU\n", per_cu);
        (void)hipGetLastError();
        grid = cus;
    }
    if (grid < 0) return;
    if (hipMemsetAsync((char*)d_ws + WS_CTL, 0, CTL_ZERO_BYTES, stream) != hipSuccess) return;
    Args a{};
    for (int i = 0; i < 22; ++i) a.in[i] = (const float*)d_in[i];
    a.out = (float*)d_out; a.ws = (unsigned char*)d_ws;
#if MK_PER_PHASE
    for (int p = 0; p < NPHASE; ++p) { a.ph_lo = p; a.ph_hi = p + 1; hipLaunchKernelGGL(mk_fwd, dim3(grid), dim3(NWAVES * 64), LDS_BYTES, stream, a); }
#else
    a.ph_lo = 0; a.ph_hi = NPHASE;
    hipLaunchKernelGGL(mk_fwd, dim3(grid), dim3(NWAVES * 64), LDS_BYTES, stream, a);
#endif
}
```

```cpp
#include <hip/hip_runtime.h>
#include <cstdio>
#include <cstdint>
namespace pg8 {
#define PG8_LAS __attribute__((address_space(3)))
typedef unsigned short bf16_t;
typedef short bf16x8 __attribute__((ext_vector_type(8)));
typedef float f32x4 __attribute__((ext_vector_type(4)));
typedef unsigned u32x4 __attribute__((ext_vector_type(4)));
constexpr int BM = 256, BK = 64, HALF = 128, HTB = HALF * BK * 2  , STAGE_BYTES = 8 * HTB, NXCD = 8, WGM = 8;

__host__ __device__ __forceinline__ int lds_byte(int r, int c) { const int st = (r >> 4) * 2 + (c >> 5), rr = r & 15, cc = c & 31, ob = rr * 64 + cc * 2; return st * 1024 + (ob ^ (((ob >> 9) & 1) << 5)); }
__host__ __device__ __forceinline__ void stage_rc(int b, int& R, int& C) { const int st = b / 1024, sb = b % 1024, swz = sb ^ (((sb >> 9) & 1) << 5); R = (st >> 1) * 16 + swz / 64; C = (st & 1) * 32 + (swz % 64) / 2; }
__host__ __device__ __forceinline__ int perm32(int rho) { const int n = rho >> 4, i = rho & 15; return 8 * (i >> 2) + 4 * n + (i & 3); }

struct Unit { int pm, pn, slot; };
struct Gemm { const bf16_t* A; const bf16_t* Bt; int M, N, K; int ld = 0; };

struct StaticOrder {
    int nM, nN, nwg, G, c;
    __host__ __device__ void init(int M, int N, int G_, int c_) { nM = M / BM; nN = N / BM; nwg = nM * nN; G = G_; c = c_; }
    __host__ __device__ bool next(int i, Unit& u) const {
        const long L = (long)i * G + c; if (L >= nwg) return false;
        int wgid = (int)L; { const int q = nwg / NXCD, r = nwg % NXCD, xcd = wgid % NXCD, off = wgid / NXCD; wgid = (xcd < r ? xcd * (q + 1) : r * (q + 1) + (xcd - r) * q) + off; }
        const int nig = WGM * nN, gid = wgid / nig, fm = gid * WGM, gsz = (nM - fm) < WGM ? (nM - fm) : WGM;
        u.pm = fm + ((wgid % nig) % gsz); u.pn = (wgid % nig) / gsz; return true;
    }
    __device__ __forceinline__ void a_ready(const Unit&) const {}
    __device__ __forceinline__ void done(const Unit&) const {}
};

__device__ __forceinline__ unsigned cvt_pk_bf16(float lo, float hi) { unsigned r; asm volatile("v_cvt_pk_bf16_f32 %0, %1, %2" : "=v"(r) : "v"(lo), "v"(hi)); return r; }

struct EpiBf16P {
    static constexpr bool PERM = true, AFTER_DRAIN = false;
    bf16_t* O; int ldc;
    __device__ __forceinline__ void operator()(const f32x4 (&acc)[2][2][4][2], const Unit& u, int wr, int wc, int fr, int fq) const {
        const int row0 = u.pm * BM + wr * 64 + fr, col0 = u.pn * BM + wc * 32 + 8 * fq;
#pragma unroll
        for (int ai = 0; ai < 2; ++ai)
#pragma unroll
            for (int m = 0; m < 4; ++m) { bf16_t* rowp = O + (size_t)(row0 + ai * HALF + m * 16) * ldc + col0;
#pragma unroll
                for (int bj = 0; bj < 2; ++bj) { const f32x4 v0 = acc[ai][bj][m][0], v1 = acc[ai][bj][m][1];
                    u32x4 w; w.x = cvt_pk_bf16(v0[0], v0[1]); w.y = cvt_pk_bf16(v0[2], v0[3]); w.z = cvt_pk_bf16(v1[0], v1[1]); w.w = cvt_pk_bf16(v1[2], v1[3]);
                    *(u32x4*)(rowp + bj * HALF) = w; } }
    }
};
struct EpiGU {
    static constexpr bool PERM = true, AFTER_DRAIN = false;
    bf16_t* G; bf16_t* U; int ldc;
    __device__ __forceinline__ void operator()(const f32x4 (&acc)[2][2][4][2], const Unit& u, int wr, int wc, int fr, int fq) const {
        const int row0 = u.pm * BM + wr * 64 + fr, col0 = u.pn * HALF + wc * 32 + 8 * fq;
#pragma unroll
        for (int ai = 0; ai < 2; ++ai)
#pragma unroll
            for (int m = 0; m < 4; ++m) { const size_t off = (size_t)(row0 + ai * HALF + m * 16) * ldc + col0;
#pragma unroll
                for (int bj = 0; bj < 2; ++bj) { const f32x4 v0 = acc[ai][bj][m][0], v1 = acc[ai][bj][m][1];
                    u32x4 w; w.x = cvt_pk_bf16(v0[0], v0[1]); w.y = cvt_pk_bf16(v0[2], v0[3]); w.z = cvt_pk_bf16(v1[0], v1[1]); w.w = cvt_pk_bf16(v1[2], v1[3]);
                    *(u32x4*)((bj == 0 ? G : U) + off) = w; } }
    }
};
struct EpiF32P {
    static constexpr bool PERM = false, AFTER_DRAIN = false;
    float* C; int ldc;
    __device__ __forceinline__ void operator()(const f32x4 (&acc)[2][2][4][2], const Unit& u, int wr, int wc, int fr, int fq) const {
        const int row0 = u.pm * BM + wr * 64 + fr, col0 = u.pn * BM + wc * 32 + 4 * fq;
#pragma unroll
        for (int ai = 0; ai < 2; ++ai)
#pragma unroll
            for (int m = 0; m < 4; ++m) { float* rowp = C + (size_t)(row0 + ai * HALF + m * 16) * ldc + col0;
#pragma unroll
                for (int bj = 0; bj < 2; ++bj)
#pragma unroll
                    for (int n = 0; n < 2; ++n) *(f32x4*)(rowp + bj * HALF + n * 16) = acc[ai][bj][m][n]; }
    }
};


struct PoolOrder { int c, G;
    __device__ __forceinline__ bool next(int i, Unit& u) const { long L;
        if (G == 256) { if (c < 64 || c >= 128 || i >= 4) return false; L = (c - 64) + 64 * i; } else { L = (long)i * G + c; if (L >= 256) return false; }
        u.pm = (int)L; u.pn = (int)L >> 6; return true; }
    __device__ __forceinline__ void a_ready(const Unit&) const {}
    __device__ __forceinline__ void done(const Unit&) const {}
};
struct EpiPool {
    static constexpr bool PERM = true, AFTER_DRAIN = false;
    bf16_t* O; const float* scale;
    __device__ __forceinline__ void operator()(const f32x4 (&acc)[2][2][4][2], const Unit& u, int wr, int wc, int fr, int fq) const {
        const int row0 = (u.pm & 63) * BM + wr * 64 + fr, col0 = u.pn * BM + wc * 32 + 8 * fq;
#pragma unroll
        for (int bj = 0; bj < 2; ++bj) { const f32x4 s0 = *(const f32x4*)(scale + col0 + bj * HALF), s1 = *(const f32x4*)(scale + col0 + bj * HALF + 4);
#pragma unroll
            for (int ai = 0; ai < 2; ++ai)
#pragma unroll
                for (int m = 0; m < 4; ++m) { const f32x4 v0 = acc[ai][bj][m][0] * s0, v1 = acc[ai][bj][m][1] * s1;
                    u32x4 w; w.x = cvt_pk_bf16(v0[0], v0[1]); w.y = cvt_pk_bf16(v0[2], v0[3]); w.z = cvt_pk_bf16(v1[0], v1[1]); w.w = cvt_pk_bf16(v1[2], v1[3]);
                    *(u32x4*)(O + (size_t)(row0 + ai * HALF + m * 16) * 4096 + col0 + bj * HALF) = w; } }
    }
};
struct CmpOrder { int c, G;
    __device__ __forceinline__ bool next(int i, Unit& u) const { const long L = (long)i * G + c; if (L >= 64) return false; const int w = (int)L >> 5, r = (int)L & 31; u.pm = w * 16 + (r >> 1); u.pn = w * 2 + (r & 1); return true; }
    __device__ __forceinline__ void a_ready(const Unit&) const {}
    __device__ __forceinline__ void done(const Unit&) const {}
};
struct EpiCmp {
    static constexpr bool PERM = false, AFTER_DRAIN = false;
    float* C;
    __device__ __forceinline__ void operator()(const f32x4 (&acc)[2][2][4][2], const Unit& u, int wr, int wc, int fr, int fq) const {
        const int row0 = u.pm * BM + wr * 64 + fr, col0 = (u.pn & 1) * BM + wc * 32 + 4 * fq;
#pragma unroll
        for (int ai = 0; ai < 2; ++ai)
#pragma unroll
            for (int m = 0; m < 4; ++m) { float* rowp = C + (size_t)(row0 + ai * HALF + m * 16) * 512 + col0;
#pragma unroll
                for (int bj = 0; bj < 2; ++bj)
#pragma unroll
                    for (int n = 0; n < 2; ++n) *(f32x4*)(rowp + bj * HALF + n * 16) = acc[ai][bj][m][n]; }
    }
};

__device__ __forceinline__ float dpp_ror1(float v) { return __builtin_bit_cast(float, __builtin_amdgcn_update_dpp(0, __builtin_bit_cast(int, v), 0x121, 0xf, 0xf, false)); }
__device__ __forceinline__ float dpp_ror2(float v) { return __builtin_bit_cast(float, __builtin_amdgcn_update_dpp(0, __builtin_bit_cast(int, v), 0x122, 0xf, 0xf, false)); }
struct ActOrder {
    StaticOrder S; const float* cw; const float* cb; int dff; PG8_LAS unsigned char* wl;
    __device__ __forceinline__ bool next(int i, Unit& u) const { if (!S.next(i, u)) return false; u.slot = i & 1; return true; }
    __device__ __forceinline__ void a_ready(const Unit& u) const {
        const int l = threadIdx.x & 31, wc = (threadIdx.x >> 6) & 3, a = l >> 3, q = l & 7;
        int ff = u.pn * HALF + wc * 32 + q * 4; ff = ff < dff - 4 ? ff : dff - 4;
        const float* src = (a < 3 ? cw + a * dff : cb) + ff;
        __builtin_amdgcn_global_load_lds((const unsigned*)src, (PG8_LAS unsigned*)(wl + u.slot * 1024), 16, 0, 0);
    }
    __device__ __forceinline__ void done(const Unit&) const {}
};
struct EpiAct {
    static constexpr bool PERM = true, AFTER_DRAIN = false;
    bf16_t* ACT; bf16_t* side; PG8_LAS unsigned char* wl; int ldc, dff;
    __device__ __forceinline__ void operator()(const f32x4 (&acc)[2][2][4][2], const Unit& u, int wr, int wc, int fr, int fq) const {
        const int ff0 = u.pn * HALF + wc * 32 + 8 * fq;
        float w0[8], w1[8], w2[8], bb[8];
        if (ff0 < dff) {
#pragma unroll
            for (int h = 0; h < 2; ++h) { const PG8_LAS float* wp = (const PG8_LAS float*)(wl + u.slot * 1024) + 8 * fq + 4 * h;
                const f32x4 a = *(const PG8_LAS f32x4*)wp, b1 = *(const PG8_LAS f32x4*)(wp + 32), c = *(const PG8_LAS f32x4*)(wp + 64), d = *(const PG8_LAS f32x4*)(wp + 96);
#pragma unroll
                for (int j = 0; j < 4; ++j) { w0[4 * h + j] = a[j]; w1[4 * h + j] = b1[j]; w2[4 * h + j] = c[j]; bb[4 * h + j] = d[j]; } }
        } else {
#pragma unroll
            for (int j = 0; j < 8; ++j) { w0[j] = 0.f; w1[j] = 0.f; w2[j] = 0.f; bb[j] = 0.f; } }
#pragma unroll
        for (int ai = 0; ai < 2; ++ai) {
            const int rowb = u.pm * BM + ai * HALF + wr * 64, chunk = rowb >> 6;
#pragma unroll
            for (int m = 0; m < 4; ++m) {
                float o[8];
#pragma unroll
                for (int e = 0; e < 8; ++e) { const float g = acc[ai][0][m][e >> 2][e & 3], up = acc[ai][1][m][e >> 2][e & 3];
                    const float gp = (m > 0) ? acc[ai][0][m > 0 ? m - 1 : 0][e >> 2][e & 3] : 0.f;
                    const float a1 = dpp_ror1(g), b1 = dpp_ror1(gp), a2 = dpp_ror2(g), b2 = dpp_ror2(gp);
                    const float p1 = fr >= 1 ? a1 : b1, p2 = fr >= 2 ? a2 : b2;
                    const float x = bb[e] + w0[e] * g + w1[e] * p1 + w2[e] * p2;
                    o[e] = x * __builtin_amdgcn_rcpf(1.0f + __builtin_amdgcn_exp2f(-1.4426950408889634f * x)) * up; }
                if (!(m == 0 && fr < 2)) { u32x4 w; w.x = cvt_pk_bf16(o[0], o[1]); w.y = cvt_pk_bf16(o[2], o[3]); w.z = cvt_pk_bf16(o[4], o[5]); w.w = cvt_pk_bf16(o[6], o[7]);
                    *(u32x4*)(ACT + (size_t)(rowb + 16 * m + fr) * ldc + ff0) = w; }
                if ((m == 0 && fr < 2) || (m == 3 && fr >= 14)) { const int rr = (m == 0) ? fr : fr - 12;
                    const f32x4 g0 = acc[ai][0][m][0], g1 = acc[ai][0][m][1], u0 = acc[ai][1][m][0], u1 = acc[ai][1][m][1];
                    u32x4 wg, wu; wg.x = cvt_pk_bf16(g0[0], g0[1]); wg.y = cvt_pk_bf16(g0[2], g0[3]); wg.z = cvt_pk_bf16(g1[0], g1[1]); wg.w = cvt_pk_bf16(g1[2], g1[3]);
                    wu.x = cvt_pk_bf16(u0[0], u0[1]); wu.y = cvt_pk_bf16(u0[2], u0[3]); wu.z = cvt_pk_bf16(u1[0], u1[1]); wu.w = cvt_pk_bf16(u1[2], u1[3]);
                    bf16_t* sp = side + ((size_t)(chunk * 4 + rr) * 2) * ldc + ff0; *(u32x4*)sp = wg; *(u32x4*)(sp + ldc) = wu; }
            }
        }
    }
};

struct EpiAB {
    static constexpr bool PERM = true, AFTER_DRAIN = false;
    bf16_t* O; float* glog;
    __device__ __forceinline__ void operator()(const f32x4 (&acc)[2][2][4][2], const Unit& u, int wr, int wc, int fr, int fq) const {
        const int row0 = u.pm * BM + wr * 64 + fr;
        if (u.pn < 28) { const int col0 = u.pn * BM + wc * 32 + 8 * fq;
#pragma unroll
            for (int ai = 0; ai < 2; ++ai)
#pragma unroll
                for (int m = 0; m < 4; ++m) { bf16_t* rowp = O + (size_t)(row0 + ai * HALF + m * 16) * 7168 + col0;
#pragma unroll
                    for (int bj = 0; bj < 2; ++bj) { const f32x4 v0 = acc[ai][bj][m][0], v1 = acc[ai][bj][m][1];
                        u32x4 w; w.x = cvt_pk_bf16(v0[0], v0[1]); w.y = cvt_pk_bf16(v0[2], v0[3]); w.z = cvt_pk_bf16(v1[0], v1[1]); w.w = cvt_pk_bf16(v1[2], v1[3]);
                        *(u32x4*)(rowp + bj * HALF) = w; } }
        } else { const int c0 = wc * 32 + 8 * fq;
            if (c0 < 72) {
#pragma unroll
                for (int ai = 0; ai < 2; ++ai)
#pragma unroll
                    for (int m = 0; m < 4; ++m) { float* rowp = glog + (size_t)(row0 + ai * HALF + m * 16) * 72 + c0;
                        *(f32x4*)rowp = acc[ai][0][m][0]; *(f32x4*)(rowp + 4) = acc[ai][0][m][1]; } } }
    }
};

struct GateOrder { int c, first, n, sh;
    __device__ __forceinline__ bool next(int i, Unit& u) const { if (i != 0 || c < first || c >= first + n) return false; u.pm = (c - first) >> sh; u.pn = 0; return true; }
    __device__ __forceinline__ void a_ready(const Unit&) const {}
    __device__ __forceinline__ void done(const Unit&) const {}
};
struct EpiGate {
    static constexpr bool PERM = true, AFTER_DRAIN = false;
    float* glog;
    __device__ __forceinline__ void operator()(const f32x4 (&acc)[2][2][4][2], const Unit& u, int wr, int wc, int fr, int fq) const {
        const int row0 = u.pm * BM + wr * 64 + fr, c0 = wc * 32 + 8 * fq;
        if (c0 < 72) {
#pragma unroll
            for (int ai = 0; ai < 2; ++ai)
#pragma unroll
                for (int m = 0; m < 4; ++m) { float* rowp = glog + (size_t)(row0 + ai * HALF + m * 16) * 72 + c0;
                    *(f32x4*)rowp = acc[ai][0][m][0]; *(f32x4*)(rowp + 4) = acc[ai][0][m][1]; } }
    }
};
template <class Epi, class Sched, bool ALIGN_EPI = false, bool SP2 = false>
__device__ __forceinline__ void gemm_phase(PG8_LAS unsigned char* lds, const Gemm g, const Sched& S, const Epi& E) {
    const int tid = threadIdx.x, wid = __builtin_amdgcn_readfirstlane(tid >> 6), lane = tid & 63, wr = wid >> 2, wc = wid & 3, fr = lane & 15, fq = lane >> 4;
    const int K = g.K, LD = g.ld ? g.ld : g.K, nt = K / BK;
    unsigned voffA[2], voffB[2];
#pragma unroll
    for (int i = 0; i < 2; ++i) { int R, C; stage_rc(tid * 16 + i * 8192, R, C); const int Rb = Epi::PERM ? ((R & ~31) + perm32(R & 31)) : R;
        voffA[i] = (unsigned)(R * LD + C) * 2u; voffB[i] = (unsigned)(Rb * LD + C) * 2u; }
    const size_t kstep = (size_t)(BK * 2);
    const size_t hstep = (size_t)HALF * LD * 2;
    const size_t tstep = 2 * hstep;
    const unsigned ldsw = (unsigned)wid * 1024u;
    const int aoff = lds_byte(wr * 64 + fr, fq * 8), boff = lds_byte(wc * 32 + fr, fq * 8);
#define PG8_SA(b, h) (((b) * 2 + (h)) * HTB)
#define PG8_SB(b, h) ((4 + (b) * 2 + (h)) * HTB)
#define PG8_STAGE(bufoff, gbase, voff) do { _Pragma("unroll") for (int _i = 0; _i < 2; ++_i) \
        __builtin_amdgcn_global_load_lds((const unsigned*)((const char*)(gbase) + (voff)[_i]), (PG8_LAS unsigned*)(lds + (bufoff) + ldsw + _i * 8192), 16, 0, 0); } while (0)
#define PG8_LDA(dst, b, h) do { _Pragma("unroll") for (int m = 0; m < 4; ++m) _Pragma("unroll") for (int k = 0; k < 2; ++k) dst[m][k] = *(const PG8_LAS bf16x8*)(lds + PG8_SA(b, h) + aoff + m * 2048 + k * 1024); } while (0)
#define PG8_LDB(dst, b, h) do { _Pragma("unroll") for (int n = 0; n < 2; ++n) _Pragma("unroll") for (int k = 0; k < 2; ++k) dst[n][k] = *(const PG8_LAS bf16x8*)(lds + PG8_SB(b, h) + boff + n * 2048 + k * 1024); } while (0)
#define PG8_MMA(ai, bj, At, Bt) do { __builtin_amdgcn_s_setprio(1); _Pragma("unroll") for (int m = 0; m < 4; ++m) _Pragma("unroll") for (int n = 0; n < 2; ++n) _Pragma("unroll") for (int k = 0; k < 2; ++k) \
        acc[ai][bj][m][n] = __builtin_amdgcn_mfma_f32_16x16x32_bf16(Bt[n][k], At[m][k], acc[ai][bj][m][n], 0, 0, 0); __builtin_amdgcn_s_setprio(0); } while (0)
#define PG8_WAIT_V(n) asm volatile("s_waitcnt vmcnt(" #n ")" ::: "memory")
#define PG8_WAIT_L(n) asm volatile("s_waitcnt lgkmcnt(" #n ")" ::: "memory")
#define PG8_BAR __builtin_amdgcn_s_barrier()
#define PG8_SCHED __builtin_amdgcn_sched_barrier(0)
    Unit cur, nxt; int ui = 0;
    if (!S.next(0, cur)) return;
    f32x4 acc[2][2][4][2];
#pragma unroll
    for (int a = 0; a < 2; ++a)
#pragma unroll
        for (int b = 0; b < 2; ++b)
#pragma unroll
            for (int m = 0; m < 4; ++m)
#pragma unroll
                for (int n = 0; n < 2; ++n) acc[a][b][m][n] = (f32x4){0.f, 0.f, 0.f, 0.f};
    bf16x8 At[4][2], B0[2][2], B1[2][2];
    const char* cA = (const char*)g.A + (size_t)cur.pm * tstep; const char* cB = (const char*)g.Bt + (size_t)cur.pn * tstep;
    S.a_ready(cur);
    if constexpr (SP2) {
        PG8_STAGE(PG8_SB(0, 0), cB, voffB); PG8_STAGE(PG8_SB(0, 1), cB + hstep, voffB); PG8_STAGE(PG8_SA(0, 0), cA, voffA); PG8_STAGE(PG8_SA(0, 1), cA + hstep, voffA);
        if (wr == 1) PG8_BAR;
        PG8_WAIT_V(2); PG8_BAR;
        PG8_STAGE(PG8_SB(1, 0), cB + kstep, voffB); PG8_STAGE(PG8_SA(1, 0), cA + kstep, voffA); PG8_STAGE(PG8_SB(1, 1), cB + hstep + kstep, voffB);
        PG8_WAIT_V(6); PG8_BAR;
    } else {
        PG8_STAGE(PG8_SB(0, 0), cB, voffB); PG8_STAGE(PG8_SA(0, 0), cA, voffA); PG8_STAGE(PG8_SB(0, 1), cB + hstep, voffB); PG8_STAGE(PG8_SA(0, 1), cA + hstep, voffA);
        if (wr == 1) PG8_BAR;
        PG8_WAIT_V(4); PG8_BAR;
        PG8_STAGE(PG8_SB(1, 0), cB + kstep, voffB); PG8_STAGE(PG8_SA(1, 0), cA + kstep, voffA); PG8_STAGE(PG8_SB(1, 1), cB + hstep + kstep, voffB);
        PG8_WAIT_V(6); PG8_BAR;
    }
    for (;;) {
        const bool has_next = S.next(ui + 1, nxt);
        const char* nA = has_next ? (const char*)g.A + (size_t)nxt.pm * tstep : cA; const char* nB = has_next ? (const char*)g.Bt + (size_t)nxt.pn * tstep : cB;
        for (int t = 0; t < nt; t += 2) {
            const bool last = (t == nt - 2);
            const char* a1 = cA + (size_t)(t + 1) * kstep;
            const char* a2 = last ? nA : cA + (size_t)(t + 2) * kstep; const char* b2 = last ? nB : cB + (size_t)(t + 2) * kstep;
            const char* a3 = a2 + kstep; const char* b3 = b2 + kstep;
            if (last && has_next) S.a_ready(nxt);
            if constexpr (SP2) {
            PG8_LDB(B0, 0, 0); PG8_LDB(B1, 0, 1); PG8_SCHED; PG8_LDA(At, 0, 0); PG8_STAGE(PG8_SA(1, 1), a1 + hstep, voffA);
            PG8_WAIT_V(8); PG8_WAIT_L(0); PG8_BAR; PG8_MMA(0, 0, At, B0); PG8_MMA(0, 1, At, B1); PG8_BAR; PG8_SCHED;
            PG8_LDA(At, 0, 1); PG8_STAGE(PG8_SB(0, 0), b2, voffB); PG8_STAGE(PG8_SB(0, 1), b2 + hstep, voffB); PG8_STAGE(PG8_SA(0, 0), a2, voffA);
            PG8_WAIT_V(8); PG8_WAIT_L(0); PG8_BAR; PG8_MMA(1, 0, At, B0); PG8_MMA(1, 1, At, B1); PG8_BAR; PG8_SCHED;
            PG8_LDB(B0, 1, 0); PG8_LDB(B1, 1, 1); PG8_SCHED; PG8_LDA(At, 1, 0); PG8_STAGE(PG8_SA(0, 1), a2 + hstep, voffA);
            PG8_WAIT_V(8); PG8_WAIT_L(0); PG8_BAR; PG8_MMA(0, 0, At, B0); PG8_MMA(0, 1, At, B1); PG8_BAR; PG8_SCHED;
            PG8_LDA(At, 1, 1); PG8_STAGE(PG8_SB(1, 0), b3, voffB); PG8_STAGE(PG8_SB(1, 1), b3 + hstep, voffB); PG8_STAGE(PG8_SA(1, 0), a3, voffA);
            PG8_WAIT_V(8); PG8_WAIT_L(0); PG8_BAR; PG8_MMA(1, 0, At, B0); PG8_MMA(1, 1, At, B1); PG8_BAR; PG8_SCHED;
            } else {
            PG8_LDB(B0, 0, 0); PG8_SCHED; PG8_LDA(At, 0, 0); PG8_STAGE(PG8_SA(1, 1), a1 + hstep, voffA);
            PG8_WAIT_L(8); PG8_BAR; PG8_WAIT_L(0); PG8_MMA(0, 0, At, B0); PG8_BAR; PG8_SCHED;
            PG8_LDB(B1, 0, 1); PG8_STAGE(PG8_SB(0, 0), b2, voffB);
            PG8_BAR; PG8_WAIT_L(0); PG8_MMA(0, 1, At, B1); PG8_BAR;
            PG8_LDA(At, 0, 1); PG8_STAGE(PG8_SA(0, 0), a2, voffA);
            PG8_BAR; PG8_WAIT_L(0); PG8_MMA(1, 0, At, B0); PG8_BAR; PG8_SCHED;
            PG8_STAGE(PG8_SB(0, 1), b2 + hstep, voffB);
            PG8_WAIT_V(6); PG8_BAR; PG8_MMA(1, 1, At, B1); PG8_BAR;
            PG8_LDB(B0, 1, 0); PG8_SCHED; PG8_LDA(At, 1, 0); PG8_STAGE(PG8_SA(0, 1), a2 + hstep, voffA);
            PG8_WAIT_L(8); PG8_BAR; PG8_WAIT_L(0); PG8_MMA(0, 0, At, B0); PG8_BAR; PG8_SCHED;
            PG8_LDB(B1, 1, 1); PG8_STAGE(PG8_SB(1, 0), b3, voffB);
            PG8_BAR; PG8_WAIT_L(0); PG8_MMA(0, 1, At, B1); PG8_BAR;
            PG8_LDA(At, 1, 1); PG8_STAGE(PG8_SA(1, 0), a3, voffA);
            PG8_BAR; PG8_WAIT_L(0); PG8_MMA(1, 0, At, B0); PG8_BAR; PG8_SCHED;
            PG8_STAGE(PG8_SB(1, 1), b3 + hstep, voffB);
            PG8_WAIT_V(6); PG8_BAR; PG8_MMA(1, 1, At, B1); PG8_BAR;
            }
        }
        if constexpr (ALIGN_EPI) { if (wr == 0) PG8_BAR; }
        if constexpr (!Epi::AFTER_DRAIN) { E(acc, cur, wr, wc, fr, fq); S.done(cur); }
        if (!has_next) break;
#pragma unroll
        for (int a = 0; a < 2; ++a)
#pragma unroll
            for (int b = 0; b < 2; ++b)
#pragma unroll
                for (int m = 0; m < 4; ++m)
#pragma unroll
                    for (int n = 0; n < 2; ++n) acc[a][b][m][n] = (f32x4){0.f, 0.f, 0.f, 0.f};
        cur = nxt; cA = nA; cB = nB; ++ui;
        if constexpr (ALIGN_EPI) { if (wr == 1) PG8_BAR; }
    }
    PG8_WAIT_V(0);
    if constexpr (!ALIGN_EPI) { if (wr == 0) PG8_BAR; }
    PG8_BAR;
    if constexpr (Epi::AFTER_DRAIN) { E.fused(acc, cur, wr, wc, fr, fq, lds, wid, lane); S.done(cur); }
#undef PG8_SA
#undef PG8_SB
#undef PG8_STAGE
#undef PG8_LDA
#undef PG8_LDB
#undef PG8_MMA
#undef PG8_WAIT_V
#undef PG8_WAIT_L
#undef PG8_BAR
#undef PG8_SCHED
}
}
#define LAS __attribute__((address_space(3)))
#define XB_TMO      128
#define XB_XCNT(j)  (256  + 64 * (j))
#define XB_XSUB(j)  (1280 + 64 * (j))
#define XB_XGEN(j)  (2304 + 64 * (j))
#define XB_TOP      3328
#define XB_TOPGEN   3392
#define XCD_BAR_WORDS 3456
#define XB_SPIN_CAP (1u << 18)

__device__ __forceinline__ unsigned xb_ld(unsigned* p)              { return __hip_atomic_load(p, __ATOMIC_RELAXED, __HIP_MEMORY_SCOPE_AGENT); }
__device__ __forceinline__ unsigned xb_add(unsigned* p, unsigned v) { return __hip_atomic_fetch_add(p, v, __ATOMIC_RELAXED, __HIP_MEMORY_SCOPE_AGENT); }
__device__ __forceinline__ unsigned xb_xcc_id() { return (unsigned)__builtin_amdgcn_s_getreg((3 << 11) | 20) & 0xFu; }
#define XB_SPIN(cond, bar) do { unsigned _sp = 0; while (cond) { __builtin_amdgcn_s_sleep(1); \
    if ((++_sp & 255u) == 0u) { if (xb_ld(&(bar)[XB_TMO])) break; if (_sp > XB_SPIN_CAP) { atomicAdd(&(bar)[XB_TMO], 1u); break; } } } } while (0)

struct XcdBarrier {
    unsigned* bar; unsigned x;
    volatile LAS unsigned* st;
};

__device__ __forceinline__ XcdBarrier xcd_barrier_post(unsigned* bar, volatile LAS unsigned* st) {
    XcdBarrier b; b.bar = bar; b.x = xb_xcc_id(); b.st = st;
    if (threadIdx.x == 0) (void)xb_add(&bar[XB_XCNT(b.x)], 1u);
    return b;
}
__device__ __forceinline__ void xcd_barrier_complete(unsigned* bar, unsigned x, unsigned& nloc, unsigned& nx) {
    const unsigned G = gridDim.x * gridDim.y * gridDim.z;
    unsigned sum, cnt, mine, sp = 0u;
    for (;;) {
        sum = 0u; cnt = 0u; mine = 0u;
#pragma unroll
        for (unsigned j = 0; j < 16; ++j) { const unsigned c = xb_ld(&bar[XB_XCNT(j)]); sum += c; cnt += (c > 0u) ? 1u : 0u; mine = (j == x) ? c : mine; }
        if (sum == G) break;
        __builtin_amdgcn_s_sleep(1);
        if ((++sp & 255u) == 0u) { if (xb_ld(&bar[XB_TMO])) break; if (sp > XB_SPIN_CAP) { atomicAdd(&bar[XB_TMO], 1u); break; } }
    }
    nloc = mine > 0u ? mine : 1u; nx = cnt > 0u ? cnt : 1u;
}

__device__ __forceinline__ void xcd_barrier(const XcdBarrier& b) {
    asm volatile("s_waitcnt vmcnt(0)" ::: "memory");
    __syncthreads();
    if (threadIdx.x == 0) {
        unsigned* bar = b.bar;
        __builtin_amdgcn_s_waitcnt(0);
        unsigned nloc = b.st[0], nx = b.st[1];
        if (nloc == 0u) { xcd_barrier_complete(bar, b.x, nloc, nx); b.st[0] = nloc; b.st[1] = nx; }
        const unsigned old = xb_add(&bar[XB_XSUB(b.x)], 1u);
        const unsigned gen = old / nloc;
        if (old + 1u == (gen + 1u) * nloc) {
            __builtin_amdgcn_fence(__ATOMIC_RELEASE, "agent");
            asm volatile("s_waitcnt vmcnt(0)" ::: "memory");
            const unsigned og = xb_add(&bar[XB_TOP], 1u);
            const unsigned tg = og / nx;
            if (og + 1u == (tg + 1u) * nx) xb_add(&bar[XB_TOPGEN], 1u);
            else XB_SPIN(xb_ld(&bar[XB_TOPGEN]) == tg, bar);
            __builtin_amdgcn_fence(__ATOMIC_ACQUIRE, "agent");
            xb_add(&bar[XB_XGEN(b.x)], 1u);
            asm volatile("s_waitcnt vmcnt(0)" ::: "memory");
        } else {
            XB_SPIN(xb_ld(&bar[XB_XGEN(b.x)]) == gen, bar);
            __builtin_amdgcn_fence(__ATOMIC_ACQUIRE, "agent");
            asm volatile("s_waitcnt vmcnt(0)" ::: "memory");
        }
    }
    __syncthreads();
}
#ifndef MK_REP_PHASE
#define MK_REP_PHASE -1
#endif
#define REPK(k) for (int rep_ = 0; rep_ < ((k) == MK_REP_PHASE ? 2 : 1); ++rep_)
#ifndef MK_ML_WARM
#define MK_ML_WARM 0
#endif
#ifndef MK_GLOG_CMP
#define MK_GLOG_CMP 0
#endif
#ifndef MK_ML_PROBE
#define MK_ML_PROBE 0
#endif
#ifndef MK_ML_REFILL
#define MK_ML_REFILL 0
#endif
#ifndef MK_NSA_V1
#define MK_NSA_V1 0
#endif
#ifndef MK_MLSTM_NAIVE
#define MK_MLSTM_NAIVE 0
#endif
#ifndef MK_NSA_CMP
#define MK_NSA_CMP 0
#endif

typedef unsigned short bf16;
typedef float f32x4 __attribute__((ext_vector_type(4)));
typedef short bf16x8 __attribute__((ext_vector_type(8)));
typedef unsigned u32x4 __attribute__((ext_vector_type(4)));
typedef unsigned u32x2 __attribute__((ext_vector_type(2)));
constexpr int NWAVES = 8;
constexpr int TOK = 16384, DM = 4096, SEQ = 8192;
constexpr int AB_N = 7168, AB_W = 7240, C_N = 12288, C_W = 12304;
constexpr int DFF = 10944, FFP = 11008, F1N = 22016, F1W = 21888;
constexpr float RMS_EPS = 1e-6f;
constexpr float NEGF = -1e30f;
constexpr size_t MiB = 1u << 20;
constexpr size_t WS_CTL = 0, CTL_ZERO_BYTES = 1 * MiB;
constexpr size_t WS_WAB = 1 * MiB, WS_WABG = 57 * MiB  , WS_WOAB = 60 * MiB, WS_WC = 92 * MiB, WS_WCG = 188 * MiB, WS_WOC = 189 * MiB;
constexpr size_t WS_WF1 = 221 * MiB, WF1_BYTES = 172 * MiB, WS_WF2 = 565 * MiB, WF2_BYTES = 86 * MiB;
constexpr size_t WS_R0 = 737 * MiB, WS_R1 = 1425 * MiB, WS_R2 = 1769 * MiB, WS_HB = 1969 * MiB  , WS_END = 2097 * MiB;
constexpr size_t WS_PROJ = WS_R0, WS_G = WS_R0, WS_U2 = WS_R0 + 344 * MiB, WS_Y = WS_R0 + 384 * MiB, WS_HOUT = WS_R0 + 384 * MiB;
constexpr size_t WS_SIDE = WS_R0 + 640 * MiB;
constexpr size_t WS_U = WS_R1, WS_YMIX = WS_R1 + 128 * MiB, WS_ACT = WS_R0;
constexpr size_t WS_QF = WS_R2 + 120 * MiB;
constexpr size_t WS_WQ = WS_R2 + 100 * MiB;
constexpr size_t WS_LSC = WS_R2 + 20 * MiB;
constexpr size_t WS_SCAL = WS_R2 + 16 * MiB, WS_KT = WS_R2 + 32 * MiB, WS_VT = WS_R1;
constexpr int GLOG_P2 = TOK * 72;
constexpr size_t WS_GLOG = WS_R2, WS_GIF = WS_R2 + 8 * MiB, WS_KCMP = WS_R2 + 10 * MiB, WS_VCMP = WS_R2 + 11 * MiB, WS_VCT = WS_R2 + 12 * MiB, WS_VTS = WS_R2 + 16 * MiB, WS_VTW = WS_R2 + 32 * MiB, WS_YMIX2 = WS_R0 + 256 * MiB,
    WS_POOLED = WS_R2 + 48 * MiB, WS_KCR = WS_R2 + 80 * MiB, WS_PCMP = WS_R2 + 112 * MiB, WS_WCMP = WS_R2 + 128 * MiB, WS_WPOOL = WS_R2 + 132 * MiB, WS_CPART = WS_R2 + 133 * MiB, WS_KFS = WS_R2 + 134 * MiB, WS_KFW = WS_R2 + 150 * MiB, WS_KCF = WS_R2 + 166 * MiB;
static_assert((size_t)F1N * DM * 2 == WF1_BYTES && (size_t)DM * FFP * 2 == WF2_BYTES, "weight copy sizes");
constexpr int CW_BAR = 4096;
constexpr int LDS_BYTES = 163840, MISC_OFF = LDS_BYTES - 256;

#define LDS_WAIT() asm volatile("s_waitcnt lgkmcnt(0)" ::: "memory")
__device__ __forceinline__ int opaque_tid() { int t = threadIdx.x; asm volatile("" : "+v"(t)); return t; }
__device__ __forceinline__ float bf2f(unsigned v) { return __uint_as_float(v << 16); }
__device__ __forceinline__ unsigned f2bf(float f) { unsigned u = __float_as_uint(f); return (u + 0x7fffu + ((u >> 16) & 1u)) >> 16; }
__device__ __forceinline__ unsigned pk2(float lo, float hi) { return f2bf(lo) | (f2bf(hi) << 16); }
__device__ __forceinline__ float wave_sum(float v) {
#pragma unroll
    for (int o = 32; o >= 1; o >>= 1) v += __shfl_xor(v, o);
    return v;
}
__device__ __forceinline__ float wave_max(float v) {
#pragma unroll
    for (int o = 32; o >= 1; o >>= 1) v = fmaxf(v, __shfl_xor(v, o));
    return v;
}
__device__ __forceinline__ void unpack8(const u32x4 w, float (&f)[8]) {
    f[0] = __uint_as_float(w.x << 16); f[1] = __uint_as_float(w.x & 0xffff0000u); f[2] = __uint_as_float(w.y << 16); f[3] = __uint_as_float(w.y & 0xffff0000u);
    f[4] = __uint_as_float(w.z << 16); f[5] = __uint_as_float(w.z & 0xffff0000u); f[6] = __uint_as_float(w.w << 16); f[7] = __uint_as_float(w.w & 0xffff0000u);
}
__device__ __forceinline__ float sigmoidf_(float x) { return 1.0f / (1.0f + __expf(-x)); }

__device__ __forceinline__ void tr_item(const float* W, int ldw, int k0, int n0, bf16* WT, size_t ldk, int dst_row0, LAS float* scr, int lane, int kd0 = -1) {
    if (kd0 < 0) kd0 = k0;
#pragma unroll
    for (int i = 0; i < 8; ++i) { const int kk = 8 * i + (lane >> 3), c4 = (lane & 7) * 4; const f32x4 v = *(const f32x4*)(W + (size_t)(k0 + kk) * ldw + n0 + c4);
        LAS float* d = scr + kk * 33 + c4; d[0] = v.x; d[1] = v.y; d[2] = v.z; d[3] = v.w; }
    LDS_WAIT();
    const int c = lane & 7;
#pragma unroll
    for (int j = 0; j < 4; ++j) { const int n = (lane >> 3) + 8 * j; const LAS float* s = scr + (8 * c) * 33 + n;
        u32x4 o; o.x = pk2(s[0 * 33], s[1 * 33]); o.y = pk2(s[2 * 33], s[3 * 33]); o.z = pk2(s[4 * 33], s[5 * 33]); o.w = pk2(s[6 * 33], s[7 * 33]);
        *(u32x4*)(WT + (size_t)(dst_row0 + n) * ldk + kd0 + 8 * c) = o; }
    LDS_WAIT();
}
__device__ __forceinline__ void rms_row_bf16(const float* xrow, const float* gain, bf16* orow, int lane) {
    const f32x4* xr = (const f32x4*)xrow + lane; const f32x4* gr = (const f32x4*)gain + lane;
    f32x4 v[16]; float ss = 0.f;
#pragma unroll
    for (int j = 0; j < 16; ++j) { v[j] = xr[64 * j]; ss += (v[j].x * v[j].x + v[j].y * v[j].y) + (v[j].z * v[j].z + v[j].w * v[j].w); }
    const float rstd = rsqrtf(wave_sum(ss) * (1.f / DM) + RMS_EPS);
    u32x2* o8 = (u32x2*)orow + lane;
#pragma unroll
    for (int j = 0; j < 16; ++j) { const f32x4 g = gr[64 * j]; u32x2 w; w.x = pk2(v[j].x * rstd * g.x, v[j].y * rstd * g.y); w.y = pk2(v[j].z * rstd * g.z, v[j].w * rstd * g.w); o8[64 * j] = w; }
}
template <bool HIN_BF, bool HOUT_BF>
__device__ __forceinline__ void post_row(const bf16* yrow, const float* gpost, const void* hin, void* hout, const float* gpre, bf16* urow, int lane) {
    const u32x2* yr = (const u32x2*)yrow + lane; const f32x4* gr = (const f32x4*)gpost + lane;
    f32x4 v[16]; float ss = 0.f;
#pragma unroll
    for (int j = 0; j < 16; ++j) { const u32x2 w = yr[64 * j]; v[j].x = __uint_as_float(w.x << 16); v[j].y = __uint_as_float(w.x & 0xffff0000u); v[j].z = __uint_as_float(w.y << 16); v[j].w = __uint_as_float(w.y & 0xffff0000u);
        ss += (v[j].x * v[j].x + v[j].y * v[j].y) + (v[j].z * v[j].z + v[j].w * v[j].w); }
    const float rstd = rsqrtf(wave_sum(ss) * (1.f / DM) + RMS_EPS);
    float s2 = 0.f;
#pragma unroll
    for (int j = 0; j < 16; ++j) { const f32x4 g = gr[64 * j]; f32x4 h0;
        if constexpr (HIN_BF) { const u32x2 w = __builtin_nontemporal_load((const u32x2*)hin + lane + 64 * j);
            h0.x = __uint_as_float(w.x << 16); h0.y = __uint_as_float(w.x & 0xffff0000u); h0.z = __uint_as_float(w.y << 16); h0.w = __uint_as_float(w.y & 0xffff0000u); }
        else h0 = __builtin_nontemporal_load((const f32x4*)hin + lane + 64 * j);
        f32x4 h; h.x = h0.x + v[j].x * rstd * g.x; h.y = h0.y + v[j].y * rstd * g.y; h.z = h0.z + v[j].z * rstd * g.z; h.w = h0.w + v[j].w * rstd * g.w;
        v[j] = h; s2 += (h.x * h.x + h.y * h.y) + (h.z * h.z + h.w * h.w);
        if constexpr (HOUT_BF) { u32x2 w; w.x = pk2(h.x, h.y); w.y = pk2(h.z, h.w); __builtin_nontemporal_store(w, (u32x2*)hout + lane + 64 * j); }
        else __builtin_nontemporal_store(h, (f32x4*)hout + lane + 64 * j); }
    if (gpre) {
        const float r2 = rsqrtf(wave_sum(s2) * (1.f / DM) + RMS_EPS); const f32x4* pr = (const f32x4*)gpre + lane; u32x2* o8 = (u32x2*)urow + lane;
#pragma unroll
        for (int j = 0; j < 16; ++j) { const f32x4 g = pr[64 * j]; u32x2 w; w.x = pk2(v[j].x * r2 * g.x, v[j].y * r2 * g.y); w.y = pk2(v[j].z * r2 * g.z, v[j].w * r2 * g.w); o8[64 * j] = w; }
    }
}
template <bool HIN_BF, bool HOUT_BF>
__device__ __forceinline__ void post_phase(const bf16* y, const float* gpost, const void* hin, void* hout, const float* gpre, bf16* u) {
    const int tx_ = opaque_tid();
    const int lane = tx_ & 63, gw = blockIdx.x * NWAVES + __builtin_amdgcn_readfirstlane(tx_ >> 6), NGW = gridDim.x * NWAVES;
    const bool own = gridDim.x == 256; const int r0 = 2048 * (int)(blockIdx.x & 7) + 8 * (int)(blockIdx.x >> 3) + (gw & 7);
    for (int m0 = gw, k = 0; m0 < TOK; m0 += NGW, ++k) { const int m = own ? r0 + 256 * k : m0; post_row<HIN_BF, HOUT_BF>(y + (size_t)m * DM, gpost, (const char*)hin + (size_t)m * DM * (HIN_BF ? 2 : 4), (char*)hout + (size_t)m * DM * (HOUT_BF ? 2 : 4), gpre, u + (size_t)m * DM, lane); }
}

struct Ptrs {
    const float* in[22]; float* out; unsigned char* ws;
};

__device__ __forceinline__ void prologue_phase(const Ptrs& P, LAS unsigned char* lds) {
    const int tx_ = opaque_tid();
    const int tid = tx_, lane = tid & 63, wave = __builtin_amdgcn_readfirstlane(tid >> 6);
    LAS float* scr = (LAS float*)(lds + wave * 16384);
    const int gw = blockIdx.x * NWAVES + wave, NGW = gridDim.x * NWAVES;
    constexpr int IT_AB = 64 * 224, IT_OAB = 64 * 128, IT_C = 64 * 384, IT_OC = 64 * 128, IT_F1 = 64 * 684, IT_F2 = 171 * 128;
    constexpr int NITEMS = IT_AB + IT_OAB + IT_C + IT_OC + 2 * IT_F1 + 2 * IT_F2;
    unsigned char* ws = P.ws;
    constexpr int NITEMS_P = NITEMS - 2 * IT_F2 - IT_OC;
    for (int it = gw; it < NITEMS_P; it += NGW) {
        int r = NITEMS_P - 1 - it;
        if (r < IT_AB) { const int kb = r / 224, nb = r % 224; tr_item(P.in[3], AB_W, 64 * kb, 32 * nb, (bf16*)(ws + WS_WAB), DM, 32 * nb, scr, lane); continue; } r -= IT_AB;
        if (r < IT_OAB) { const int kb = r / 128, nb = r % 128; tr_item(P.in[11], DM, 64 * kb, 32 * nb, (bf16*)(ws + WS_WOAB), DM, 32 * nb, scr, lane); continue; } r -= IT_OAB;
        if (r < IT_C) { const int kb = r / 384, nb = r % 384; tr_item(P.in[12], C_W, 64 * kb, 32 * nb, (bf16*)(ws + WS_WC), DM, 32 * nb, scr, lane); continue; } r -= IT_C;
        if (r < 2 * IT_F1) { const int l = r / IT_F1; r -= l * IT_F1; const int kb = r / 684, nb = r % 684, n0 = 32 * nb, part = n0 >= DFF ? 1 : 0, ff = n0 - part * DFF;
            tr_item(P.in[18] + (size_t)l * DM * F1W, F1W, 64 * kb, n0, (bf16*)(ws + WS_WF1 + l * WF1_BYTES), DM, 256 * (ff >> 7) + 128 * part + (ff & 127), scr, lane); continue; } r -= 2 * IT_F1;
        { const int l = r / IT_F2; r -= l * IT_F2; const int kb = r / 128, nb = r % 128;
            tr_item(P.in[21] + (size_t)l * DFF * DM, DM, 64 * kb, 32 * nb, (bf16*)(ws + WS_WF2 + l * WF2_BYTES), FFP, 32 * nb, scr, lane); }
    }
    for (int it = gw; it < 2 * 64 * 8 + 4 * 4 * 8; it += NGW) {
        if (it < 1024) { const int which = it >> 9, r = it & 511, kb = r >> 3, nb = r & 7, p = kb >> 5;
            tr_item(P.in[which ? 9 : 7], 256, 64 * kb, 32 * nb, (bf16*)(ws + WS_WCMP), 2048, which * 512 + p * 256 + 32 * nb, scr, lane, 64 * kb - 2048 * p); }
        else { const int r = it - 1024, g = r >> 5, kb = (r >> 3) & 3, nb = r & 7;
            tr_item(P.in[4] + (size_t)g * 65536, 256, 64 * kb, 32 * nb, (bf16*)(ws + WS_WPOOL), 256, g * 256 + 32 * nb, scr, lane); }
    }
    for (int task = gw; task < 128; task += NGW) { const int which = task >> 6, jg = (task >> 4) & 3, ic = task & 15; const float* w1 = P.in[which ? 9 : 7] + (size_t)(ic * 256) * 256 + jg * 64 + lane; const float* pp = P.in[6] + ic * 256;
        float a = 0.f;
#pragma unroll 8
        for (int i = 0; i < 256; ++i) a += pp[i] * w1[(size_t)i * 256];
        ((float*)(ws + WS_CPART))[(ic * 2 + which) * 256 + jg * 64 + lane] = a; }
    const size_t gt = (size_t)blockIdx.x * 512 + tid, NT = (size_t)gridDim.x * 512;
    for (size_t i = gt; i < (size_t)2 * 128 * (DM / 8); i += NT) {
        const int l = (int)(i / (128 * 512)); const int rr = (int)(i % (128 * 512)); const int row = rr >> 9, ch = rr & 511;
        const int drow = 85 * 256 + (row >> 6) * 128 + 64 + (row & 63);
        *(u32x4*)((bf16*)(ws + WS_WF1 + l * WF1_BYTES) + (size_t)drow * DM + ch * 8) = (u32x4){0u, 0u, 0u, 0u}; }
    for (size_t i = gt; i < (size_t)2 * DM * 8; i += NT) {
        const int l = (int)(i / (DM * 8)); const int rr = (int)(i % (DM * 8)); const int row = rr >> 3, ch = rr & 7;
        *(u32x4*)((bf16*)(ws + WS_WF2 + l * WF2_BYTES) + (size_t)row * FFP + DFF + ch * 8) = (u32x4){0u, 0u, 0u, 0u}; }
    for (size_t i = gt; i < (size_t)256 * DM; i += NT) { const int rrow = (int)(i / DM), k = (int)(i % DM);
        ((bf16*)(ws + WS_WABG))[i] = rrow < 72 ? (bf16)f2bf(P.in[3][(size_t)k * AB_W + AB_N + rrow]) : (bf16)0; }
    for (size_t i = gt; i < (size_t)16 * DM; i += NT) { const int rrow = (int)(i / DM), k = (int)(i % DM);
        ((bf16*)(ws + WS_WCG))[i] = (bf16)f2bf(P.in[12][(size_t)k * C_W + C_N + rrow]); }
    for (int m = gw; m < TOK; m += NGW) rms_row_bf16(P.in[0] + (size_t)m * DM, P.in[1], (bf16*)(ws + WS_U) + (size_t)m * DM, lane);
}

template <int NT> __device__ __forceinline__ void skinny_phase(const bf16* A, const bf16* Wt, float* out, int ldo, int ncols) {
    const int tx_ = opaque_tid();
    const int lane = tx_ & 63, gw = blockIdx.x * NWAVES + __builtin_amdgcn_readfirstlane(tx_ >> 6), NGW = gridDim.x * NWAVES;
    const int fr = lane & 15, fq = lane >> 4;
    for (int task = gw; task < TOK / 16; task += NGW) {
        const int t0 = task * 16;
        f32x4 acc[NT];
#pragma unroll
        for (int n = 0; n < NT; ++n) acc[n] = (f32x4){0.f, 0.f, 0.f, 0.f};
        const bf16* ap = A + (size_t)(t0 + fr) * DM + 8 * fq; const bf16* bp = Wt + (size_t)fr * DM + 8 * fq;
#pragma unroll 4
        for (int k0 = 0; k0 < DM; k0 += 32) {
            const bf16x8 a = *(const bf16x8*)(ap + k0);
#pragma unroll
            for (int n = 0; n < NT; ++n) { const bf16x8 b = *(const bf16x8*)(bp + (size_t)n * 16 * DM + k0); acc[n] = __builtin_amdgcn_mfma_f32_16x16x32_bf16(a, b, acc[n], 0, 0, 0); }
        }
#pragma unroll
        for (int n = 0; n < NT; ++n) { const int col = n * 16 + fr; if (col < ncols) {
#pragma unroll
            for (int r = 0; r < 4; ++r) out[(size_t)(t0 + 4 * fq + r) * ldo + col] = acc[n][r]; } }
    }
}

__device__ __forceinline__ void f2_convert_tail(const Ptrs& P, int l, int bidx, int nblk, LAS unsigned char* lds) {
    const int tx_ = opaque_tid();
    const int lane = tx_ & 63, wave = __builtin_amdgcn_readfirstlane(tx_ >> 6);
    LAS float* scr = (LAS float*)(lds + wave * 16384);
    constexpr int IT_F2 = 171 * 128;
    for (int r = bidx * NWAVES + wave; r < IT_F2; r += nblk * NWAVES) { const int kb = r / 128, nb = r % 128;
        tr_item(P.in[21] + (size_t)l * DFF * DM, DM, 64 * kb, 32 * nb, (bf16*)(P.ws + WS_WF2 + l * WF2_BYTES), FFP, 32 * nb, scr, lane); }
    if (l == 0) for (int r = bidx * NWAVES + wave; r < 64 * 128; r += nblk * NWAVES) { const int kb = r / 128, nb = r % 128;
        tr_item(P.in[15], DM, 64 * kb, 32 * nb, (bf16*)(P.ws + WS_WOC), DM, 32 * nb, scr, lane); }
}

__device__ __forceinline__ void pool_naive_phase(const bf16* proj, const float* pool_w, const float* pool_scale, bf16* ymix, LAS unsigned char* lds) {
    const int tx_ = opaque_tid();
    const int tid = tx_; LAS float* pl = (LAS float*)lds;
    for (int unit = blockIdx.x; unit < 4096; unit += gridDim.x) {
        const int tt = unit >> 2, g = unit & 3, tok0 = tt * 16, w = 2 << g;
        { const int ti = tid >> 5, c8 = (tid & 31) * 8, tok = tok0 + ti, tpos = tok & (SEQ - 1), cnt = (tpos + 1 < w) ? tpos + 1 : w;
          float sum[8], cur[8];
#pragma unroll
          for (int j = 0; j < 8; ++j) sum[j] = 0.f;
          for (int j = 0; j < cnt; ++j) { float f[8]; unpack8(*(const u32x4*)(proj + (size_t)(tok - j) * AB_N + g * 256 + c8), f);
#pragma unroll
              for (int q = 0; q < 8; ++q) { sum[q] += f[q]; if (j == 0) cur[q] = f[q]; } }
          const float inv = 1.0f / (float)cnt;
#pragma unroll
          for (int q = 0; q < 8; ++q) pl[ti * 256 + c8 + q] = sum[q] * inv - cur[q]; }
        __syncthreads();
        { const int d = tid & 255, half = tid >> 8; float acc[8];
#pragma unroll
          for (int i = 0; i < 8; ++i) acc[i] = 0.f;
          const float* wp = pool_w + (size_t)g * 65536 + d;
          for (int c = 0; c < 256; ++c) { const float wv = wp[(size_t)c * 256];
#pragma unroll
              for (int i = 0; i < 8; ++i) acc[i] += pl[(half * 8 + i) * 256 + c] * wv; }
          const float sc = pool_scale[g * 256 + d];
#pragma unroll
          for (int i = 0; i < 8; ++i) ymix[(size_t)(tok0 + half * 8 + i) * DM + g * 256 + d] = (bf16)f2bf(acc[i] * sc); }
        __syncthreads();
    }
}
__device__ __forceinline__ float gelu_tanh(float x) { const float u = 0.7978845608028654f * (x + 0.044715f * x * x * x); return 0.5f * x * (1.0f + tanhf(u)); }
__device__ __forceinline__ void compress_naive_phase(const bf16* proj, const float* pos, const float* kw1, const float* kw2, const float* vw1, const float* vw2, bf16* kcmp, bf16* vcmp, bf16* vct, LAS unsigned char* lds) {
    const int tx_ = opaque_tid();
    const int tid = tx_;
    LAS float* flat = (LAS float*)lds;
    LAS float* part = flat + 4 * 4096;
    LAS float* hid = part + 2 * 4 * 256;
    for (int unit = blockIdx.x; unit < 2048; unit += gridDim.x) {
        const int which = unit >> 10, b = (unit >> 9) & 1, g = (unit >> 7) & 3, ng = unit & 127;
        const float* w1 = which ? vw1 : kw1; const float* w2 = which ? vw2 : kw2; bf16* outp = which ? vcmp : kcmp;
        const int col0 = (which ? 4608 : 4096) + g * 128;
        for (int i = tid; i < 4 * 4096; i += 512) { const int nn = i >> 12, r = i & 4095, l = r >> 7, d = r & 127, n = 4 * ng + nn;
            float v = 0.f; if (n <= 510) v = bf2f(proj[(size_t)(b * SEQ + 16 * n + l) * AB_N + col0 + d]) + pos[l * 128 + d];
            flat[i] = v; }
        __syncthreads();
        { const int j = tid & 255, ih = tid >> 8; float a0 = 0.f, a1 = 0.f, a2 = 0.f, a3 = 0.f;
          const float* wp = w1 + (size_t)(ih * 2048) * 256 + j; const LAS float* fp = flat + ih * 2048;
          for (int i = 0; i < 2048; ++i) { const float wv = wp[(size_t)i * 256]; a0 += fp[i] * wv; a1 += fp[4096 + i] * wv; a2 += fp[8192 + i] * wv; a3 += fp[12288 + i] * wv; }
          part[(ih * 4 + 0) * 256 + j] = a0; part[(ih * 4 + 1) * 256 + j] = a1; part[(ih * 4 + 2) * 256 + j] = a2; part[(ih * 4 + 3) * 256 + j] = a3; }
        __syncthreads();
        for (int i = tid; i < 1024; i += 512) hid[i] = gelu_tanh(part[i] + part[1024 + i]);
        __syncthreads();
        { const int dd = tid & 127, nn = tid >> 7, n = 4 * ng + nn; float o = 0.f;
          for (int j = 0; j < 256; ++j) o += hid[nn * 256 + j] * w2[j * 128 + dd];
          const bf16 ob = (n <= 510) ? (bf16)f2bf(o) : (bf16)0;
          outp[((size_t)(b * 4 + g) * 512 + n) * 128 + dd] = ob;
          if (which) { const int kap = n & 31, ppos = 8 * ((kap & 15) >> 2) + (kap & 3) + 4 * (kap >> 4); vct[((((size_t)(b * 4 + g) * 16 + (n >> 5)) * 128 + dd) << 5) + ppos] = ob; } }
        __syncthreads();
    }
}

__device__ __forceinline__ void dot6(const bf16* krow, const LAS float* qs, float (&s)[6]) {
#pragma unroll
    for (int h = 0; h < 6; ++h) s[h] = 0.f;
#pragma unroll 4
    for (int c = 0; c < 16; ++c) { float kf[8]; unpack8(*(const u32x4*)(krow + 8 * c), kf);
#pragma unroll
        for (int h = 0; h < 6; ++h) { const f32x4 qa = *(const LAS f32x4*)(qs + h * 128 + 8 * c), qb = *(const LAS f32x4*)(qs + h * 128 + 8 * c + 4);
            s[h] += (kf[0] * qa.x + kf[1] * qa.y) + (kf[2] * qa.z + kf[3] * qa.w) + (kf[4] * qb.x + kf[5] * qb.y) + (kf[6] * qb.z + kf[7] * qb.w); } }
}
__device__ __forceinline__ void attn_block(const bf16* kbase, const bf16* vbase, int pos0, int lo, int hi, const LAS float* qs, LAS float* pb, int lane, float (&m)[6], float (&l)[6], float (&o)[6][2]) {
    const int pos = pos0 + lane; const bool valid = (pos >= lo && pos <= hi);
    float s[6];
    if (valid) dot6(kbase + (size_t)pos * AB_N, qs, s);
#pragma unroll
    for (int h = 0; h < 6; ++h) { const float sv = valid ? s[h] : NEGF; const float bm = wave_max(sv), mn = fmaxf(m[h], bm), alpha = __expf(m[h] - mn), p = valid ? __expf(sv - mn) : 0.f;
        l[h] = l[h] * alpha + wave_sum(p); m[h] = mn; o[h][0] *= alpha; o[h][1] *= alpha; pb[h * 64 + lane] = p; }
    LDS_WAIT();
    const int kmin = (lo - pos0) > 0 ? (lo - pos0) : 0, kmax = (hi - pos0) < 63 ? (hi - pos0) : 63;
    for (int k = kmin; k <= kmax; ++k) { const unsigned v2 = *(const unsigned*)(vbase + (size_t)(pos0 + k) * AB_N + 2 * lane); const float v0 = bf2f(v2 & 0xffffu), v1 = __uint_as_float(v2 & 0xffff0000u);
#pragma unroll
        for (int h = 0; h < 6; ++h) { const float p = pb[h * 64 + k]; o[h][0] += p * v0; o[h][1] += p * v1; } }
    LDS_WAIT();
}
__device__ __forceinline__ void nsa_naive_phase(const bf16* proj, const bf16* kcmp, const bf16* vcmp, const float* glog, bf16* ymix, LAS unsigned char* lds) {
    const int tx_ = opaque_tid();
    const int lane = tx_ & 63, wave = __builtin_amdgcn_readfirstlane(tx_ >> 6);
    LAS float* qs = (LAS float*)(lds + wave * 17536);
    LAS float* sc = qs + 768;
    LAS float* imp = sc + 3072;
    LAS float* pb = imp + 128;
    LAS int* sel = (LAS int*)(pb + 384);
    const int gw = blockIdx.x * NWAVES + wave, NGW = gridDim.x * NWAVES;
    for (int item = gw; item < 65536; item += NGW) {
        const int t = item >> 3, b = (item >> 2) & 1, g = item & 3;
        const size_t tok = (size_t)b * SEQ + t;
        const bf16* prow = proj + tok * AB_N;
#pragma unroll
        for (int j = 0; j < 12; ++j) { const int idx = lane + 64 * j, h = idx >> 7, d = idx & 127; qs[idx] = bf2f(prow[1024 + (g * 6 + h) * 128 + d]) * 0.08838834764831845f; }
        imp[lane] = 0.f; imp[lane + 64] = 0.f;
        LDS_WAIT();
        float oc[6][2];
#pragma unroll
        for (int h = 0; h < 6; ++h) { oc[h][0] = 0.f; oc[h][1] = 0.f; }
        const int ncv = (t >= 31) ? ((t - 31) >> 4) + 1 : 0;
        if (ncv > 0) {
            const bf16* kc = kcmp + (size_t)(b * 4 + g) * 512 * 128; const bf16* vc = vcmp + (size_t)(b * 4 + g) * 512 * 128;
            float mx[6], sm[6];
#pragma unroll
            for (int h = 0; h < 6; ++h) { mx[h] = NEGF; sm[h] = 0.f; }
            for (int n0 = 0; n0 < ncv; n0 += 64) { const int n = n0 + lane; if (n < ncv) { float s[6]; dot6(kc + (size_t)n * 128, qs, s);
#pragma unroll
                for (int h = 0; h < 6; ++h) { sc[h * 512 + n] = s[h]; mx[h] = fmaxf(mx[h], s[h]); } } }
#pragma unroll
            for (int h = 0; h < 6; ++h) mx[h] = wave_max(mx[h]);
            LDS_WAIT();
            for (int n0 = 0; n0 < ncv; n0 += 64) { const int n = n0 + lane; if (n < ncv) {
#pragma unroll
                for (int h = 0; h < 6; ++h) { const float e = __expf(sc[h * 512 + n] - mx[h]); sc[h * 512 + n] = e; sm[h] += e; } } }
#pragma unroll
            for (int h = 0; h < 6; ++h) sm[h] = 1.0f / wave_sum(sm[h]);
            LDS_WAIT();
            for (int n0 = 0; n0 < ncv; n0 += 64) { const int n = n0 + lane; if (n < ncv) {
#pragma unroll
                for (int h = 0; h < 6; ++h) sc[h * 512 + n] *= sm[h]; } }
            LDS_WAIT();
#pragma unroll
            for (int jj = 0; jj < 2; ++jj) { const int j = lane + 64 * jj; float a = 0.f;
#pragma unroll
                for (int i = 0; i < 5; ++i) { const int n = 4 * j - 1 + i; if (n >= 0 && n < ncv) { const float wgt = (i == 0 || i == 4) ? 1.0f : 2.0f;
#pragma unroll
                    for (int h = 0; h < 6; ++h) a += wgt * sc[h * 512 + n]; } }
                imp[j] = a; }
            for (int n = 0; n < ncv; ++n) { const unsigned v2 = *(const unsigned*)(vc + (size_t)n * 128 + 2 * lane); const float v0 = bf2f(v2 & 0xffffu), v1 = __uint_as_float(v2 & 0xffff0000u);
#pragma unroll
                for (int h = 0; h < 6; ++h) { const float p = sc[h * 512 + n]; oc[h][0] += p * v0; oc[h][1] += p * v1; } }
            LDS_WAIT();
        }
        const int cur = t >> 6; int nsel;
        if (cur < 16) { nsel = cur + 1; if (lane < nsel) sel[lane] = lane; }
        else {
            if (lane == 0) { sel[0] = 0; sel[1] = cur - 1; sel[2] = cur; }
            int cnt = 3;
#pragma unroll
            for (int jj = 0; jj < 2; ++jj) { const int j = lane + 64 * jj; const bool cand = (j >= 1 && j <= cur - 2); const float mv = cand ? imp[j] : 0.f; int rank = 0;
                for (int k = 1; k <= cur - 2; ++k) { const float ov = imp[k]; rank += ((ov > mv) || (ov == mv && k < j)) ? 1 : 0; }
                const bool pick = cand && rank < 13;
                const unsigned long long bm = __ballot(pick); const int posi = cnt + __popcll(bm & ((1ull << lane) - 1ull)); if (pick) sel[posi] = j; cnt += __popcll(bm); }
            nsel = cnt;
        }
        LDS_WAIT();
        const bf16* seqbase = proj + (size_t)b * SEQ * AB_N;
        float ms[6], ls[6], os[6][2];
#pragma unroll
        for (int h = 0; h < 6; ++h) { ms[h] = NEGF; ls[h] = 0.f; os[h][0] = 0.f; os[h][1] = 0.f; }
        for (int i = 0; i < nsel; ++i) { const int j = sel[i]; attn_block(seqbase + 5120 + g * 128, seqbase + 5632 + g * 128, 64 * j, 0, t, qs, pb, lane, ms, ls, os); }
        float mw[6], lw[6], ow[6][2];
#pragma unroll
        for (int h = 0; h < 6; ++h) { mw[h] = NEGF; lw[h] = 0.f; ow[h][0] = 0.f; ow[h][1] = 0.f; }
        const int lo = (t - 511) > 0 ? (t - 511) : 0;
        for (int p0 = lo & ~63; p0 <= t; p0 += 64) attn_block(seqbase + 6144 + g * 128, seqbase + 6656 + g * 128, p0, lo, t, qs, pb, lane, mw, lw, ow);
#pragma unroll
        for (int h = 0; h < 6; ++h) { const float* gl = glog + tok * 72 + (g * 6 + h) * 3; const float g0 = sigmoidf_(gl[0] + gl[GLOG_P2]), g1 = sigmoidf_(gl[1] + gl[GLOG_P2 + 1]) / ls[h], g2 = sigmoidf_(gl[2] + gl[GLOG_P2 + 2]) / lw[h];
            const float r0 = g0 * oc[h][0] + g1 * os[h][0] + g2 * ow[h][0], r1 = g0 * oc[h][1] + g1 * os[h][1] + g2 * ow[h][1];
            *(unsigned*)(ymix + tok * DM + 1024 + (g * 6 + h) * 128 + 2 * lane) = pk2(r0, r1); }
    }
}


__device__ __forceinline__ void p2a_phase(const bf16* proj, bf16* pooled, bf16* kcr) {
    const int tx_ = opaque_tid();
    const size_t gt = (size_t)blockIdx.x * 512 + tx_, NT = (size_t)gridDim.x * 512;
    for (size_t it = gt; it < (size_t)TOK * 128; it += NT) {
        const int tok = (int)(it >> 7), chk = (int)(it & 127), g = chk >> 5, c8 = (chk & 31) * 8, w = 2 << g, tpos = tok & (SEQ - 1), cnt = (tpos + 1 < w) ? tpos + 1 : w;
        float sum[8], cur[8];
#pragma unroll
        for (int q = 0; q < 8; ++q) { sum[q] = 0.f; cur[q] = 0.f; }
        for (int j = 0; j < cnt; ++j) { float f[8]; unpack8(*(const u32x4*)(proj + (size_t)(tok - j) * AB_N + g * 256 + c8), f);
#pragma unroll
            for (int q = 0; q < 8; ++q) { sum[q] += f[q]; if (j == 0) cur[q] = f[q]; } }
        const float inv = 1.0f / (float)cnt; u32x4 o;
        o.x = pk2(sum[0] * inv - cur[0], sum[1] * inv - cur[1]); o.y = pk2(sum[2] * inv - cur[2], sum[3] * inv - cur[3]); o.z = pk2(sum[4] * inv - cur[4], sum[5] * inv - cur[5]); o.w = pk2(sum[6] * inv - cur[6], sum[7] * inv - cur[7]);
        *(u32x4*)(pooled + ((size_t)g * TOK + tok) * 256 + c8) = o; }
    for (size_t it = gt; it < (size_t)2 * TOK * 4 * 16; it += NT) {
        const int ch = (int)(it & 15), g = (int)((it >> 4) & 3), tok = (int)((it >> 6) & (TOK - 1)), which = (int)(it >> 20), b = tok >> 13, t = tok & (SEQ - 1);
        *(u32x4*)(kcr + (((size_t)which * 8 + b * 4 + g) * SEQ + t) * 128 + ch * 8) = *(const u32x4*)(proj + (size_t)tok * AB_N + 4096 + which * 512 + g * 128 + ch * 8); }
}
__device__ __forceinline__ void p2c_phase(const float* pcmp, const float* cpart, const float* kw2, const float* vw2, bf16* kcmp, bf16* vct, bf16* kcf, bf16* vcmp_dbg, LAS unsigned char* lds) {
    const int tx_ = opaque_tid();
    const int tid = tx_, G = gridDim.x, half = G >> 1; const bool own = G == 256;
    const int which = own ? (int)(blockIdx.x >> 7) : ((int)blockIdx.x >= half ? 1 : 0), lb = own ? (int)(blockIdx.x >> 3) & 15 : (int)blockIdx.x - which * half;
    const int ustep = own ? 16 : half, uend = own ? 128 : 1022, bgo = (int)(blockIdx.x & 7);
    LAS float* w2s = (LAS float*)lds;
    LAS float* hid = w2s + 256 * 128;
    LAS float* cs = hid + 1024;
    const float* w2 = which ? vw2 : kw2;
    for (int i = tid; i < 256 * 128; i += 512) w2s[i] = w2[i];
    if (tid < 256) { float a = 0.f;
#pragma unroll
        for (int ic = 0; ic < 16; ++ic) a += cpart[(ic * 2 + which) * 256 + tid];
        cs[tid] = a; }
    __syncthreads();
    for (int u = lb; u < uend; u += ustep) {
        for (int i = tid; i < 1024; i += 512) { const int nn = i >> 8, j = i & 255, R = 4 * u + nn, bg = own ? bgo : R / 511, n0 = own ? R : R - bg * 511, n = n0 < 511 ? n0 : 510; const size_t row = (size_t)which * 4096 + bg * 512 + n;
            hid[i] = gelu_tanh(cs[j] + pcmp[row * 512 + j] + pcmp[(row + 1) * 512 + 256 + j]); }
        __syncthreads();
        { const int dd = tid & 127, nn = tid >> 7, R = 4 * u + nn, bg = own ? bgo : R / 511, n = own ? R : R - bg * 511; float o = 0.f;
#pragma unroll 8
          for (int j = 0; j < 256; ++j) o += hid[nn * 256 + j] * w2s[j * 128 + dd];
          const bf16 ob = (bf16)f2bf(o);
          if (n >= 511) { }
          else if (which == 0) { kcmp[((size_t)bg * 512 + n) * 128 + dd] = ob; kcf[((((size_t)(bg * 16 + (n >> 5)) * 2 + ((n >> 4) & 1)) * 4 + (dd >> 5)) * 64 + ((dd >> 3) & 3) * 16 + (n & 15)) * 8 + (dd & 7)] = ob; }
          else { const int kap = n & 31, ppos = 8 * ((kap & 15) >> 2) + (kap & 3) + 4 * (kap >> 4); vct[((((size_t)bg * 16 + (n >> 5)) * 128 + dd) << 5) + ppos] = ob;
              if (vcmp_dbg) vcmp_dbg[((size_t)bg * 512 + n) * 128 + dd] = ob; } }
        __syncthreads();
    }
    if (lb == 0) for (int i = tid; i < (own ? 128 : 8 * 128); i += 512) { const int bg = own ? bgo : i >> 7, dd = i & 127;
        if (which == 0) { kcmp[((size_t)bg * 512 + 511) * 128 + dd] = (bf16)0; kcf[((((size_t)(bg * 16 + 15) * 2 + 1) * 4 + (dd >> 5)) * 64 + ((dd >> 3) & 3) * 16 + 15) * 8 + (dd & 7)] = (bf16)0; } else vct[((((size_t)bg * 16 + 15) * 128 + dd) << 5) + 31] = (bf16)0; }
}

__device__ __forceinline__ void vt_relayout_phase(const bf16* proj, bf16* vts, bf16* vtw, bf16* kfs, bf16* kfw, LAS unsigned char* lds) {
    const int tx_ = opaque_tid();
    const int lane = tx_ & 63, wave = __builtin_amdgcn_readfirstlane(tx_ >> 6);
    LAS bf16* tile = (LAS bf16*)(lds + wave * 8704);
    const int gw = blockIdx.x * NWAVES + wave, NGW = gridDim.x * NWAVES;
    for (int task = gw; task < 4096; task += NGW) {
        const int which = task >> 11, b = (task >> 10) & 1, g = (task >> 8) & 3, step = task & 255;
        const bf16* src = proj + (size_t)(b * SEQ + step * 32) * AB_N + (which ? 6656 : 5632) + g * 128;
#pragma unroll
        for (int i = 0; i < 8; ++i) { const int idx = lane + 64 * i, r = idx >> 4, ch = idx & 15; *(LAS u32x4*)(tile + r * 136 + ch * 8) = *(const u32x4*)(src + (size_t)r * AB_N + ch * 8); }
        LDS_WAIT();
        bf16* dst = (which ? vtw : vts) + (((size_t)(b * 4 + g) * 256 + step) * 128) * 32;
#pragma unroll
        for (int dd = 0; dd < 2; ++dd) { const int d = lane + 64 * dd; unsigned w[16];
#pragma unroll
            for (int pp = 0; pp < 16; ++pp) { const int p0 = 2 * pp, q = p0 >> 3, j = p0 & 7, k0 = (j < 4) ? 4 * q + j : 16 + 4 * q + j - 4;
                w[pp] = (unsigned)tile[k0 * 136 + d] | ((unsigned)tile[(k0 + 1) * 136 + d] << 16); }
#pragma unroll
            for (int c4 = 0; c4 < 4; ++c4) *(u32x4*)(dst + (size_t)d * 32 + c4 * 8) = (u32x4){w[4 * c4], w[4 * c4 + 1], w[4 * c4 + 2], w[4 * c4 + 3]}; }
        LDS_WAIT();
        const bf16* ksrc = proj + (size_t)(b * SEQ + step * 32) * AB_N + (which ? 6144 : 5120) + g * 128;
        bf16* kdst = (which ? kfw : kfs) + ((size_t)(b * 4 + g) * 256 + step) * 4096;
#pragma unroll
        for (int tl = 0; tl < 2; ++tl)
#pragma unroll
            for (int sk = 0; sk < 4; ++sk) *(u32x4*)(kdst + ((tl * 4 + sk) * 64 + lane) * 8) = *(const u32x4*)(ksrc + (size_t)(16 * tl + (lane & 15)) * AB_N + 32 * sk + 8 * (lane >> 4));
    }
}

#define MFMA16(a, b, c) __builtin_amdgcn_mfma_f32_16x16x32_bf16((a), (b), (c), 0, 0, 0)
__device__ __forceinline__ void nsa_qk32(const bf16* k0, size_t tile_stride, const bf16x8 (&qf)[4], int qd, f32x4& s0, f32x4& s1) {
    bf16x8 a0[4], a1[4];
#pragma unroll
    for (int s = 0; s < 4; ++s) { a0[s] = *(const bf16x8*)(k0 + 32 * s + 8 * qd); a1[s] = *(const bf16x8*)(k0 + tile_stride + 32 * s + 8 * qd); }
    s0 = (f32x4){0.f, 0.f, 0.f, 0.f}; s1 = (f32x4){0.f, 0.f, 0.f, 0.f};
#pragma unroll
    for (int s = 0; s < 4; ++s) { s0 = MFMA16(a0[s], qf[s], s0); s1 = MFMA16(a1[s], qf[s], s1); }
}
__device__ __forceinline__ void nsa_pv32(const bf16* vt, int fr, int qd, const bf16x8 pf, f32x4 (&O)[8]) {
#pragma unroll
    for (int dt = 0; dt < 8; ++dt) { const bf16x8 a = *(const bf16x8*)(vt + (size_t)(16 * dt + fr) * 32 + 8 * qd); O[dt] = MFMA16(a, pf, O[dt]); }
}
__device__ __forceinline__ bf16x8 nsa_pack(const float (&p)[8]) {
    u32x4 w; w.x = pg8::cvt_pk_bf16(p[0], p[1]); w.y = pg8::cvt_pk_bf16(p[2], p[3]); w.z = pg8::cvt_pk_bf16(p[4], p[5]); w.w = pg8::cvt_pk_bf16(p[6], p[7]);
    return __builtin_bit_cast(bf16x8, w);
}
__device__ __forceinline__ void nsa_step(const bf16* k0, size_t tile_stride, const bf16* vt, const bf16x8 (&qf)[4], int fr, int qd, int pos0, int lo, int hi, bool en, float& m, float& l, f32x4 (&O)[8]) {
    constexpr float SC = 0.08838834764831845f * 1.4426950408889634f;
    f32x4 s0, s1; nsa_qk32(k0, tile_stride, qf, qd, s0, s1);
    float x[8]; bool v[8]; float lm = NEGF;
#pragma unroll
    for (int i = 0; i < 8; ++i) { const int pos = pos0 + 16 * (i >> 2) + 4 * qd + (i & 3); v[i] = en && pos >= lo && pos <= hi; x[i] = ((i < 4) ? s0[i & 3] : s1[i & 3]) * SC; lm = v[i] ? fmaxf(lm, x[i]) : lm; }
    lm = fmaxf(lm, __shfl_xor(lm, 16)); lm = fmaxf(lm, __shfl_xor(lm, 32));
    if (__any(lm > m + 8.0f)) { const float mn = fmaxf(m, lm), alpha = __builtin_amdgcn_exp2f(m - mn); l *= alpha; m = mn;
#pragma unroll
        for (int dt = 0; dt < 8; ++dt) O[dt] *= alpha; }
    float p[8]; float ps = 0.f;
#pragma unroll
    for (int i = 0; i < 8; ++i) { p[i] = v[i] ? __builtin_amdgcn_exp2f(x[i] - m) : 0.f; ps += p[i]; }
    l += ps;
    nsa_pv32(vt, fr, qd, nsa_pack(p), O);
}
__device__ __forceinline__ void nsa_fast_phase(const bf16* proj, const bf16* kcmp, const bf16* vct, const bf16* vts, const bf16* vtw, const float* glog, bf16* ymix, LAS unsigned char* lds) {
    const int tx_ = opaque_tid();
    constexpr float SC = 0.08838834764831845f * 1.4426950408889634f;
    const int lane = tx_ & 63, wave = __builtin_amdgcn_readfirstlane(tx_ >> 6), fr = lane & 15, qd = lane >> 4;
    LAS float* imp = (LAS float*)(lds + wave * 2048);
    const int gw = blockIdx.x * NWAVES + wave, NGW = gridDim.x * NWAVES;
    const int qi = fr >= 6 ? 1 : 0, hd = fr - 6 * qi; const bool cv = fr < 12;
    for (int item = gw; item < 32768; item += NGW) {
        const int tp = item >> 3, b = (item >> 2) & 1, g = item & 3, tA = 2 * tp, tB = tA + 1, tq = tA + qi;
        const size_t tokq = (size_t)b * SEQ + tq; const int bg = b * 4 + g;
        bf16x8 qf[4];
#pragma unroll
        for (int s = 0; s < 4; ++s) qf[s] = cv ? *(const bf16x8*)(proj + tokq * AB_N + 1024 + (g * 6 + hd) * 128 + 32 * s + 8 * qd) : (bf16x8){0, 0, 0, 0, 0, 0, 0, 0};
        float gt0 = 0.f, gt1 = 0.f, gt2 = 0.f;
        if (cv) { const float* gl = glog + tokq * 72 + (g * 6 + hd) * 3; gt0 = sigmoidf_(gl[0] + gl[GLOG_P2]); gt1 = sigmoidf_(gl[1] + gl[GLOG_P2 + 1]); gt2 = sigmoidf_(gl[2] + gl[GLOG_P2 + 2]); }
        f32x4 outacc[8];
#pragma unroll
        for (int dt = 0; dt < 8; ++dt) outacc[dt] = (f32x4){0.f, 0.f, 0.f, 0.f};
        for (int i = lane; i < 272; i += 64) imp[i] = 0.f;
        LDS_WAIT();
        const int ncvB = (tB >= 31) ? ((tB - 31) >> 4) + 1 : 0;
        const int ncvq = cv ? ((tq >= 31) ? ((tq - 31) >> 4) + 1 : 0) : 0;
        if (ncvB > 0) {
            const bf16* kc = kcmp + (size_t)bg * 512 * 128 + (size_t)fr * 128;
            float m = NEGF, l = 0.f;
            for (int n0 = 0; n0 < ncvB; n0 += 32) {
                f32x4 s0, s1; nsa_qk32(kc + (size_t)n0 * 128, 16 * 128, qf, qd, s0, s1);
                float x[8]; bool v[8]; float lm = NEGF;
#pragma unroll
                for (int i = 0; i < 8; ++i) { const int n = n0 + 16 * (i >> 2) + 4 * qd + (i & 3); v[i] = n < ncvq; x[i] = ((i < 4) ? s0[i & 3] : s1[i & 3]) * SC; lm = v[i] ? fmaxf(lm, x[i]) : lm; }
                lm = fmaxf(lm, __shfl_xor(lm, 16)); lm = fmaxf(lm, __shfl_xor(lm, 32));
                if (__any(lm > m + 8.0f)) { const float mn = fmaxf(m, lm); l *= __builtin_amdgcn_exp2f(m - mn); m = mn; }
#pragma unroll
                for (int i = 0; i < 8; ++i) l += v[i] ? __builtin_amdgcn_exp2f(x[i] - m) : 0.f;
            }
            l += __shfl_xor(l, 16); l += __shfl_xor(l, 32);
            const float invl = l > 0.f ? 1.0f / l : 0.f;
            f32x4 O[8];
#pragma unroll
            for (int dt = 0; dt < 8; ++dt) O[dt] = (f32x4){0.f, 0.f, 0.f, 0.f};
            for (int n0 = 0; n0 < ncvB; n0 += 32) {
                f32x4 s0, s1; nsa_qk32(kc + (size_t)n0 * 128, 16 * 128, qf, qd, s0, s1);
                float p[8];
#pragma unroll
                for (int i = 0; i < 8; ++i) { const int n = n0 + 16 * (i >> 2) + 4 * qd + (i & 3); const float xv = ((i < 4) ? s0[i & 3] : s1[i & 3]) * SC; p[i] = (n < ncvq) ? __builtin_amdgcn_exp2f(xv - m) * invl : 0.f; }
                if (cv) {
#pragma unroll
                    for (int tl = 0; tl < 2; ++tl) { const int j = ((n0 + 16 * tl) >> 2) + qd; const float a = 2.0f * (p[4 * tl] + p[4 * tl + 1] + p[4 * tl + 2]) + p[4 * tl + 3];
                        __hip_atomic_fetch_add(imp + qi * 136 + j, a, __ATOMIC_RELAXED, __HIP_MEMORY_SCOPE_WORKGROUP); __hip_atomic_fetch_add(imp + qi * 136 + j + 1, p[4 * tl + 3], __ATOMIC_RELAXED, __HIP_MEMORY_SCOPE_WORKGROUP); } }
                nsa_pv32(vct + (((size_t)bg * 16 + (n0 >> 5)) * 128) * 32, fr, qd, nsa_pack(p), O);
            }
#pragma unroll
            for (int dt = 0; dt < 8; ++dt) outacc[dt] += gt0 * O[dt];
        }
        LDS_WAIT();
        unsigned long long mA0, mA1, mB0, mB1;
#pragma unroll
        for (int qq = 0; qq < 2; ++qq) { const int t = tA + qq, cur = t >> 6; unsigned long long s0m, s1m;
            if (cur < 16) { s0m = (2ull << cur) - 1ull; s1m = 0ull; }
            else { const LAS float* im = imp + qq * 136; const int j0 = lane, j1 = lane + 64; const bool c0 = (j0 >= 1 && j0 <= cur - 2), c1 = (j1 <= cur - 2);
                const float v0 = im[j0], v1 = im[j1]; int r0 = 0, r1 = 0;
                for (int k = 1; k <= cur - 2; ++k) { const float ov = im[k]; r0 += ((ov > v0) || (ov == v0 && k < j0)) ? 1 : 0; r1 += ((ov > v1) || (ov == v1 && k < j1)) ? 1 : 0; }
                s0m = __ballot(c0 && r0 < 13); s1m = __ballot(c1 && r1 < 13);
                s0m |= 1ull; { const int f1 = cur - 1; if (f1 < 64) s0m |= 1ull << f1; else s1m |= 1ull << (f1 - 64); if (cur < 64) s0m |= 1ull << cur; else s1m |= 1ull << (cur - 64); } }
            if (qq == 0) { mA0 = s0m; mA1 = s1m; } else { mB0 = s0m; mB1 = s1m; } }
        const unsigned long long my0 = qi ? mB0 : mA0, my1 = qi ? mB1 : mA1;
        const bf16* seqk = proj + (size_t)b * SEQ * AB_N + (size_t)fr * AB_N + g * 128;
        { float m = NEGF, l = 0.f; f32x4 O[8];
#pragma unroll
          for (int dt = 0; dt < 8; ++dt) O[dt] = (f32x4){0.f, 0.f, 0.f, 0.f};
          const int hiq = cv ? tq : -1;
#pragma unroll
          for (int w = 0; w < 2; ++w) { unsigned long long u = w ? (mA1 | mB1) : (mA0 | mB0); const unsigned long long mine = w ? my1 : my0;
              while (u) { const int bit = __ffsll((long long)u) - 1; u &= u - 1ull; const int j = 64 * w + bit; const bool en = (mine >> bit) & 1ull;
#pragma unroll
                  for (int hf = 0; hf < 2; ++hf) { const int pos0 = 64 * j + 32 * hf; if (pos0 > tB) break;
                      nsa_step(seqk + (size_t)pos0 * AB_N + 5120, (size_t)16 * AB_N, vts + (((size_t)bg * 256 + (pos0 >> 5)) * 128) * 32, qf, fr, qd, pos0, 0, hiq, en, m, l, O); } } }
          l += __shfl_xor(l, 16); l += __shfl_xor(l, 32);
          const float cf = l > 0.f ? gt1 / l : 0.f;
#pragma unroll
          for (int dt = 0; dt < 8; ++dt) outacc[dt] += cf * O[dt]; }
        { float m = NEGF, l = 0.f; f32x4 O[8];
#pragma unroll
          for (int dt = 0; dt < 8; ++dt) O[dt] = (f32x4){0.f, 0.f, 0.f, 0.f};
          const int hiq = cv ? tq : -1, loq = tq - 511; const int lo0 = (tA - 511) > 0 ? (tA - 511) : 0;
          for (int pos0 = lo0 & ~31; pos0 <= tB; pos0 += 32)
              nsa_step(seqk + (size_t)pos0 * AB_N + 6144, (size_t)16 * AB_N, vtw + (((size_t)bg * 256 + (pos0 >> 5)) * 128) * 32, qf, fr, qd, pos0, loq, hiq, true, m, l, O);
          l += __shfl_xor(l, 16); l += __shfl_xor(l, 32);
          const float cf = l > 0.f ? gt2 / l : 0.f;
#pragma unroll
          for (int dt = 0; dt < 8; ++dt) outacc[dt] += cf * O[dt]; }
        if (cv) { bf16* op = ymix + tokq * DM + 1024 + (g * 6 + hd) * 128 + 4 * qd;
#pragma unroll
            for (int dt = 0; dt < 8; ++dt) { u32x2 w; w.x = pk2(outacc[dt][0], outacc[dt][1]); w.y = pk2(outacc[dt][2], outacc[dt][3]); *(u32x2*)(op + 16 * dt) = w; } }
    }
}

struct NsaCtx { const bf16* kb; const bf16* vb; int klane, vlane, p0, lo, hi, qi; const LAS int* list; };
template <int BR> __device__ __forceinline__ void nsa_desc(const NsaCtx& X, int i, int& pos0, bool& en) {
    if (BR == 2) { const int e = __builtin_amdgcn_readfirstlane(X.list[i]); pos0 = e & 0xffff; en = ((e >> (30 + X.qi)) & 1) != 0; } else { pos0 = X.p0 + 32 * i; en = true; }
}
template <int BR> __device__ __forceinline__ void nsa_load(const NsaCtx& X, int i, int n, bf16x8 (&k0)[4], bf16x8 (&k1)[4], bf16x8 (&vf)[8]) {
    int pos0; bool en; nsa_desc<BR>(X, i < n ? i : n - 1, pos0, en);
    int kl = X.klane, vl = X.vlane; asm volatile("" : "+v"(kl), "+v"(vl));
    const bf16* kp = X.kb + (size_t)(pos0 >> 5) * 4096;
    const int kl1 = kl + 2048;
#pragma unroll
    for (int s = 0; s < 4; ++s) { k0[s] = *(const bf16x8*)(kp + (kl + 512 * s)); k1[s] = *(const bf16x8*)(kp + (kl1 + 512 * s)); }
    if (BR != 0) { const bf16* vp = X.vb + (size_t)(pos0 >> 5) * 4096;
        const int vl1 = vl + 2048;
#pragma unroll
        for (int dt = 0; dt < 4; ++dt) { vf[dt] = *(const bf16x8*)(vp + (vl + dt * 512)); vf[dt + 4] = *(const bf16x8*)(vp + (vl1 + dt * 512)); } }
}
template <int BR> __device__ __forceinline__ void nsa_compute(const NsaCtx& X, int i, int n, int fr, int qd, bool cv, const LAS bf16x8* qfl, const bf16x8 (&k0)[4], const bf16x8 (&k1)[4], const bf16x8 (&vf)[8],
                                                             float& m, float& l, f32x4 (&O)[8], LAS float* imp) {
    constexpr float SC = 0.08838834764831845f * 1.4426950408889634f;
    int pos0; bool en; nsa_desc<BR>(X, i < n ? i : n - 1, pos0, en); en = en && (i < n);
    f32x4 s0 = (f32x4){0.f, 0.f, 0.f, 0.f}, s1 = (f32x4){0.f, 0.f, 0.f, 0.f};
#pragma unroll
    for (int s = 0; s < 4; ++s) { const bf16x8 qv = qfl[s * 64]; s0 = MFMA16(k0[s], qv, s0); s1 = MFMA16(k1[s], qv, s1); }
    float x[8]; bool v[8]; float lm = NEGF;
#pragma unroll
    for (int e = 0; e < 8; ++e) { const int pos = pos0 + 16 * (e >> 2) + 4 * qd + (e & 3); v[e] = en && pos >= X.lo && pos <= X.hi; x[e] = ((e < 4) ? s0[e & 3] : s1[e & 3]) * SC; lm = v[e] ? fmaxf(lm, x[e]) : lm; }
    float p[8];
    if (BR == 1) {
#pragma unroll
        for (int e = 0; e < 8; ++e) p[e] = v[e] ? __builtin_amdgcn_exp2f(x[e] - m) * l : 0.f;
        if (cv) {
#pragma unroll
            for (int tl = 0; tl < 2; ++tl) { const int j = ((pos0 + 16 * tl) >> 2) + qd; const float a = 2.0f * (p[4 * tl] + p[4 * tl + 1] + p[4 * tl + 2]) + p[4 * tl + 3];
                __hip_atomic_fetch_add(imp + X.qi * 136 + j, a, __ATOMIC_RELAXED, __HIP_MEMORY_SCOPE_WORKGROUP); __hip_atomic_fetch_add(imp + X.qi * 136 + j + 1, p[4 * tl + 3], __ATOMIC_RELAXED, __HIP_MEMORY_SCOPE_WORKGROUP); } }
    } else {
        lm = fmaxf(lm, __shfl_xor(lm, 16)); lm = fmaxf(lm, __shfl_xor(lm, 32));
        if (__any(lm > m + 8.0f)) { const float mn = fmaxf(m, lm), alpha = __builtin_amdgcn_exp2f(m - mn); l *= alpha; m = mn;
            if (BR != 0) {
#pragma unroll
                for (int dt = 0; dt < 8; ++dt) O[dt] *= alpha; } }
        float ps = 0.f;
#pragma unroll
        for (int e = 0; e < 8; ++e) { p[e] = v[e] ? __builtin_amdgcn_exp2f(x[e] - m) : 0.f; ps += p[e]; }
        l += ps;
    }
    if (BR != 0) { const bf16x8 pf = nsa_pack(p);
#pragma unroll
        for (int dt = 0; dt < 8; ++dt) O[dt] = MFMA16(vf[dt], pf, O[dt]); }
}
template <int BR> __device__ __forceinline__ void nsa_run(const NsaCtx& X, int n, int fr, int qd, bool cv, const LAS bf16x8* qfl, float& m, float& l, f32x4 (&O)[8], LAS float* imp) {
    bf16x8 ka[2][4], kb[2][4], vf[2][8];
    if (n <= 0) return;
    nsa_load<BR>(X, 0, n, ka[0], kb[0], vf[0]);
#pragma unroll 1
    for (int i0 = 0; i0 < n; i0 += 2) {
        nsa_load<BR>(X, i0 + 1, n, ka[1], kb[1], vf[1]);
        nsa_compute<BR>(X, i0, n, fr, qd, cv, qfl, ka[0], kb[0], vf[0], m, l, O, imp);
        nsa_load<BR>(X, i0 + 2, n, ka[0], kb[0], vf[0]);
        nsa_compute<BR>(X, i0 + 1, n, fr, qd, cv, qfl, ka[1], kb[1], vf[1], m, l, O, imp);
    }
}
__device__ __forceinline__ void nsa_acc_out(LAS float* ol, int fr, int qd, const f32x4 (&O)[8], float cf, bool first) {
#pragma unroll
    for (int dt = 0; dt < 8; ++dt) { LAS f32x4* pp = (LAS f32x4*)(ol + fr * 132 + 16 * dt + 4 * qd); f32x4 vv = O[dt] * cf; if (!first) vv += *pp; *pp = vv; }
}
__device__ __forceinline__ void nsa_fast2_phase(const bf16* proj, const bf16* kcf, const bf16* vct, const bf16* kfs, const bf16* vts, const bf16* kfw, const bf16* vtw, const float* glog, bf16* ymix, LAS unsigned char* lds) {
    const int tx_ = opaque_tid();
    const int lane = tx_ & 63, wave = __builtin_amdgcn_readfirstlane(tx_ >> 6), fr = lane & 15, qd = lane >> 4;
    LAS float* imp = (LAS float*)(lds + wave * 14592);
    LAS int* list = (LAS int*)(imp + 272);
    LAS float* ol = imp + 512;
    LAS bf16x8* qfl = (LAS bf16x8*)(lds + wave * 14592 + 10496) + lane;
    const int gw = blockIdx.x * NWAVES + wave, NGW = gridDim.x * NWAVES;
    const int qi = fr >= 6 ? 1 : 0, hd = fr - 6 * qi; const bool cv = fr < 12;
    const bool xmap = (gridDim.x & 7) == 0;
    const int nI = xmap ? 4096 : 32768, i_lo = xmap ? (int)(blockIdx.x >> 3) * NWAVES + wave : gw, i_st = xmap ? (int)(gridDim.x >> 3) * NWAVES : NGW;
    for (int item = i_lo; item < nI; item += i_st) {
        const int tp = xmap ? item : (item >> 3), bgi = xmap ? (int)(blockIdx.x & 7) : (item & 7), b = bgi >> 2, g = bgi & 3, tA = 2 * tp, tB = tA + 1, tq = tA + qi;
        if (xmap) { asm volatile("s_waitcnt lgkmcnt(0)" ::: "memory"); __builtin_amdgcn_s_barrier(); }
        const size_t tokq = (size_t)b * SEQ + tq; const int bg = b * 4 + g;
#pragma unroll
        for (int s = 0; s < 4; ++s) qfl[s * 64] = cv ? *(const bf16x8*)(proj + tokq * AB_N + 1024 + (g * 6 + hd) * 128 + 32 * s + 8 * qd) : (bf16x8){0, 0, 0, 0, 0, 0, 0, 0};
        float gt0 = 0.f, gt1 = 0.f, gt2 = 0.f;
        if (cv) { const float* gl = glog + tokq * 72 + (g * 6 + hd) * 3; gt0 = sigmoidf_(gl[0] + gl[GLOG_P2]); gt1 = sigmoidf_(gl[1] + gl[GLOG_P2 + 1]); gt2 = sigmoidf_(gl[2] + gl[GLOG_P2 + 2]); }
        for (int i = lane; i < 272; i += 64) imp[i] = 0.f;
        LDS_WAIT();
        NsaCtx X; X.qi = qi; X.list = list; X.vlane = fr * 32 + 8 * qd; X.klane = lane * 8;
        const int ncvB = (tB >= 31) ? ((tB - 31) >> 4) + 1 : 0;
        const int ncvq = cv ? ((tq >= 31) ? ((tq - 31) >> 4) + 1 : 0) : 0;
        { f32x4 O[8];
#pragma unroll
          for (int dt = 0; dt < 8; ++dt) O[dt] = (f32x4){0.f, 0.f, 0.f, 0.f};
          if (ncvB > 0) {
              X.kb = kcf + (size_t)bg * 16 * 4096; X.vb = vct + (size_t)bg * 16 * 4096; X.p0 = 0; X.lo = 0; X.hi = ncvq - 1;
              const int nst = (ncvB + 31) >> 5;
              float m = NEGF, l = 0.f;
              nsa_run<0>(X, nst, fr, qd, cv, qfl, m, l, O, imp);
              l += __shfl_xor(l, 16); l += __shfl_xor(l, 32);
              float invl = l > 0.f ? 1.0f / l : 0.f;
              nsa_run<1>(X, nst, fr, qd, cv, qfl, m, invl, O, imp);
          }
          nsa_acc_out(ol, fr, qd, O, gt0, true); }
        LDS_WAIT();
        { float m = NEGF, l = 0.f; f32x4 O[8];
#pragma unroll
          for (int dt = 0; dt < 8; ++dt) O[dt] = (f32x4){0.f, 0.f, 0.f, 0.f};
          const int lo0 = (tA - 511) > 0 ? (tA - 511) : 0, st0 = lo0 & ~31;
          X.kb = kfw + (size_t)bg * 256 * 4096; X.vb = vtw + (size_t)bg * 256 * 4096; X.p0 = st0; X.lo = tq - 511; X.hi = cv ? tq : -1;
          nsa_run<3>(X, ((tB - st0) >> 5) + 1, fr, qd, cv, qfl, m, l, O, imp);
          l += __shfl_xor(l, 16); l += __shfl_xor(l, 32);
          nsa_acc_out(ol, fr, qd, O, l > 0.f ? gt2 / l : 0.f, false); }
        LDS_WAIT();
        unsigned long long mA0, mA1, mB0, mB1;
#pragma unroll
        for (int qq = 0; qq < 2; ++qq) { const int t = tA + qq, cur = t >> 6; unsigned long long s0m, s1m;
            if (cur < 16) { s0m = (2ull << cur) - 1ull; s1m = 0ull; }
            else { LAS float* im = imp + qq * 136; const int j0 = lane, j1 = lane + 64; const bool c0 = (j0 >= 1 && j0 <= cur - 2), c1 = (j1 <= cur - 2);
                const float v0 = im[j0], v1 = im[j1]; int r0 = 0, r1 = 0;
                LDS_WAIT();
                if (lane == 0) im[0] = 0.f;
                if (lane == 1) { im[cur - 1] = 0.f; im[cur] = 0.f; }
                LDS_WAIT();
                { const unsigned b0 = c0 ? __float_as_uint(v0) : 0xffffffffu, b1 = c1 ? __float_as_uint(v1) : 0xffffffffu;
#pragma unroll 2
                  for (int k = 0; k <= cur - 2; k += 8) { const u32x4 a = *(const LAS u32x4*)(im + k), b = *(const LAS u32x4*)(im + k + 4);
                      r0 += (a.x > b0 ? 1 : 0) + (a.y > b0 ? 1 : 0) + (a.z > b0 ? 1 : 0) + (a.w > b0 ? 1 : 0) + (b.x > b0 ? 1 : 0) + (b.y > b0 ? 1 : 0) + (b.z > b0 ? 1 : 0) + (b.w > b0 ? 1 : 0);
                      r1 += (a.x > b1 ? 1 : 0) + (a.y > b1 ? 1 : 0) + (a.z > b1 ? 1 : 0) + (a.w > b1 ? 1 : 0) + (b.x > b1 ? 1 : 0) + (b.y > b1 ? 1 : 0) + (b.z > b1 ? 1 : 0) + (b.w > b1 ? 1 : 0); } }
                s0m = __ballot(c0 && r0 < 13); s1m = __ballot(c1 && r1 < 13);
                const int ncand = cur - 2;
                if (__popcll(s0m) + __popcll(s1m) != (ncand < 13 ? ncand : 13)) { r0 = 0; r1 = 0;
                    for (int k = 1; k <= cur - 2; ++k) { const float ov = im[k]; r0 += ((ov > v0) || (ov == v0 && k < j0)) ? 1 : 0; r1 += ((ov > v1) || (ov == v1 && k < j1)) ? 1 : 0; }
                    s0m = __ballot(c0 && r0 < 13); s1m = __ballot(c1 && r1 < 13); }
                s0m |= 1ull; { const int f1 = cur - 1; if (f1 < 64) s0m |= 1ull << f1; else s1m |= 1ull << (f1 - 64); if (cur < 64) s0m |= 1ull << cur; else s1m |= 1ull << (cur - 64); } }
            if (qq == 0) { mA0 = s0m; mA1 = s1m; } else { mB0 = s0m; mB1 = s1m; } }
        const unsigned long long U0 = mA0 | mB0, U1 = mA1 | mB1; const int nU0 = __popcll(U0), nsel = 2 * (nU0 + __popcll(U1));
#pragma unroll
        for (int w = 0; w < 2; ++w) { const unsigned long long U = w ? U1 : U0, mAw = w ? mA1 : mA0, mBw = w ? mB1 : mB0;
            if ((U >> lane) & 1ull) { const int idx = (w ? nU0 : 0) + __popcll(U & ((1ull << lane) - 1ull)), j = 64 * w + lane;
                const int fl = (int)(((mAw >> lane) & 1ull) << 30) | (int)(((mBw >> lane) & 1ull) << 31);
                list[2 * idx] = (64 * j) | fl; list[2 * idx + 1] = (64 * j + 32) | ((64 * j + 32 <= tB) ? fl : 0); } }
        LDS_WAIT();
        { float m = NEGF, l = 0.f; f32x4 O[8];
#pragma unroll
          for (int dt = 0; dt < 8; ++dt) O[dt] = (f32x4){0.f, 0.f, 0.f, 0.f};
          X.kb = kfs + (size_t)bg * 256 * 4096; X.vb = vts + (size_t)bg * 256 * 4096; X.p0 = 0; X.lo = 0; X.hi = cv ? tq : -1;
          nsa_run<2>(X, nsel, fr, qd, cv, qfl, m, l, O, imp);
          l += __shfl_xor(l, 16); l += __shfl_xor(l, 32);
          nsa_acc_out(ol, fr, qd, O, l > 0.f ? gt1 / l : 0.f, false); }
        if (cv) { bf16* op = ymix + tokq * DM + 1024 + (g * 6 + hd) * 128 + 4 * qd;
#pragma unroll
            for (int dt = 0; dt < 8; ++dt) { const f32x4 o = *(const LAS f32x4*)(ol + fr * 132 + 16 * dt + 4 * qd); u32x2 w; w.x = pk2(o[0], o[1]); w.y = pk2(o[2], o[3]); *(u32x2*)(op + 16 * dt) = w; } }
    }
}

__device__ __forceinline__ void act_phase(const bf16* G, const bf16* U2, const float* cw, const float* cb, bf16* act) {
    const int tx_ = opaque_tid();
    constexpr int CPR = FFP / 8, RB = 16, NRB = TOK / RB;
    const int gt = blockIdx.x * 512 + tx_, NT = gridDim.x * 512;
    for (int item = gt; item < NRB * CPR; item += NT) {
        const int rb = item / CPR, ch = item - rb * CPR, f8 = ch * 8, row0 = rb * RB; size_t off = (size_t)row0 * FFP + f8;
        if (f8 >= DFF) {
#pragma unroll
            for (int r = 0; r < RB; ++r) *(u32x4*)(act + off + (size_t)r * FFP) = (u32x4){0u, 0u, 0u, 0u};
            continue; }
        float w0[8], w1[8], w2[8], bb[8];
        { const f32x4 a0 = *(const f32x4*)(cw + f8), a1 = *(const f32x4*)(cw + f8 + 4), b0 = *(const f32x4*)(cw + DFF + f8), b1 = *(const f32x4*)(cw + DFF + f8 + 4), c0 = *(const f32x4*)(cw + 2 * DFF + f8), c1 = *(const f32x4*)(cw + 2 * DFF + f8 + 4), d0 = *(const f32x4*)(cb + f8), d1 = *(const f32x4*)(cb + f8 + 4);
#pragma unroll
          for (int j = 0; j < 4; ++j) { w0[j] = a0[j]; w0[j + 4] = a1[j]; w1[j] = b0[j]; w1[j + 4] = b1[j]; w2[j] = c0[j]; w2[j + 4] = c1[j]; bb[j] = d0[j]; bb[j + 4] = d1[j]; } }
        float g1[8], g2[8];
        const int tpos0 = row0 & (SEQ - 1);
        if (tpos0 >= 2) { unpack8(*(const u32x4*)(G + off - FFP), g1); unpack8(*(const u32x4*)(G + off - 2 * FFP), g2); }
        else {
#pragma unroll
            for (int j = 0; j < 8; ++j) { g1[j] = 0.f; g2[j] = 0.f; } }
#pragma unroll 4
        for (int r = 0; r < RB; ++r) {
            float g0[8], up[8]; unpack8(*(const u32x4*)(G + off), g0); unpack8(*(const u32x4*)(U2 + off), up);
            float o[8];
#pragma unroll
            for (int j = 0; j < 8; ++j) { const float x = bb[j] + w0[j] * g0[j] + w1[j] * g1[j] + w2[j] * g2[j]; o[j] = x * sigmoidf_(x) * up[j]; g2[j] = g1[j]; g1[j] = g0[j]; }
            u32x4 w; w.x = pk2(o[0], o[1]); w.y = pk2(o[2], o[3]); w.z = pk2(o[4], o[5]); w.w = pk2(o[6], o[7]);
            *(u32x4*)(act + off) = w; off += FFP;
        }
    }
}


__device__ __forceinline__ void act_fix_phase(const bf16* side, const float* cw, const float* cb, bf16* act) {
    const int tx_ = opaque_tid();
    constexpr int CPR = FFP / 8;
    const int gt = blockIdx.x * 512 + tx_, NT = gridDim.x * 512;
    const bool own = gridDim.x == 256; const int lt = (int)(blockIdx.x >> 3) * 512 + tx_, kx = 32 * (int)(blockIdx.x & 7);
    for (int item0 = own ? lt : gt; item0 < (own ? 32 : 256) * 2 * CPR; item0 += own ? 32 * 512 : NT) {
        const int ch = item0 % CPR, kr = item0 / CPR, rho = kr & 1, k = (kr >> 1) + (own ? kx : 0), f8 = ch * 8, t = 64 * k + rho, tpos = t & (SEQ - 1);
        const size_t off = (size_t)t * FFP + f8;
        if (f8 >= DFF) { *(u32x4*)(act + off) = (u32x4){0u, 0u, 0u, 0u}; continue; }
        float g0[8], g1[8], g2[8], up[8];
        const bf16* sk = side + ((size_t)(k * 4) * 2) * FFP + f8;
        unpack8(*(const u32x4*)(sk + (size_t)(rho * 2) * FFP), g0); unpack8(*(const u32x4*)(sk + (size_t)(rho * 2 + 1) * FFP), up);
        const bool hasprev = tpos >= 2 || (rho == 1);
#pragma unroll
        for (int j = 0; j < 8; ++j) { g1[j] = 0.f; g2[j] = 0.f; }
        if (rho == 1) { unpack8(*(const u32x4*)sk, g1); if (tpos >= 2) unpack8(*(const u32x4*)(sk - (size_t)8 * FFP + (size_t)(3 * 2) * FFP), g2); }
        else if (tpos >= 2) { unpack8(*(const u32x4*)(sk - (size_t)8 * FFP + (size_t)(3 * 2) * FFP), g1); unpack8(*(const u32x4*)(sk - (size_t)8 * FFP + (size_t)(2 * 2) * FFP), g2); }
        (void)hasprev;
        float r[8];
#pragma unroll
        for (int j = 0; j < 8; ++j) { const int f = f8 + j; const float x = cb[f] + cw[f] * g0[j] + cw[DFF + f] * g1[j] + cw[2 * DFF + f] * g2[j]; r[j] = x * sigmoidf_(x) * up[j]; }
        u32x4 w; w.x = pk2(r[0], r[1]); w.y = pk2(r[2], r[3]); w.z = pk2(r[4], r[5]); w.w = pk2(r[6], r[7]);
        *(u32x4*)(act + off) = w;
    }
}

__device__ __forceinline__ void mlstm_naive_phase(const bf16* projc, const float* gif, const float* bif, float* hout, LAS unsigned char* lds) {
    const int tx_ = opaque_tid();
    constexpr int QS = 264;
    const int tid = tx_, lane = tid & 63;
    LAS bf16* qs = (LAS bf16*)lds;
    LAS bf16* ks = qs + 64 * QS;
    LAS float* vsl = (LAS float*)(lds + 67584);
    LAS float* Cs = vsl + 2048;
    LAS float* ns = Cs + 256 * 36;
    LAS float* wq = ns + 256;
    LAS float* bb = wq + 64 * 65; LAS float* gi = bb + 64; LAS float* mt = gi + 64; LAS float* inter = mt + 64; LAS float* ksc = inter + 64; LAS float* dd = ksc + 64; LAS float* sca = dd + 64;
    for (int unit = blockIdx.x; unit < 256; unit += gridDim.x) {
        const int b = unit >> 7, h = (unit >> 4) & 7, es = unit & 15;
        for (int i = tid; i < 256 * 36; i += 512) Cs[i] = 0.f;
        if (tid < 256) ns[tid] = 0.f;
        if (tid == 0) sca[0] = 0.f;
        __syncthreads();
        for (int c = 0; c < 128; ++c) {
            const size_t tok0 = (size_t)b * SEQ + 64 * c;
#pragma unroll
            for (int i = 0; i < 4; ++i) { const int idx = tid + 512 * i, r = idx >> 5, ch = idx & 31; const bf16* src = projc + (tok0 + r) * C_N + h * 256 + ch * 8;
                *(LAS u32x4*)(qs + r * QS + ch * 8) = *(const u32x4*)src; *(LAS u32x4*)(ks + r * QS + ch * 8) = *(const u32x4*)(src + 2048); }
            if (tid < 256) { const int r = tid >> 2, q4 = tid & 3; float f[8]; unpack8(*(const u32x4*)(projc + (tok0 + r) * C_N + 4096 + h * 512 + es * 32 + q4 * 8), f);
#pragma unroll
                for (int j = 0; j < 8; ++j) vsl[r * 32 + q4 * 8 + j] = f[j]; }
            if (tid >= 448) {
                const int s = lane; const float ig = gif[(tok0 + s) * 16 + h] + bif[h], fg = gif[(tok0 + s) * 16 + 8 + h] + bif[8 + h];
                const float lf = fg >= 0.f ? -log1pf(__expf(-fg)) : fg - log1pf(__expf(fg));
                float bsum = lf;
#pragma unroll
                for (int o = 1; o < 64; o <<= 1) { const float tv = __shfl_up(bsum, o); if (lane >= o) bsum += tv; }
                float pm = ig - bsum;
#pragma unroll
                for (int o = 1; o < 64; o <<= 1) { const float tv = __shfl_up(pm, o); if (lane >= o) pm = fmaxf(pm, tv); }
                const float m_prev = sca[0]; const float mts = bsum + fmaxf(m_prev, pm);
                const float b_last = __shfl(bsum, 63), m_new = __shfl(mts, 63);
                bb[s] = bsum; gi[s] = ig; mt[s] = mts; inter[s] = __expf(bsum + m_prev - mts); ksc[s] = __expf(b_last - bsum + ig - m_new);
                if (s == 0) { sca[1] = __expf(b_last + m_prev - m_new); sca[2] = m_new; }
            }
            __syncthreads();
            {
                const int t = tid >> 3, sg = tid & 7; float acc[8];
#pragma unroll
                for (int i = 0; i < 8; ++i) acc[i] = 0.f;
                for (int ch = 0; ch < 32; ++ch) { float qv[8]; unpack8(*(const LAS u32x4*)(qs + t * QS + ch * 8), qv);
#pragma unroll
                    for (int i = 0; i < 8; ++i) { const int s = sg + 8 * i; if (s <= t) { float kv[8]; unpack8(*(const LAS u32x4*)(ks + s * QS + ch * 8), kv);
                        acc[i] += (qv[0] * kv[0] + qv[1] * kv[1]) + (qv[2] * kv[2] + qv[3] * kv[3]) + (qv[4] * kv[4] + qv[5] * kv[5]) + (qv[6] * kv[6] + qv[7] * kv[7]); } } }
                const float bt = bb[t], mtt = mt[t];
#pragma unroll
                for (int i = 0; i < 8; ++i) { const int s = sg + 8 * i; wq[t * 65 + s] = (s <= t) ? acc[i] * 0.0625f * __expf(bt - bb[s] + gi[s] - mtt) : 0.f; }
            }
            __syncthreads();
            if (tid < 64) { const int t = tid; float rs = 0.f, qn = 0.f;
                for (int s = 0; s < 64; ++s) rs += wq[t * 65 + s];
                for (int d = 0; d < 256; ++d) qn += bf2f(qs[t * QS + d]) * ns[d];
                const float den = inter[t] * qn * 0.0625f + rs; dd[t] = fmaxf(fabsf(den), __expf(-mt[t])); }
            f32x4 a = (f32x4){0.f, 0.f, 0.f, 0.f};
            const int t4 = tid >> 3, e0 = 4 * (tid & 7);
            { for (int ch = 0; ch < 32; ++ch) { float qv[8]; unpack8(*(const LAS u32x4*)(qs + t4 * QS + ch * 8), qv);
#pragma unroll
                    for (int j = 0; j < 8; ++j) { const f32x4 cv = *(const LAS f32x4*)(Cs + (ch * 8 + j) * 36 + e0); a += qv[j] * cv; } }
              a *= inter[t4] * 0.0625f;
              for (int s = 0; s <= t4; ++s) { const float w = wq[t4 * 65 + s]; const f32x4 vv = *(const LAS f32x4*)(vsl + s * 32 + e0); a += w * vv; } }
            __syncthreads();
            { const float inv = 1.0f / dd[t4]; *(f32x4*)(hout + (tok0 + t4) * DM + h * 512 + es * 32 + e0) = a * inv; }
            {
                const int d = tid >> 1, eh = tid & 1, eo = 16 * eh; float u[16]; float un = 0.f;
#pragma unroll
                for (int j = 0; j < 16; ++j) u[j] = 0.f;
                for (int s = 0; s < 64; ++s) { const float kk = bf2f(ks[s * QS + d]) * ksc[s]; un += kk;
#pragma unroll
                    for (int j = 0; j < 16; ++j) u[j] += kk * vsl[s * 32 + eo + j]; }
                const float decay = sca[1];
#pragma unroll
                for (int j = 0; j < 16; ++j) Cs[d * 36 + eo + j] = decay * Cs[d * 36 + eo + j] + u[j];
                if (eh == 0) ns[d] = decay * ns[d] + un;
            }
            __syncthreads();
            if (tid == 0) sca[0] = sca[2];
            __syncthreads();
        }
    }
}

__device__ __forceinline__ void mlstm_scalars(const float* gif, const float* bif, float* scal, int bh, int lane) {
    constexpr float L2E = 1.4426950408889634f; constexpr size_t AS = (size_t)16 * SEQ;
    const int b = bh >> 3, h = bh & 7; float m_prev = 0.f;
    const float bi = bif[h], bf = bif[8 + h];
    for (int c = 0; c < 128; ++c) {
        const size_t tok = (size_t)b * SEQ + 64 * c + lane; const float ig = gif[tok * 16 + h] + bi, fg = gif[tok * 16 + 8 + h] + bf;
        const float lf = fg >= 0.f ? -log1pf(__expf(-fg)) : fg - log1pf(__expf(fg));
        float bsum = lf;
#pragma unroll
        for (int o = 1; o < 64; o <<= 1) { const float tv = __shfl_up(bsum, o); if (lane >= o) bsum += tv; }
        float pm = ig - bsum;
#pragma unroll
        for (int o = 1; o < 64; o <<= 1) { const float tv = __shfl_up(pm, o); if (lane >= o) pm = fmaxf(pm, tv); }
        const float mts = bsum + fmaxf(m_prev, pm); const float b_last = __shfl(bsum, 63), m_new = __shfl(mts, 63);
        float* sp = scal + (size_t)bh * SEQ + 64 * c + lane;
        sp[0] = (bsum - mts) * L2E; sp[AS] = (ig - bsum) * L2E; sp[2 * AS] = __expf(bsum + m_prev - mts); sp[3 * AS] = __expf(b_last - bsum + ig - m_new); sp[4 * AS] = __expf(-mts); sp[5 * AS] = __expf(b_last + m_prev - m_new);
        m_prev = m_new;
    }
}

__device__ __forceinline__ void cgates_phase(const bf16* A, const bf16* Wt, const float* bif, float* lsc, LAS unsigned char* lds) {
    const int tx_ = opaque_tid();
    const int lane = tx_ & 63, wave = __builtin_amdgcn_readfirstlane(tx_ >> 6), gw = blockIdx.x * NWAVES + wave, NGW = gridDim.x * NWAVES;
    const int fr = lane & 15, fq = lane >> 4;
    LAS float* gl = (LAS float*)(lds + wave * 4608);
    constexpr size_t AS = (size_t)16 * SEQ;
    const bool own = gridDim.x == 256;
    if (own) {
        const int task = 32 * (int)(blockIdx.x & 7) + (int)(blockIdx.x >> 3), tok0 = task * 64, b = task >> 7, c = task & 127;
        f32x4 acc[4];
#pragma unroll
        for (int r = 0; r < 4; ++r) acc[r] = (f32x4){0.f, 0.f, 0.f, 0.f};
        const bf16* ap = A + (size_t)(tok0 + fr) * DM + 8 * fq + 512 * wave; const bf16* bp = Wt + (size_t)fr * DM + 8 * fq + 512 * wave;
#pragma unroll 4
        for (int k0 = 0; k0 < 512; k0 += 32) { const bf16x8 bv = *(const bf16x8*)(bp + k0);
#pragma unroll
            for (int r = 0; r < 4; ++r) { const bf16x8 av = *(const bf16x8*)(ap + (size_t)r * 16 * DM + k0); acc[r] = __builtin_amdgcn_mfma_f32_16x16x32_bf16(av, bv, acc[r], 0, 0, 0); } }
#pragma unroll
        for (int r = 0; r < 4; ++r)
#pragma unroll
            for (int q = 0; q < 4; ++q) gl[(16 * r + 4 * fq + q) * 17 + fr] = acc[r][q];
        __syncthreads();
        { const int h = wave, bh = b * 8 + h; float ig = bif[h], fg = bif[8 + h];
#pragma unroll
          for (int w8 = 0; w8 < 8; ++w8) { const LAS float* g8 = (const LAS float*)(lds + w8 * 4608); ig += g8[lane * 17 + h]; fg += g8[lane * 17 + 8 + h]; }
          const float lf = fg >= 0.f ? -log1pf(__expf(-fg)) : fg - log1pf(__expf(fg));
          float bsum = lf;
#pragma unroll
          for (int o = 1; o < 64; o <<= 1) { const float tv = __shfl_up(bsum, o); if (lane >= o) bsum += tv; }
          float pm = ig - bsum;
#pragma unroll
          for (int o = 1; o < 64; o <<= 1) { const float tv = __shfl_up(pm, o); if (lane >= o) pm = fmaxf(pm, tv); }
          float* sp = lsc + (size_t)bh * SEQ + 64 * c + lane; sp[0] = bsum; sp[AS] = pm; sp[2 * AS] = ig;
          if (lane == 63) { lsc[3 * AS + bh * 128 + c] = bsum; lsc[3 * AS + 2048 + bh * 128 + c] = pm; } }
        __syncthreads();
        return;
    }
    for (int task0 = gw; task0 < TOK / 64; task0 += NGW) {
        const int task = task0;
        const int tok0 = task * 64, b = task >> 7, c = task & 127;
        f32x4 acc[4];
#pragma unroll
        for (int r = 0; r < 4; ++r) acc[r] = (f32x4){0.f, 0.f, 0.f, 0.f};
        const bf16* ap = A + (size_t)(tok0 + fr) * DM + 8 * fq; const bf16* bp = Wt + (size_t)fr * DM + 8 * fq;
#pragma unroll 4
        for (int k0 = 0; k0 < DM; k0 += 32) { const bf16x8 bv = *(const bf16x8*)(bp + k0);
#pragma unroll
            for (int r = 0; r < 4; ++r) { const bf16x8 av = *(const bf16x8*)(ap + (size_t)r * 16 * DM + k0); acc[r] = __builtin_amdgcn_mfma_f32_16x16x32_bf16(av, bv, acc[r], 0, 0, 0); } }
#pragma unroll
        for (int r = 0; r < 4; ++r)
#pragma unroll
            for (int q = 0; q < 4; ++q) gl[(16 * r + 4 * fq + q) * 17 + fr] = acc[r][q];
        LDS_WAIT();
        for (int h = 0; h < 8; ++h) { const int bh = b * 8 + h; const float ig = gl[lane * 17 + h] + bif[h], fg = gl[lane * 17 + 8 + h] + bif[8 + h];
            const float lf = fg >= 0.f ? -log1pf(__expf(-fg)) : fg - log1pf(__expf(fg));
            float bsum = lf;
#pragma unroll
            for (int o = 1; o < 64; o <<= 1) { const float tv = __shfl_up(bsum, o); if (lane >= o) bsum += tv; }
            float pm = ig - bsum;
#pragma unroll
            for (int o = 1; o < 64; o <<= 1) { const float tv = __shfl_up(pm, o); if (lane >= o) pm = fmaxf(pm, tv); }
            float* sp = lsc + (size_t)bh * SEQ + 64 * c + lane; sp[0] = bsum; sp[AS] = pm; sp[2 * AS] = ig;
            if (lane == 63) { lsc[3 * AS + bh * 128 + c] = bsum; lsc[3 * AS + 2048 + bh * 128 + c] = pm; } }
        LDS_WAIT();
    }
}
__device__ __forceinline__ void mlstm_scalars2(const float* lsc, float* scal, int bh, int c, int lane) {
    constexpr float L2E = 1.4426950408889634f; constexpr size_t AS = (size_t)16 * SEQ;
    const float cb0 = lsc[3 * AS + bh * 128 + lane], cb1 = lsc[3 * AS + bh * 128 + 64 + lane], cp0 = lsc[3 * AS + 2048 + bh * 128 + lane], cp1 = lsc[3 * AS + 2048 + bh * 128 + 64 + lane];
    float m_prev = 0.f;
    for (int k = 0; k < c; ++k) { const float cbk = __shfl(k < 64 ? cb0 : cb1, k & 63), cpk = __shfl(k < 64 ? cp0 : cp1, k & 63); m_prev = cbk + fmaxf(m_prev, cpk); }
    const float b_last = __shfl(c < 64 ? cb0 : cb1, c & 63), pm_last = __shfl(c < 64 ? cp0 : cp1, c & 63), m_new = b_last + fmaxf(m_prev, pm_last);
    const float* lp = lsc + (size_t)bh * SEQ + 64 * c + lane; const float bsum = lp[0], pm = lp[AS], ig = lp[2 * AS];
    const float mts = bsum + fmaxf(m_prev, pm);
    float* sp = scal + (size_t)bh * SEQ + 64 * c + lane;
    sp[0] = (bsum - mts) * L2E; sp[AS] = (ig - bsum) * L2E; sp[2 * AS] = __expf(bsum + m_prev - mts); sp[3 * AS] = __expf(b_last - bsum + ig - m_new); sp[4 * AS] = __expf(-mts); sp[5 * AS] = __expf(b_last + m_prev - m_new);
}
__device__ __forceinline__ void mlstm_relayout(const bf16* projc, bf16* kT, bf16* vT, LAS unsigned char* lds, int task_lo, int task_step, bool v_only = false) {
    const int tx_ = opaque_tid();
    const int lane = tx_ & 63, wave = __builtin_amdgcn_readfirstlane(tx_ >> 6);
    LAS bf16* tile = (LAS bf16*)(lds + wave * 9216);
    (void)kT; (void)v_only;
    for (int task = task_lo; task < 2048 * 2; task += task_step) {
        const int bc = task >> 1, hf = task & 1, bh = bc >> 7, c = bc & 127, b = bh >> 3, h = bh & 7;
        u32x4 raw[4][8];
#pragma unroll
        for (int q4 = 0; q4 < 4; ++q4) { const bf16* src = projc + (size_t)(b * SEQ + 64 * c) * C_N + 4096 + h * 512 + (hf * 4 + q4) * 64;
#pragma unroll
            for (int i = 0; i < 8; ++i) { const int idx = lane + 64 * i, r = idx >> 3, ch = idx & 7; raw[q4][i] = *(const u32x4*)(src + (size_t)r * C_N + ch * 8); } }
#pragma unroll
        for (int q4 = 0; q4 < 4; ++q4) {
#pragma unroll
            for (int i = 0; i < 8; ++i) { const int idx = lane + 64 * i, r = idx >> 3, ch = idx & 7; *(LAS u32x4*)(tile + r * 72 + ch * 8) = raw[q4][i]; }
            LDS_WAIT();
            const int eg = (hf * 4 + q4) * 64 + lane;
            bf16* dst = vT + ((size_t)bh * 128 + c) * 32768 + (size_t)(((eg >> 5) * 2 + ((eg >> 4) & 1)) * 2) * 512 + (eg & 15) * 8;
#pragma unroll
            for (int c8 = 0; c8 < 8; ++c8) { u32x4 w;
                w.x = (unsigned)tile[(8 * c8 + 0) * 72 + lane] | ((unsigned)tile[(8 * c8 + 1) * 72 + lane] << 16); w.y = (unsigned)tile[(8 * c8 + 2) * 72 + lane] | ((unsigned)tile[(8 * c8 + 3) * 72 + lane] << 16);
                w.z = (unsigned)tile[(8 * c8 + 4) * 72 + lane] | ((unsigned)tile[(8 * c8 + 5) * 72 + lane] << 16); w.w = (unsigned)tile[(8 * c8 + 6) * 72 + lane] | ((unsigned)tile[(8 * c8 + 7) * 72 + lane] << 16);
                *(u32x4*)(dst + (c8 >> 2) * 512 + (c8 & 3) * 128) = w; }
            LDS_WAIT();
        }
    }
}
__device__ __forceinline__ void mlstm_pre_phase(const bf16* projc, const float* lsc, float* scal, bf16* kT, bf16* vT, LAS unsigned char* lds) {
    const int tx_ = opaque_tid();
    const int gw = blockIdx.x * NWAVES + __builtin_amdgcn_readfirstlane(tx_ >> 6), NGW = gridDim.x * NWAVES;
    for (int task = gw; task < 2048; task += NGW) mlstm_scalars2(lsc, scal, task >> 7, task & 127, tx_ & 63);
    mlstm_relayout(projc, kT, vT, lds, gw, NGW);
}
__device__ __forceinline__ void mlstm_wq(const bf16* projc, const float* scal, int b, int h, int bh, int c, int tt, int sp, int fr, int qd, LAS bf16* buf, bf16x8 (&qf)[8]) {
    constexpr size_t AS = (size_t)16 * SEQ;
    const size_t tok0 = (size_t)b * SEQ + 64 * c;
    const bf16* qp = projc + (tok0 + 16 * tt + fr) * C_N + h * 256 + 8 * qd;
#pragma unroll
    for (int i = 0; i < 8; ++i) qf[i] = *(const bf16x8*)(qp + 32 * i);
    const int t = 16 * tt + fr; const float ra = scal[(size_t)bh * SEQ + 64 * c + t];
#pragma unroll
    for (int ss = 0; ss < 2; ++ss) { const int st = 2 * sp + ss;
        u32x2 w = (u32x2){0u, 0u};
        if (st <= tt) {
            const bf16* kp = projc + (tok0 + 16 * st + fr) * C_N + 2048 + h * 256 + 8 * qd;
            f32x4 acc = (f32x4){0.f, 0.f, 0.f, 0.f};
#pragma unroll
            for (int i = 0; i < 8; ++i) { const bf16x8 kf = *(const bf16x8*)(kp + 32 * i); acc = MFMA16(kf, qf[i], acc); }
            const f32x4 cb = *(const f32x4*)(scal + AS + (size_t)bh * SEQ + 64 * c + 16 * st + 4 * qd);
            float wv[4];
#pragma unroll
            for (int r = 0; r < 4; ++r) { const int sidx = 16 * st + 4 * qd + r; wv[r] = (sidx <= t) ? acc[r] * 0.0625f * __builtin_amdgcn_exp2f(ra + cb[r]) : 0.f; }
            w.x = pk2(wv[0], wv[1]); w.y = pk2(wv[2], wv[3]);
        }
        *(LAS u32x2*)(buf + t * 72 + 16 * st + 4 * qd) = w;
    }
}
__device__ __forceinline__ void mlstm_fast_phase(const bf16* projc, const bf16* kT, const bf16* vT, const float* scal, float* hout, LAS unsigned char* lds) {
    const int tx_ = opaque_tid();
    constexpr size_t AS = (size_t)16 * SEQ;
    const int tid = tx_, lane = tid & 63, w = __builtin_amdgcn_readfirstlane(tid >> 6), fr = lane & 15, qd = lane >> 4;
    const int tt = w & 3, sp = w >> 2, et = w >> 2;
    for (int unit = blockIdx.x; unit < 256; unit += gridDim.x) {
        const int b = unit >> 7, h = (unit >> 4) & 7, es = unit & 15, bh = b * 8 + h;
        LAS bf16* wqb0 = (LAS bf16*)lds; LAS bf16* wqb1 = wqb0 + 64 * 72; LAS bf16* ctb0 = wqb1 + 64 * 72; LAS bf16* ctb1 = ctb0 + 48 * 264;
        for (int i = tid; i < 48 * 264 / 2; i += 512) ((LAS unsigned*)ctb0)[i] = 0u;
        f32x4 C[2][3];
#pragma unroll
        for (int a = 0; a < 2; ++a)
#pragma unroll
            for (int e3 = 0; e3 < 3; ++e3) C[a][e3] = (f32x4){0.f, 0.f, 0.f, 0.f};
        bf16x8 qf[8];
        mlstm_wq(projc, scal, b, h, bh, 0, tt, sp, fr, qd, wqb0, qf);
        for (int c = 0; c < 128; ++c) {
            LAS bf16* wqc = (c & 1) ? wqb1 : wqb0; LAS bf16* ctc = (c & 1) ? ctb1 : ctb0; LAS bf16* ctn = (c & 1) ? ctb0 : ctb1;
            __syncthreads();
            const size_t tok0 = (size_t)b * SEQ + 64 * c; const float* sc0 = scal + (size_t)bh * SEQ + 64 * c;
            const bf16* vbase = vT + (((size_t)bh * 128 + c) * 512 + es * 32 + fr) * 64 + 8 * qd;
            bf16x8 vf[2][2];
#pragma unroll
            for (int e2 = 0; e2 < 2; ++e2)
#pragma unroll
                for (int i = 0; i < 2; ++i) vf[e2][i] = *(const bf16x8*)(vbase + (size_t)e2 * 16 * 64 + 32 * i);
            f32x4 ae = (f32x4){0.f, 0.f, 0.f, 0.f}, an = (f32x4){0.f, 0.f, 0.f, 0.f};
#pragma unroll
            for (int i = 0; i < 8; ++i) { const bf16x8 b0 = *(const LAS bf16x8*)(ctc + (16 * et + fr) * 264 + 32 * i + 8 * qd), b2 = *(const LAS bf16x8*)(ctc + (32 + fr) * 264 + 32 * i + 8 * qd);
                ae = MFMA16(qf[i], b0, ae); an = MFMA16(qf[i], b2, an); }
            { const f32x4 it = *(const f32x4*)(sc0 + 2 * AS + 16 * tt + 4 * qd);
#pragma unroll
              for (int r = 0; r < 4; ++r) { ae[r] *= it[r] * 0.0625f; an[r] *= it[r] * 0.0625f; } }
            const bf16x8 ones = (fr == 0) ? (bf16x8){0x3F80, 0x3F80, 0x3F80, 0x3F80, 0x3F80, 0x3F80, 0x3F80, 0x3F80} : (bf16x8){0, 0, 0, 0, 0, 0, 0, 0};
#pragma unroll
            for (int i = 0; i < 2; ++i) { const bf16x8 a = *(const LAS bf16x8*)(wqc + (16 * tt + fr) * 72 + 32 * i + 8 * qd);
                ae = MFMA16(a, (et ? vf[1][i] : vf[0][i]), ae); an = MFMA16(a, ones, an); }
            { const f32x4 em = *(const f32x4*)(sc0 + 4 * AS + 16 * tt + 4 * qd); f32x4 hv;
#pragma unroll
              for (int r = 0; r < 4; ++r) { const float dn = __shfl(an[r], lane & 48); hv[r] = ae[r] / fmaxf(fabsf(dn), em[r]); }
              float* hp = hout + (tok0 + 16 * tt + 4 * qd) * DM + h * 512 + es * 32 + 16 * et + fr;
#pragma unroll
              for (int r = 0; r < 4; ++r) hp[(size_t)r * DM] = hv[r]; }
            { const float decay = sc0[5 * AS];
#pragma unroll
              for (int a = 0; a < 2; ++a)
#pragma unroll
                  for (int e3 = 0; e3 < 3; ++e3) C[a][e3] *= decay;
              const bf16* kb = kT + (((size_t)bh * 128 + c) * 256 + 32 * w + fr) * 64 + 8 * qd;
#pragma unroll
              for (int i = 0; i < 2; ++i) { const bf16x8 a0 = *(const bf16x8*)(kb + 32 * i), a1 = *(const bf16x8*)(kb + 16 * 64 + 32 * i);
                  const f32x4 k0 = *(const f32x4*)(sc0 + 3 * AS + 32 * i + 8 * qd), k1 = *(const f32x4*)(sc0 + 3 * AS + 32 * i + 8 * qd + 4);
                  const float ks[8] = {k0[0], k0[1], k0[2], k0[3], k1[0], k1[1], k1[2], k1[3]};
                  bf16x8 vs[2];
#pragma unroll
                  for (int e2 = 0; e2 < 2; ++e2) { float f[8]; unpack8(__builtin_bit_cast(u32x4, vf[e2][i]), f); u32x4 p; p.x = pk2(f[0] * ks[0], f[1] * ks[1]); p.y = pk2(f[2] * ks[2], f[3] * ks[3]); p.z = pk2(f[4] * ks[4], f[5] * ks[5]); p.w = pk2(f[6] * ks[6], f[7] * ks[7]); vs[e2] = __builtin_bit_cast(bf16x8, p); }
                  u32x4 pn = (u32x4){0u, 0u, 0u, 0u}; if (fr == 0) { pn.x = pk2(ks[0], ks[1]); pn.y = pk2(ks[2], ks[3]); pn.z = pk2(ks[4], ks[5]); pn.w = pk2(ks[6], ks[7]); }
                  const bf16x8 vn = __builtin_bit_cast(bf16x8, pn);
                  C[0][0] = MFMA16(a0, vs[0], C[0][0]); C[0][1] = MFMA16(a0, vs[1], C[0][1]); C[0][2] = MFMA16(a0, vn, C[0][2]);
                  C[1][0] = MFMA16(a1, vs[0], C[1][0]); C[1][1] = MFMA16(a1, vs[1], C[1][1]); C[1][2] = MFMA16(a1, vn, C[1][2]); }
#pragma unroll
              for (int a = 0; a < 2; ++a)
#pragma unroll
                  for (int e3 = 0; e3 < 3; ++e3) { u32x2 p; p.x = pk2(C[a][e3][0], C[a][e3][1]); p.y = pk2(C[a][e3][2], C[a][e3][3]); *(LAS u32x2*)(ctn + (16 * e3 + fr) * 264 + 32 * w + 16 * a + 4 * qd) = p; } }
            if (c + 1 < 128) mlstm_wq(projc, scal, b, h, bh, c + 1, tt, sp, fr, qd, (c & 1) ? wqb0 : wqb1, qf);
        }
        __syncthreads();
    }
}


__device__ __forceinline__ void mlstm_chunk_task(const bf16* projc, const float* lsc, float* scal, bf16* wqg, bf16* kT, bf16* qF, LAS unsigned char* ldsw, int bh, int c, int lane) {
    constexpr float L2E = 1.4426950408889634f; constexpr size_t AS = (size_t)16 * SEQ;
    const int b = bh >> 3, h = bh & 7, fr = lane & 15, qd = lane >> 4;
    const float cb0 = lsc[3 * AS + bh * 128 + lane], cb1 = lsc[3 * AS + bh * 128 + 64 + lane], cp0 = lsc[3 * AS + 2048 + bh * 128 + lane], cp1 = lsc[3 * AS + 2048 + bh * 128 + 64 + lane];
    float m_prev = 0.f;
    for (int k = 0; k < c; ++k) { const float cbk = __shfl(k < 64 ? cb0 : cb1, k & 63), cpk = __shfl(k < 64 ? cp0 : cp1, k & 63); m_prev = cbk + fmaxf(m_prev, cpk); }
    const float b_last = __shfl(c < 64 ? cb0 : cb1, c & 63), pm_last = __shfl(c < 64 ? cp0 : cp1, c & 63), m_new = b_last + fmaxf(m_prev, pm_last);
    const float* lp = lsc + (size_t)bh * SEQ + 64 * c + lane; const float bsum = lp[0], pm = lp[AS], ig = lp[2 * AS];
    const float mts = bsum + fmaxf(m_prev, pm);
    const float rowA = (bsum - mts) * L2E, colB = (ig - bsum) * L2E;
    float* sp = scal + (size_t)bh * SEQ + 64 * c + lane;
    sp[2 * AS] = __expf(bsum + m_prev - mts); sp[3 * AS] = __expf(b_last - bsum + ig - m_new); sp[4 * AS] = __expf(-mts); sp[5 * AS] = __expf(b_last + m_prev - m_new);
    const size_t tok0 = (size_t)b * SEQ + 64 * c; bf16* wq = wqg + ((size_t)bh * 128 + c) * 4096;
#pragma unroll
    for (int tt = 0; tt < 4; ++tt) {
        int lq = lane * 8; asm volatile("" : "+v"(lq));
        const bf16* qp = projc + (tok0 + 16 * tt + fr) * C_N + h * 256 + 8 * qd; bf16x8 qf[8], kf[4][8];
#pragma unroll
        for (int i = 0; i < 8; ++i) { qf[i] = *(const bf16x8*)(qp + 32 * i); *(bf16x8*)(qF + (((size_t)bh * 128 + c) * 32 + tt * 8 + i) * 512 + lq) = qf[i]; }
#pragma unroll
        for (int st = 0; st < 4; ++st) if (st <= tt) { const bf16* kp = projc + (tok0 + 16 * st + fr) * C_N + 2048 + h * 256 + 8 * qd;
#pragma unroll
            for (int i = 0; i < 8; ++i) kf[st][i] = *(const bf16x8*)(kp + 32 * i); }
        const int t = 16 * tt + fr; const float ra = __shfl(rowA, t);
#pragma unroll
        for (int st = 0; st < 4; ++st) { u32x2 w = (u32x2){0u, 0u};
            if (st <= tt) { f32x4 acc = (f32x4){0.f, 0.f, 0.f, 0.f};
#pragma unroll
                for (int i = 0; i < 8; ++i) acc = MFMA16(kf[st][i], qf[i], acc);
                float wv[4];
#pragma unroll
                for (int r = 0; r < 4; ++r) { const int sidx = 16 * st + 4 * qd + r; const float cb = __shfl(colB, sidx); wv[r] = (sidx <= t) ? acc[r] * 0.0625f * __builtin_amdgcn_exp2f(ra + cb) : 0.f; }
                w.x = pk2(wv[0], wv[1]); w.y = pk2(wv[2], wv[3]); }
            *(u32x2*)(wq + ((tt * 2 + (st >> 1)) * 64 + (2 * (st & 1) + (qd >> 1)) * 16 + fr) * 8 + 4 * (qd & 1)) = w; }
    }
    { const float kscv = __expf(b_last - bsum + ig - m_new);
      LAS float* kl = (LAS float*)ldsw; LAS bf16* tile = (LAS bf16*)(ldsw + 256);
      kl[lane] = kscv; LDS_WAIT();
      u32x4 raw[4][8];
#pragma unroll
      for (int sub = 0; sub < 4; ++sub) { const bf16* src = projc + tok0 * C_N + 2048 + h * 256 + sub * 64;
#pragma unroll
          for (int i = 0; i < 8; ++i) { const int idx = lane + 64 * i, r = idx >> 3, ch = idx & 7; raw[sub][i] = *(const u32x4*)(src + (size_t)r * C_N + ch * 8); } }
#pragma unroll
      for (int sub = 0; sub < 4; ++sub) {
#pragma unroll
          for (int i = 0; i < 8; ++i) { const int idx = lane + 64 * i, r = idx >> 3, ch = idx & 7; float f[8]; unpack8(raw[sub][i], f); const float sc = kl[r];
              u32x4 o; o.x = pg8::cvt_pk_bf16(f[0] * sc, f[1] * sc); o.y = pg8::cvt_pk_bf16(f[2] * sc, f[3] * sc); o.z = pg8::cvt_pk_bf16(f[4] * sc, f[5] * sc); o.w = pg8::cvt_pk_bf16(f[6] * sc, f[7] * sc);
              *(LAS u32x4*)(tile + r * 72 + ch * 8) = o; }
          LDS_WAIT();
          bf16* dst = kT + ((size_t)bh * 128 + c) * 16384 + (size_t)((sub * 2 + (lane >> 5)) * 2 + ((lane >> 4) & 1)) * 1024 + (lane & 15) * 8;
#pragma unroll
          for (int c8 = 0; c8 < 8; ++c8) { u32x4 w;
              w.x = (unsigned)tile[(8 * c8 + 0) * 72 + lane] | ((unsigned)tile[(8 * c8 + 1) * 72 + lane] << 16); w.y = (unsigned)tile[(8 * c8 + 2) * 72 + lane] | ((unsigned)tile[(8 * c8 + 3) * 72 + lane] << 16);
              w.z = (unsigned)tile[(8 * c8 + 4) * 72 + lane] | ((unsigned)tile[(8 * c8 + 5) * 72 + lane] << 16); w.w = (unsigned)tile[(8 * c8 + 6) * 72 + lane] | ((unsigned)tile[(8 * c8 + 7) * 72 + lane] << 16);
              *(u32x4*)(dst + (c8 >> 2) * 512 + (c8 & 3) * 128) = w; }
          LDS_WAIT();
      } }
}
__device__ __forceinline__ void mlstm_pre2_phase(const bf16* projc, const float* lsc, float* scal, bf16* wqg, bf16* kT, bf16* vT, bf16* qF, LAS unsigned char* lds) {
    const int tx_ = opaque_tid();
    const int wave = __builtin_amdgcn_readfirstlane(tx_ >> 6), gw = blockIdx.x * NWAVES + wave, NGW = gridDim.x * NWAVES;
    for (int task = gw; task < 2048; task += NGW) mlstm_chunk_task(projc, lsc, scal, wqg, kT, qF, lds + wave * 9728, task >> 7, task & 127, tx_ & 63);
    __syncthreads();
    mlstm_relayout(projc, kT, vT, lds, gw, NGW, true);
}
struct MlSet { bf16x8 wa[2], qf[8], vf[2][2], ka[2][2]; f32x4 it, em; float decay; };
struct MlOff { int ow, oq, ov, os; };
__device__ __forceinline__ void mlstm_load_set(MlSet& S, const MlOff& Of, const bf16* qF, const bf16* wqg, const bf16* kT, const bf16* vT, const float* scal, int b, int h, int bh, int es, int c, int w, int tt) {
    constexpr size_t AS = (size_t)16 * SEQ;
    int ol = Of.ow, os = Of.os; asm volatile("" : "+v"(ol), "+v"(os));
    const size_t cb = (size_t)bh * 128 + c;
    const bf16* wp = wqg + cb * 4096 + tt * 1024;
    const bf16* qp = qF + cb * 16384 + tt * 4096;
    const bf16* vp = vT + cb * 32768 + es * 2048;
    const bf16* kp = kT + cb * 16384 + w * 2048;
    const float* sc0 = scal + (size_t)bh * SEQ + 64 * c + 16 * tt;
    S.wa[0] = *(const bf16x8*)(wp + ol); S.wa[1] = *(const bf16x8*)(wp + (ol + 512));
#pragma unroll
    for (int i = 0; i < 8; ++i) S.qf[i] = *(const bf16x8*)(qp + (ol + 512 * i));
#pragma unroll
    for (int e2 = 0; e2 < 2; ++e2)
#pragma unroll
        for (int i = 0; i < 2; ++i) { S.vf[e2][i] = *(const bf16x8*)(vp + (ol + (e2 * 2 + i) * 512)); S.ka[e2][i] = *(const bf16x8*)(kp + (ol + (e2 * 2 + i) * 512)); }
    S.it = *(const f32x4*)(sc0 + 2 * AS + os); S.em = *(const f32x4*)(sc0 + 4 * AS + os);
    S.decay = scal[(size_t)bh * SEQ + 64 * c + 5 * AS];
}
template <bool STORE = true> __device__ __forceinline__ void mlstm_step(const MlSet& S, f32x4 (&C)[2][3], const LAS bf16* ctc, LAS bf16* ctn, float* hout, int b, int h, int es, int c, int w, int tt, int et, int lane) {
    const int fr = lane & 15, qd = lane >> 4;
    f32x4 ae = (f32x4){0.f, 0.f, 0.f, 0.f}, an = (f32x4){0.f, 0.f, 0.f, 0.f};
#pragma unroll
    for (int i = 0; i < 8; ++i) { const bf16x8 b0 = *(const LAS bf16x8*)(ctc + (16 * et + fr) * 264 + 32 * i + 8 * qd), b2 = *(const LAS bf16x8*)(ctc + (32 + fr) * 264 + 32 * i + 8 * qd);
        ae = MFMA16(S.qf[i], b0, ae); an = MFMA16(S.qf[i], b2, an); }
#pragma unroll
    for (int r = 0; r < 4; ++r) { const float sc = S.it[r] * 0.0625f; ae[r] *= sc; an[r] *= sc; }
    const bf16x8 ones = (fr == 0) ? (bf16x8){0x3F80, 0x3F80, 0x3F80, 0x3F80, 0x3F80, 0x3F80, 0x3F80, 0x3F80} : (bf16x8){0, 0, 0, 0, 0, 0, 0, 0};
#pragma unroll
    for (int i = 0; i < 2; ++i) { ae = MFMA16(S.wa[i], (et ? S.vf[1][i] : S.vf[0][i]), ae); an = MFMA16(S.wa[i], ones, an); }
    { f32x4 hv;
#pragma unroll
      for (int r = 0; r < 4; ++r) { const float dn = __shfl(an[r], lane & 48); hv[r] = ae[r] * __builtin_amdgcn_rcpf(fmaxf(fabsf(dn), S.em[r])); }
      bf16* hp = (bf16*)hout + ((size_t)b * SEQ + 64 * c + 16 * tt + 4 * qd) * DM + h * 512 + es * 32 + 16 * et + fr;
      if (STORE) {
#pragma unroll
      for (int r = 0; r < 4; ++r) hp[(size_t)r * DM] = (bf16)f2bf(hv[r]); } else asm volatile("" :: "v"(hv[0]), "v"(hv[1]), "v"(hv[2]), "v"(hv[3])); }
#pragma unroll
    for (int a = 0; a < 2; ++a)
#pragma unroll
        for (int e3 = 0; e3 < 3; ++e3) C[a][e3] *= S.decay;
#pragma unroll
    for (int i = 0; i < 2; ++i) {
        C[0][0] = MFMA16(S.ka[0][i], S.vf[0][i], C[0][0]); C[0][1] = MFMA16(S.ka[0][i], S.vf[1][i], C[0][1]); C[0][2] = MFMA16(S.ka[0][i], ones, C[0][2]);
        C[1][0] = MFMA16(S.ka[1][i], S.vf[0][i], C[1][0]); C[1][1] = MFMA16(S.ka[1][i], S.vf[1][i], C[1][1]); C[1][2] = MFMA16(S.ka[1][i], ones, C[1][2]); }
    asm volatile("s_nop 15\n\ts_nop 15" : "+v"(C[0][0]), "+v"(C[0][1]), "+v"(C[0][2]), "+v"(C[1][0]), "+v"(C[1][1]), "+v"(C[1][2]));
#pragma unroll
    for (int a = 0; a < 2; ++a)
#pragma unroll
        for (int e3 = 0; e3 < 3; ++e3) { u32x2 pc; pc.x = pg8::cvt_pk_bf16(C[a][e3][0], C[a][e3][1]); pc.y = pg8::cvt_pk_bf16(C[a][e3][2], C[a][e3][3]); *(LAS u32x2*)(ctn + (16 * e3 + fr) * 264 + 32 * w + 16 * a + 4 * qd) = pc; }
}
struct MlAddr { const bf16 *wp, *qp, *vp, *kp; const float* sc0; const float* dcp; };
__device__ __forceinline__ MlAddr mlstm_addr(const bf16* qF, const bf16* wqg, const bf16* kT, const bf16* vT, const float* scal, int bh, int es, int c, int w, int tt) {
    constexpr size_t AS = (size_t)16 * SEQ; const size_t cb = (size_t)bh * 128 + c; MlAddr A;
    A.wp = wqg + cb * 4096 + tt * 1024; A.qp = qF + cb * 16384 + tt * 4096; A.vp = vT + cb * 32768 + es * 2048; A.kp = kT + cb * 16384 + w * 2048;
    A.sc0 = scal + (size_t)bh * SEQ + 64 * c + 16 * tt; A.dcp = scal + (size_t)bh * SEQ + 64 * c + 5 * AS; return A;
}
__device__ __forceinline__ void mlstm_load_q(MlSet& S, const MlOff& Of, const MlAddr& A) {
    int ol = Of.ow; asm volatile("" : "+v"(ol));
#pragma unroll
    for (int i = 0; i < 8; ++i) S.qf[i] = *(const bf16x8*)(A.qp + (ol + 512 * i));
}
__device__ __forceinline__ void mlstm_load_w(MlSet& S, const MlOff& Of, const MlAddr& A) {
    int ol = Of.ow; asm volatile("" : "+v"(ol));
    S.wa[0] = *(const bf16x8*)(A.wp + ol); S.wa[1] = *(const bf16x8*)(A.wp + (ol + 512));
}
__device__ __forceinline__ void mlstm_load_r(MlSet& S, const MlOff& Of, const MlAddr& A) {
    constexpr size_t AS = (size_t)16 * SEQ;
    int ol = Of.ow, os = Of.os; asm volatile("" : "+v"(ol), "+v"(os));
#pragma unroll
    for (int e2 = 0; e2 < 2; ++e2)
#pragma unroll
        for (int i = 0; i < 2; ++i) { S.vf[e2][i] = *(const bf16x8*)(A.vp + (ol + (e2 * 2 + i) * 512)); S.ka[e2][i] = *(const bf16x8*)(A.kp + (ol + (e2 * 2 + i) * 512)); }
    S.it = *(const f32x4*)(A.sc0 + 2 * AS + os); S.em = *(const f32x4*)(A.sc0 + 4 * AS + os);
    S.decay = *A.dcp;
}
__device__ __forceinline__ void mlstm_step2(MlSet& S, const MlOff& Of, const MlAddr& A2, f32x4 (&C)[2][3], const LAS bf16* ctc, LAS bf16* ctn, float* hout, int b, int h, int es, int c, int w, int tt, int et, int lane) {
    const int fr = lane & 15, qd = lane >> 4;
    f32x4 ae = (f32x4){0.f, 0.f, 0.f, 0.f}, an = (f32x4){0.f, 0.f, 0.f, 0.f};
#pragma unroll
    for (int i = 0; i < 8; ++i) { const bf16x8 b0 = *(const LAS bf16x8*)(ctc + (16 * et + fr) * 264 + 32 * i + 8 * qd), b2 = *(const LAS bf16x8*)(ctc + (32 + fr) * 264 + 32 * i + 8 * qd);
        ae = MFMA16(S.qf[i], b0, ae); an = MFMA16(S.qf[i], b2, an); }
    __builtin_amdgcn_sched_barrier(0);
    mlstm_load_q(S, Of, A2);
#pragma unroll
    for (int r = 0; r < 4; ++r) { const float sc = S.it[r] * 0.0625f; ae[r] *= sc; an[r] *= sc; }
    const bf16x8 ones = (fr == 0) ? (bf16x8){0x3F80, 0x3F80, 0x3F80, 0x3F80, 0x3F80, 0x3F80, 0x3F80, 0x3F80} : (bf16x8){0, 0, 0, 0, 0, 0, 0, 0};
#pragma unroll
    for (int i = 0; i < 2; ++i) { ae = MFMA16(S.wa[i], (et ? S.vf[1][i] : S.vf[0][i]), ae); an = MFMA16(S.wa[i], ones, an); }
    __builtin_amdgcn_sched_barrier(0);
    mlstm_load_w(S, Of, A2);
    { f32x4 hv;
#pragma unroll
      for (int r = 0; r < 4; ++r) { const float dn = __shfl(an[r], lane & 48); hv[r] = ae[r] * __builtin_amdgcn_rcpf(fmaxf(fabsf(dn), S.em[r])); }
      float* hp = hout + ((size_t)b * SEQ + 64 * c + 16 * tt + 4 * qd) * DM + h * 512 + es * 32 + 16 * et + fr;
#pragma unroll
      for (int r = 0; r < 4; ++r) hp[(size_t)r * DM] = hv[r]; }
#pragma unroll
    for (int a = 0; a < 2; ++a)
#pragma unroll
        for (int e3 = 0; e3 < 3; ++e3) C[a][e3] *= S.decay;
#pragma unroll
    for (int i = 0; i < 2; ++i) {
        C[0][0] = MFMA16(S.ka[0][i], S.vf[0][i], C[0][0]); C[0][1] = MFMA16(S.ka[0][i], S.vf[1][i], C[0][1]); C[0][2] = MFMA16(S.ka[0][i], ones, C[0][2]);
        C[1][0] = MFMA16(S.ka[1][i], S.vf[0][i], C[1][0]); C[1][1] = MFMA16(S.ka[1][i], S.vf[1][i], C[1][1]); C[1][2] = MFMA16(S.ka[1][i], ones, C[1][2]); }
    __builtin_amdgcn_sched_barrier(0);
    mlstm_load_r(S, Of, A2);
    __builtin_amdgcn_sched_barrier(0);
    asm volatile("s_nop 15\n\ts_nop 15" : "+v"(C[0][0]), "+v"(C[0][1]), "+v"(C[0][2]), "+v"(C[1][0]), "+v"(C[1][1]), "+v"(C[1][2]));
#pragma unroll
    for (int a = 0; a < 2; ++a)
#pragma unroll
        for (int e3 = 0; e3 < 3; ++e3) { u32x2 pc; pc.x = pg8::cvt_pk_bf16(C[a][e3][0], C[a][e3][1]); pc.y = pg8::cvt_pk_bf16(C[a][e3][2], C[a][e3][3]); *(LAS u32x2*)(ctn + (16 * e3 + fr) * 264 + 32 * w + 16 * a + 4 * qd) = pc; }
}
struct MlWarm { unsigned a, b, c; };
__device__ __forceinline__ void mlstm_warm(MlWarm& W, const bf16* projc, const bf16* wqg, const bf16* kT, const bf16* vT, const float* scal, int b, int h, int bh, int es, int c, int w, int tt, int lane) {
    constexpr size_t AS = (size_t)16 * SEQ;
    int lo = lane; asm volatile("" : "+v"(lo));
    const size_t tok0 = (size_t)b * SEQ + 64 * c;
    W.a = *(const unsigned*)(projc + (tok0 + 16 * tt + (lo & 15)) * C_N + h * 256 + (lo >> 4) * 64);
    const bf16* p1 = (lo < 32) ? kT + (((size_t)bh * 128 + c) * 256 + 32 * w + lo) * 64 : vT + (((size_t)bh * 128 + c) * 512 + es * 32 + (lo - 32)) * 64;
    W.b = *(const unsigned*)p1;
    const float* sc0 = scal + (size_t)bh * SEQ + 64 * c; const int si = lo - 16;
    const void* p2 = (lo < 16) ? (const void*)(wqg + ((size_t)bh * 128 + c) * 4096 + (16 * tt + lo) * 64)
                   : (si < 6) ? (const void*)(sc0 + (size_t)(2 + (si >> 1)) * AS + (si & 1) * 32) : (const void*)(sc0 + 5 * AS);
    W.c = *(const unsigned*)p2;
}
#define ML_WARM_USE(W) asm volatile("" :: "v"((W).a), "v"((W).b), "v"((W).c))
#define ML_BAR() do { asm volatile("s_waitcnt lgkmcnt(0)" ::: "memory"); __builtin_amdgcn_s_barrier(); asm volatile("" ::: "memory"); } while (0)
__device__ __forceinline__ void mlstm_fast2_phase(const bf16* qF, const bf16* wqg, const bf16* kT, const bf16* vT, const float* scal, float* hout, LAS unsigned char* lds) {
    const int tid = opaque_tid();
    const int lane = tid & 63, w = __builtin_amdgcn_readfirstlane(tid >> 6), tt = w & 3, et = w >> 2, fr = lane & 15, qd = lane >> 4;
    MlOff Of; Of.ow = lane * 8; Of.oq = 0; Of.ov = 0; Of.os = 4 * qd; (void)fr;
    for (int unit0 = blockIdx.x; unit0 < 256; unit0 += gridDim.x) {
        const int unit = unit0;
        const int b = unit >> 7, h = (unit >> 4) & 7, es = unit & 15, bh = b * 8 + h;
        LAS bf16* ctb0 = (LAS bf16*)lds; LAS bf16* ctb1 = ctb0 + 48 * 264;
        for (int i = tid; i < 48 * 264 / 2; i += 512) ((LAS unsigned*)ctb0)[i] = 0u;
        f32x4 C[2][3];
#pragma unroll
        for (int a = 0; a < 2; ++a)
#pragma unroll
            for (int e3 = 0; e3 < 3; ++e3) C[a][e3] = (f32x4){0.f, 0.f, 0.f, 0.f};
        MlSet S0, S1;
        mlstm_load_set(S0, Of, qF, wqg, kT, vT, scal, b, h, bh, es, 0, w, tt);
#if MK_ML_REFILL
        mlstm_load_set(S1, Of, qF, wqg, kT, vT, scal, b, h, bh, es, 1, w, tt);
#pragma unroll 1
        for (int c = 0; c < 128; c += 2) {
            const MlAddr A2 = mlstm_addr(qF, wqg, kT, vT, scal, bh, es, (c + 2 < 128) ? c + 2 : 127, w, tt), A3 = mlstm_addr(qF, wqg, kT, vT, scal, bh, es, (c + 3 < 128) ? c + 3 : 127, w, tt);
            ML_BAR();
            mlstm_step2(S0, Of, A2, C, ctb0, ctb1, hout, b, h, es, c, w, tt, et, lane);
            ML_BAR();
            mlstm_step2(S1, Of, A3, C, ctb1, ctb0, hout, b, h, es, c + 1, w, tt, et, lane);
        }
#else
#pragma unroll 1
        for (int c = 0; c < 128; c += 2) {
            ML_BAR();
            mlstm_load_set(S1, Of, qF, wqg, kT, vT, scal, b, h, bh, es, c + 1, w, tt);
            mlstm_step(S0, C, ctb0, ctb1, hout, b, h, es, c, w, tt, et, lane);
            ML_BAR();
            mlstm_load_set(S0, Of, qF, wqg, kT, vT, scal, b, h, bh, es, (c + 2 < 128) ? c + 2 : 127, w, tt);
            mlstm_step(S1, C, ctb1, ctb0, hout, b, h, es, c + 1, w, tt, et, lane);
        }
#endif
#if MK_ML_PROBE == 1
        __syncthreads();
#pragma unroll 1
        for (int c = 0; c < 128; c += 2) {
            ML_BAR(); mlstm_step<false>(S0, C, ctb0, ctb1, hout, b, h, es, c, w, tt, et, lane);
            ML_BAR(); mlstm_step<false>(S1, C, ctb1, ctb0, hout, b, h, es, c + 1, w, tt, et, lane);
        }
#elif MK_ML_PROBE == 2
        __syncthreads();
#pragma unroll 1
        for (int c = 0; c < 128; c += 2) {
            ML_BAR(); mlstm_load_set(S1, Of, qF, wqg, kT, vT, scal, b, h, bh, es, c + 1, w, tt); asm volatile("" :: "v"(S0.qf[0]), "v"(S0.ka[1][1]), "v"(S0.vf[1][1]), "v"(S0.wa[1]), "v"(S0.em), "v"(S0.decay));
            ML_BAR(); mlstm_load_set(S0, Of, qF, wqg, kT, vT, scal, b, h, bh, es, (c + 2 < 128) ? c + 2 : 127, w, tt); asm volatile("" :: "v"(S1.qf[0]), "v"(S1.ka[1][1]), "v"(S1.vf[1][1]), "v"(S1.wa[1]), "v"(S1.em), "v"(S1.decay));
        }
#endif
        __syncthreads();
    }
}

__device__ __forceinline__ void cgate_phase(const float* hout, const bf16* projc, const float* hnorm, bf16* ymix) {
    const int tx_ = opaque_tid();
    const int lane = tx_ & 63, gw = blockIdx.x * NWAVES + __builtin_amdgcn_readfirstlane(tx_ >> 6), NGW = gridDim.x * NWAVES;
    const bool own = gridDim.x == 256; const int j0 = 8 * (int)(blockIdx.x >> 3) + (gw & 7), t0 = 2048 * (int)(blockIdx.x & 7);
    for (int item0 = gw, k = 0; item0 < TOK * 8; item0 += NGW, ++k) {
        const int jj = j0 + 256 * k; const int tok = own ? t0 + (jj >> 3) : item0 >> 3, h = own ? jj & 7 : item0 & 7; const size_t off = (size_t)tok * DM + h * 512 + lane * 8;
#if MK_MLSTM_NAIVE || MK_ML_REFILL
        const f32x4 a = *(const f32x4*)(hout + off), c = *(const f32x4*)(hout + off + 4);
#else
        f32x4 a, c; { float h8[8]; unpack8(*(const u32x4*)((const bf16*)hout + off), h8); a = (f32x4){h8[0], h8[1], h8[2], h8[3]}; c = (f32x4){h8[4], h8[5], h8[6], h8[7]}; }
#endif
        const float ss = wave_sum((a.x * a.x + a.y * a.y) + (a.z * a.z + a.w * a.w) + (c.x * c.x + c.y * c.y) + (c.z * c.z + c.w * c.w));
        const float rstd = rsqrtf(ss * (1.f / 512.f) + RMS_EPS);
        float og[8]; unpack8(*(const u32x4*)(projc + (size_t)tok * C_N + 8192 + h * 512 + lane * 8), og);
        const f32x4 n0 = *(const f32x4*)(hnorm + h * 512 + lane * 8), n1 = *(const f32x4*)(hnorm + h * 512 + lane * 8 + 4);
        u32x4 w; w.x = pk2(sigmoidf_(og[0]) * a.x * rstd * n0.x, sigmoidf_(og[1]) * a.y * rstd * n0.y); w.y = pk2(sigmoidf_(og[2]) * a.z * rstd * n0.z, sigmoidf_(og[3]) * a.w * rstd * n0.w);
        w.z = pk2(sigmoidf_(og[4]) * c.x * rstd * n1.x, sigmoidf_(og[5]) * c.y * rstd * n1.y); w.w = pk2(sigmoidf_(og[6]) * c.z * rstd * n1.z, sigmoidf_(og[7]) * c.w * rstd * n1.w);
        *(u32x4*)(ymix + off) = w;
    }
}


#if MK_GLOG_CMP
__device__ __forceinline__ void cmpf_phase(const float* ref, const float* tst, size_t n, unsigned long long* ctl64) {
    const size_t gt = (size_t)blockIdx.x * 512 + threadIdx.x, NT = (size_t)gridDim.x * 512; unsigned long long cnt = 0, sd = 0, sr = 0;
    for (size_t i = gt; i < n; i += NT) { const float a = ref[i], d = (tst[i] + tst[i + GLOG_P2]) - a;   if (!(fabsf(d) <= 0.004f + 0.02f * fabsf(a))) ++cnt; sd += (unsigned long long)(fminf(d * d, 1e6f) * 16777216.0f); sr += (unsigned long long)(fminf(a * a, 1e6f) * 16777216.0f); }
    for (int o = 32; o >= 1; o >>= 1) { cnt += __shfl_xor(cnt, o); sd += __shfl_xor(sd, o); sr += __shfl_xor(sr, o); }
    if ((threadIdx.x & 63) == 0) { atomicAdd(ctl64, cnt); atomicAdd(ctl64 + 1, sd); atomicAdd(ctl64 + 2, sr); }
}
#endif
#if MK_NSA_CMP
__device__ __forceinline__ void cmp_phase(const bf16* ref, const bf16* tst, int c0, int c1, unsigned long long* ctl64) {
    const int tx_ = opaque_tid();
    const size_t gt = (size_t)blockIdx.x * 512 + tx_, NT = (size_t)gridDim.x * 512; const int cpr = (c1 - c0) / 8;
    unsigned long long cnt = 0, sd = 0, sr = 0;
    for (size_t it = gt; it < (size_t)TOK * cpr; it += NT) { const size_t off = (it / cpr) * DM + c0 + (it % cpr) * 8; float a[8], b[8]; unpack8(*(const u32x4*)(ref + off), a); unpack8(*(const u32x4*)(tst + off), b);
#pragma unroll
        for (int j = 0; j < 8; ++j) { const float d = b[j] - a[j]; if (!(fabsf(d) <= 0.004f + 0.02f * fabsf(a[j]))) ++cnt; sd += (unsigned long long)(fminf(d * d, 1e6f) * 16777216.0f); sr += (unsigned long long)(fminf(a[j] * a[j], 1e6f) * 16777216.0f); } }
    for (int o = 32; o >= 1; o >>= 1) { cnt += __shfl_xor(cnt, o); sd += __shfl_xor(sd, o); sr += __shfl_xor(sr, o); }
    if ((tx_ & 63) == 0) { atomicAdd(ctl64, cnt); atomicAdd(ctl64 + 1, sd); atomicAdd(ctl64 + 2, sr); }
}
#endif

__device__ __forceinline__ void xcd_barrier_rowlocal(const XcdBarrier& b, unsigned* mis) {
    asm volatile("s_waitcnt vmcnt(0)" ::: "memory");
    __syncthreads();
    if (threadIdx.x == 0) {
        unsigned* bar = b.bar;
        __builtin_amdgcn_s_waitcnt(0);
        unsigned nloc = b.st[0], nx = b.st[1];
        if (nloc == 0u) { xcd_barrier_complete(bar, b.x, nloc, nx); b.st[0] = nloc; b.st[1] = nx; }
        const bool local = (xb_ld(mis) == 0u) && (nx == 8u) && (nloc == 32u) && (gridDim.x == 256u);
        const unsigned old = xb_add(&bar[XB_XSUB(b.x)], 1u);
        const unsigned gen = old / nloc;
        if (old + 1u == (gen + 1u) * nloc) {
            if (!local) {
                __builtin_amdgcn_fence(__ATOMIC_RELEASE, "agent");
                asm volatile("s_waitcnt vmcnt(0)" ::: "memory");
                const unsigned og = xb_add(&bar[XB_TOP], 1u);
                const unsigned tg = og / nx;
                if (og + 1u == (tg + 1u) * nx) xb_add(&bar[XB_TOPGEN], 1u);
                else XB_SPIN(xb_ld(&bar[XB_TOPGEN]) == tg, bar);
            }
            __builtin_amdgcn_fence(__ATOMIC_ACQUIRE, "agent");
            xb_add(&bar[XB_XGEN(b.x)], 1u);
            asm volatile("s_waitcnt vmcnt(0)" ::: "memory");
        } else {
            XB_SPIN(xb_ld(&bar[XB_XGEN(b.x)]) == gen, bar);
            __builtin_amdgcn_fence(__ATOMIC_ACQUIRE, "agent");
            asm volatile("s_waitcnt vmcnt(0)" ::: "memory");
        }
    }
    __syncthreads();
}

#ifndef MK_PROBE
#define MK_PROBE 0
#define MK_PROBE_A 3
#define MK_PROBE_B 11
#endif
#ifndef MK_PER_PHASE
#define MK_PER_PHASE 0
#endif
constexpr int NPHASE = 19;
struct Args { const float* in[22]; float* out; unsigned char* ws; int ph_lo, ph_hi; };
__global__ void __launch_bounds__(NWAVES * 64, 2) mk_fwd(Args args) {
    extern __shared__ __attribute__((aligned(16))) unsigned char lds_raw[];
    LAS unsigned char* lds = (LAS unsigned char*)lds_raw;
    volatile LAS unsigned* MISC = (volatile LAS unsigned*)(lds + MISC_OFF);
    const int tid = threadIdx.x;
    if (tid < 64) MISC[tid] = 0u;
    __syncthreads();
    unsigned char* ws = args.ws;
    unsigned* ctl = (unsigned*)(ws + WS_CTL);
    XcdBarrier bar; bar.bar = ctl + CW_BAR; bar.x = 0; bar.st = nullptr;
    if (!MK_PER_PHASE) bar = xcd_barrier_post(ctl + CW_BAR, MISC + 8);
    unsigned* const mis = ctl + 8000;
    if (!MK_PER_PHASE && tid == 0 && bar.x != (blockIdx.x & 7u)) atomicAdd(mis, 1u);
    Ptrs P;
#pragma unroll
    for (int i = 0; i < 22; ++i) P.in[i] = args.in[i];
    P.out = args.out; P.ws = ws;
    const int lo = args.ph_lo, hi = args.ph_hi;
#define IN(k) (lo <= (k) && (k) < hi)
#define GRIDBAR() xcd_barrier(bar)
#define SEAM(k) do { if (IN(k) && IN((k) + 1)) xcd_barrier(bar); STAMP((k) + 1); } while (0)
#define SEAML(k) do { if (IN(k) && IN((k) + 1)) xcd_barrier_rowlocal(bar, mis); STAMP((k) + 1); } while (0)
    bf16* const U = (bf16*)(ws + WS_U); bf16* const PROJ = (bf16*)(ws + WS_PROJ); bf16* const YMIX = (bf16*)(ws + WS_YMIX); bf16* const Y = (bf16*)(ws + WS_Y);
    bf16* const Gb = (bf16*)(ws + WS_G); bf16* const U2 = (bf16*)(ws + WS_U2); bf16* const ACT = (bf16*)(ws + WS_ACT);
    float* const GLOG = (float*)(ws + WS_GLOG); float* const GIF = (float*)(ws + WS_GIF); bf16* const KCMP = (bf16*)(ws + WS_KCMP); bf16* const VCMP = (bf16*)(ws + WS_VCMP);
    float* const HOUT = (float*)(ws + WS_HOUT);
    const int G = gridDim.x, bx = blockIdx.x;

#if MK_PROBE
    unsigned long long* const tsb = (unsigned long long*)(ctl + 2048);
#define STAMP(k) do { if (blockIdx.x == 0 && tid == 0) tsb[k] = wall_clock64(); } while (0)
#else
#define STAMP(k) do { } while (0)
#endif
    STAMP(0);
    if (IN(0)) REPK(0) { prologue_phase(P, lds); __syncthreads(); } SEAM(0);
    if (IN(1)) {
        pg8::Gemm g{U, (const bf16*)(ws + WS_WAB), TOK, AB_N, DM}; pg8::StaticOrder S; S.init(TOK, AB_N, G, bx);
        pg8::EpiBf16P E{PROJ, AB_N};
        pg8::gemm_phase<pg8::EpiBf16P, pg8::StaticOrder, true, true>(lds, g, S, E);
#if MK_GLOG_CMP
        skinny_phase<5>(U, (const bf16*)(ws + WS_WABG), (float*)(ws + WS_R0 + 256 * MiB), 72, 72);
#endif
    } SEAM(1);
    if (IN(2)) {
        REPK(201) p2a_phase(PROJ, (bf16*)(ws + WS_POOLED), (bf16*)(ws + WS_KCR));
        REPK(202) vt_relayout_phase(PROJ, (bf16*)(ws + WS_VTS), (bf16*)(ws + WS_VTW), (bf16*)(ws + WS_KFS), (bf16*)(ws + WS_KFW), lds);
        GRIDBAR();
        { int kpool = 256; asm volatile("" : "+s"(kpool));
          pg8::Gemm g{(const bf16*)(ws + WS_POOLED), (const bf16*)(ws + WS_WPOOL), 4 * TOK, 1024, kpool}; pg8::PoolOrder S; S.c = bx; S.G = G;
          pg8::EpiPool E{YMIX, P.in[5]};
          pg8::gemm_phase<pg8::EpiPool, pg8::PoolOrder, true, true>(lds, g, S, E); }
        { pg8::Gemm g{(const bf16*)(ws + WS_KCR), (const bf16*)(ws + WS_WCMP), 8192, 1024, 2048}; pg8::CmpOrder S; S.c = bx; S.G = G;
          pg8::EpiCmp E{(float*)(ws + WS_PCMP)};
          pg8::gemm_phase<pg8::EpiCmp, pg8::CmpOrder, true, true>(lds, g, S, E); }
        {
          const bool gsplit = (G == 256); const int ks = gsplit ? (bx & 1) : 0;
          pg8::Gemm g{U + ks * 2048, (const bf16*)(ws + WS_WABG) + ks * 2048, TOK, 256, gsplit ? 2048 : DM, DM}; pg8::GateOrder S; S.c = bx; S.first = gsplit ? 128 : ((G >= 128) ? 64 : 0); S.n = gsplit ? 128 : 64; S.sh = gsplit ? 1 : 0;
          pg8::EpiGate E{GLOG + (size_t)ks * GLOG_P2};
          pg8::gemm_phase<pg8::EpiGate, pg8::GateOrder, true, true>(lds, g, S, E);
          if (!gsplit) for (size_t i = (size_t)bx * 512 + tid; i < (size_t)GLOG_P2; i += (size_t)G * 512) GLOG[GLOG_P2 + i] = 0.f; }
        GRIDBAR();
        REPK(203) p2c_phase((const float*)(ws + WS_PCMP), (const float*)(ws + WS_CPART), P.in[8], P.in[10], KCMP, (bf16*)(ws + WS_VCT), (bf16*)(ws + WS_KCF), MK_NSA_CMP ? VCMP : (bf16*)nullptr, lds);
#if MK_NSA_CMP
    } SEAM(2);
#else
    } SEAML(2);
#endif
    if (IN(3)) {
#if MK_GLOG_CMP
        cmpf_phase((const float*)(ws + WS_R0 + 256 * MiB), GLOG, (size_t)TOK * 72, (unsigned long long*)(ctl + 3072));
#endif
#if MK_NSA_CMP
        nsa_naive_phase(PROJ, KCMP, VCMP, GLOG, (bf16*)(ws + WS_YMIX2), lds); __syncthreads();
#endif
#if MK_NSA_V1
        nsa_fast_phase(PROJ, KCMP, (const bf16*)(ws + WS_VCT), (const bf16*)(ws + WS_VTS), (const bf16*)(ws + WS_VTW), GLOG, YMIX, lds);
#else
        nsa_fast2_phase(PROJ, (const bf16*)(ws + WS_KCF), (const bf16*)(ws + WS_VCT), (const bf16*)(ws + WS_KFS), (const bf16*)(ws + WS_VTS), (const bf16*)(ws + WS_KFW), (const bf16*)(ws + WS_VTW), GLOG, YMIX, lds);
#endif
    } SEAM(3);
    if (IN(4)) {
#if MK_NSA_CMP
        cmp_phase((const bf16*)(ws + WS_YMIX2), YMIX, 1024, 4096, (unsigned long long*)(ctl + 3072));
#endif
        pg8::Gemm g{YMIX, (const bf16*)(ws + WS_WOAB), TOK, DM, DM}; pg8::StaticOrder S; S.init(TOK, DM, G, bx);
        pg8::EpiBf16P E{Y, DM};
        pg8::gemm_phase<pg8::EpiBf16P, pg8::StaticOrder, true, true>(lds, g, S, E);
    } SEAML(4);
    if (IN(5)) REPK(5) { post_phase<false, true>(Y, P.in[2], P.in[0], ws + WS_HB, P.in[16], U); } SEAML(5);
    if (IN(6)) {
        pg8::Gemm g{U, (const bf16*)(ws + WS_WF1), TOK, F1N, DM}; LAS unsigned char* wl = lds + pg8::STAGE_BYTES + __builtin_amdgcn_readfirstlane((int)(threadIdx.x >> 6)) * 2048;
        pg8::ActOrder S; S.S.init(TOK, F1N, G, bx); S.cw = P.in[19]; S.cb = P.in[20]; S.dff = DFF; S.wl = wl;
        pg8::EpiAct E{ACT, (bf16*)(ws + WS_SIDE), wl, FFP, DFF};
        pg8::gemm_phase<pg8::EpiAct, pg8::ActOrder, true, true>(lds, g, S, E);
        { const int full = S.S.nwg / G, left = S.S.nwg - full * G;
          __syncthreads(); if (left == 0) f2_convert_tail(P, 0, bx, G, lds); else if (bx >= left) f2_convert_tail(P, 0, bx - left, G - left, lds); }
    } SEAM(6);
    if (IN(7)) REPK(7) { act_fix_phase((const bf16*)(ws + WS_SIDE), P.in[19], P.in[20], ACT); } SEAML(7);
    if (IN(8)) {
        pg8::Gemm g{ACT, (const bf16*)(ws + WS_WF2), TOK, DM, FFP}; pg8::StaticOrder S; S.init(TOK, DM, G, bx);
        pg8::EpiBf16P E{Y, DM};
        pg8::gemm_phase<pg8::EpiBf16P, pg8::StaticOrder, true, true>(lds, g, S, E);
    } SEAML(8);
    if (IN(9)) { post_phase<true, true>(Y, P.in[17], ws + WS_HB, ws + WS_HB, P.in[1] + DM, U); } SEAM(9);
    if (IN(10)) {
        pg8::Gemm g{U, (const bf16*)(ws + WS_WC), TOK, C_N, DM}; pg8::StaticOrder S; S.init(TOK, C_N, G, bx);
        pg8::EpiBf16P E{PROJ, C_N};
        pg8::gemm_phase<pg8::EpiBf16P, pg8::StaticOrder, true, true>(lds, g, S, E);
#if MK_MLSTM_NAIVE
        skinny_phase<1>(U, (const bf16*)(ws + WS_WCG), GIF, 16, 16);
#else
        REPK(110) cgates_phase(U, (const bf16*)(ws + WS_WCG), P.in[13], (float*)(ws + WS_LSC), lds);
#endif
    } SEAM(10);
    if (IN(11)) {
#if MK_MLSTM_NAIVE
        mlstm_naive_phase(PROJ, GIF, P.in[13], HOUT, lds);
#else
        REPK(111) mlstm_pre2_phase(PROJ, (const float*)(ws + WS_LSC), (float*)(ws + WS_SCAL), (bf16*)(ws + WS_WQ), (bf16*)(ws + WS_KT), (bf16*)(ws + WS_VT), (bf16*)(ws + WS_QF), lds);
        GRIDBAR();
        REPK(11) mlstm_fast2_phase((const bf16*)(ws + WS_QF), (const bf16*)(ws + WS_WQ), (const bf16*)(ws + WS_KT), (const bf16*)(ws + WS_VT), (const float*)(ws + WS_SCAL), HOUT, lds);
#endif
    } SEAM(11);
    if (IN(12)) REPK(12) { cgate_phase(HOUT, PROJ, P.in[14], YMIX); } SEAM(12);
    if (IN(13)) {
        pg8::Gemm g{YMIX, (const bf16*)(ws + WS_WOC), TOK, DM, DM}; pg8::StaticOrder S; S.init(TOK, DM, G, bx);
        pg8::EpiBf16P E{Y, DM};
        pg8::gemm_phase<pg8::EpiBf16P, pg8::StaticOrder, true, true>(lds, g, S, E);
    } SEAML(13);
    if (IN(14)) { post_phase<true, true>(Y, P.in[2] + DM, ws + WS_HB, ws + WS_HB, P.in[16] + DM, U); } SEAML(14);
    if (IN(15)) {
        pg8::Gemm g{U, (const bf16*)(ws + WS_WF1 + WF1_BYTES), TOK, F1N, DM}; LAS unsigned char* wl = lds + pg8::STAGE_BYTES + __builtin_amdgcn_readfirstlane((int)(threadIdx.x >> 6)) * 2048;
        pg8::ActOrder S; S.S.init(TOK, F1N, G, bx); S.cw = P.in[19] + 3 * DFF; S.cb = P.in[20] + DFF; S.dff = DFF; S.wl = wl;
        pg8::EpiAct E{ACT, (bf16*)(ws + WS_SIDE), wl, FFP, DFF};
        pg8::gemm_phase<pg8::EpiAct, pg8::ActOrder, true, true>(lds, g, S, E);
        { const int full = S.S.nwg / G, left = S.S.nwg - full * G;
          __syncthreads(); if (left == 0) f2_convert_tail(P, 1, bx, G, lds); else if (bx >= left) f2_convert_tail(P, 1, bx - left, G - left, lds); }
    } SEAM(15);
    if (IN(16)) { act_fix_phase((const bf16*)(ws + WS_SIDE), P.in[19] + 3 * DFF, P.in[20] + DFF, ACT); } SEAML(16);
    if (IN(17)) {
        pg8::Gemm g{ACT, (const bf16*)(ws + WS_WF2 + WF2_BYTES), TOK, DM, FFP}; pg8::StaticOrder S; S.init(TOK, DM, G, bx);
        pg8::EpiBf16P E{Y, DM};
        pg8::gemm_phase<pg8::EpiBf16P, pg8::StaticOrder, true, true>(lds, g, S, E);
    } SEAML(17);
    if (IN(18)) { post_phase<true, false>(Y, P.in[17] + DM, ws + WS_HB, P.out, nullptr, U); }
#if MK_NSA_CMP || MK_GLOG_CMP
    xcd_barrier(bar);
    if (blockIdx.x == 0 && tid == 0) { const unsigned long long* c64 = (const unsigned long long*)(ctl + 3072);
        const double cnt = (double)__hip_atomic_load(c64, __ATOMIC_RELAXED, __HIP_MEMORY_SCOPE_AGENT), sd = (double)__hip_atomic_load(c64 + 1, __ATOMIC_RELAXED, __HIP_MEMORY_SCOPE_AGENT), sr = (double)__hip_atomic_load(c64 + 2, __ATOMIC_RELAXED, __HIP_MEMORY_SCOPE_AGENT);
        P.out[0] = (float)(sqrt(sd / (sr + 1.0)) * 1e4);
        P.out[1] = (float)(sqrt(cnt) * 30.0);
    }
#endif
#if MK_PROBE
    xcd_barrier(bar); STAMP(19); xcd_barrier(bar);
    {
        const float c1 = (float)((double)(__hip_atomic_load(tsb + MK_PROBE_A + 1, __ATOMIC_RELAXED, __HIP_MEMORY_SCOPE_AGENT) - __hip_atomic_load(tsb + MK_PROBE_A, __ATOMIC_RELAXED, __HIP_MEMORY_SCOPE_AGENT)) * 0.01);
        const float c2 = (float)((double)(__hip_atomic_load(tsb + MK_PROBE_B + 1, __ATOMIC_RELAXED, __HIP_MEMORY_SCOPE_AGENT) - __hip_atomic_load(tsb + MK_PROBE_B, __ATOMIC_RELAXED, __HIP_MEMORY_SCOPE_AGENT)) * 0.0001);
        for (size_t i = (size_t)blockIdx.x * 512 + tid; i < (size_t)TOK * DM; i += (size_t)gridDim.x * 512) P.out[i] = (i == 0) ? c1 : c2;
    }
#endif
#undef IN
#undef SEAM
}

extern "C" void kernel_launch(void* const* d_in, const int* in_sizes, int n_in, void* d_out, int out_size, void* d_ws, size_t ws_size, hipStream_t stream) {
    static int grid = 0;
    if (grid == 0) {
        if (n_in != 22 || in_sizes[0] != TOK * DM || out_size != TOK * DM || ws_size < WS_END) { fprintf(stderr, "kernel_launch: unexpected problem shape or workspace (n_in %d, ws %zu < %zu); nothing launched\n", n_in, ws_size, (size_t)WS_END); grid = -1; return; }
        int dev = 0, cus = 0, per_cu = 0;
        if (hipGetDevice(&dev) != hipSuccess || hipDeviceGetAttribute(&cus, hipDeviceAttributeMultiprocessorCount, dev) != hipSuccess) { grid = -1; return; }
        if (hipFuncSetAttribute((const void*)mk_fwd, hipFuncAttributeMaxDynamicSharedMemorySize, LDS_BYTES) != hipSuccess) { fprintf(stderr, "kernel_launch: hipFuncSetAttribute failed\n"); grid = -1; return; }
        if (hipOccupancyMaxActiveBlocksPerMultiprocessor(&per_cu, (const void*)mk_fwd, NWAVES * 64, LDS_BYTES) != hipSuccess || per_cu < 1)
            fprintf(stderr, "kernel_launch: note: occupancy query reports %d workgroups per CU\n", per_cu);
        (void)hipGetLastError();
        grid = cus;
    }
    if (grid < 0) return;
    if (hipMemsetAsync((char*)d_ws + WS_CTL, 0, CTL_ZERO_BYTES, stream) != hipSuccess) return;
    Args a{};
    for (int i = 0; i < 22; ++i) a.in[i] = (const float*)d_in[i];
    a.out = (float*)d_out; a.ws = (unsigned char*)d_ws;
#if MK_PER_PHASE
    for (int p = 0; p < NPHASE; ++p) { a.ph_lo = p; a.ph_hi = p + 1; hipLaunchKernelGGL(mk_fwd, dim3(grid), dim3(NWAVES * 64), LDS_BYTES, stream, a); }
#else
    a.ph_lo = 0; a.ph_hi = NPHASE;
    hipLaunchKernelGGL(mk_fwd, dim3(grid), dim3(NWAVES * 64), LDS_BYTES, stream, a);
#endif
}
```

```cpp
#include <hip/hip_runtime.h>
#include <cstdio>
#include <cstdint>
namespace pg8 {
#define PG8_LAS __attribute__((address_space(3)))
typedef unsigned short bf16_t;
typedef short bf16x8 __attribute__((ext_vector_type(8)));
typedef float f32x4 __attribute__((ext_vector_type(4)));
typedef unsigned u32x4 __attribute__((ext_vector_type(4)));
constexpr int BM = 256, BK = 64, HALF = 128, HTB = HALF * BK * 2  , STAGE_BYTES = 8 * HTB, NXCD = 8, WGM = 8;

__host__ __device__ __forceinline__ int lds_byte(int r, int c) { const int st = (r >> 4) * 2 + (c >> 5), rr = r & 15, cc = c & 31, ob = rr * 64 + cc * 2; return st * 1024 + (ob ^ (((ob >> 9) & 1) << 5)); }
__host__ __device__ __forceinline__ void stage_rc(int b, int& R, int& C) { const int st = b / 1024, sb = b % 1024, swz = sb ^ (((sb >> 9) & 1) << 5); R = (st >> 1) * 16 + swz / 64; C = (st & 1) * 32 + (swz % 64) / 2; }
__host__ __device__ __forceinline__ int perm32(int rho) { const int n = rho >> 4, i = rho & 15; return 8 * (i >> 2) + 4 * n + (i & 3); }

struct Unit { int pm, pn, slot; };
struct Gemm { const bf16_t* A; const bf16_t* Bt; int M, N, K; int ld = 0; };

struct StaticOrder {
    int nM, nN, nwg, G, c;
    __host__ __device__ void init(int M, int N, int G_, int c_) { nM = M / BM; nN = N / BM; nwg = nM * nN; G = G_; c = c_; }
    __host__ __device__ bool next(int i, Unit& u) const {
        const long L = (long)i * G + c; if (L >= nwg) return false;
        int wgid = (int)L; { const int q = nwg / NXCD, r = nwg % NXCD, xcd = wgid % NXCD, off = wgid / NXCD; wgid = (xcd < r ? xcd * (q + 1) : r * (q + 1) + (xcd - r) * q) + off; }
        const int nig = WGM * nN, gid = wgid / nig, fm = gid * WGM, gsz = (nM - fm) < WGM ? (nM - fm) : WGM;
        u.pm = fm + ((wgid % nig) % gsz); u.pn = (wgid % nig) / gsz; return true;
    }
    __device__ __forceinline__ void a_ready(const Unit&) const {}
    __device__ __forceinline__ void done(const Unit&) const {}
};

__device__ __forceinline__ unsigned cvt_pk_bf16(float lo, float hi) { unsigned r; asm volatile("v_cvt_pk_bf16_f32 %0, %1, %2" : "=v"(r) : "v"(lo), "v"(hi)); return r; }

struct EpiBf16P {
    static constexpr bool PERM = true, AFTER_DRAIN = false;
    bf16_t* O; int ldc;
    __device__ __forceinline__ void operator()(const f32x4 (&acc)[2][2][4][2], const Unit& u, int wr, int wc, int fr, int fq) const {
        const int row0 = u.pm * BM + wr * 64 + fr, col0 = u.pn * BM + wc * 32 + 8 * fq;
#pragma unroll
        for (int ai = 0; ai < 2; ++ai)
#pragma unroll
            for (int m = 0; m < 4; ++m) { bf16_t* rowp = O + (size_t)(row0 + ai * HALF + m * 16) * ldc + col0;
#pragma unroll
                for (int bj = 0; bj < 2; ++bj) { const f32x4 v0 = acc[ai][bj][m][0], v1 = acc[ai][bj][m][1];
                    u32x4 w; w.x = cvt_pk_bf16(v0[0], v0[1]); w.y = cvt_pk_bf16(v0[2], v0[3]); w.z = cvt_pk_bf16(v1[0], v1[1]); w.w = cvt_pk_bf16(v1[2], v1[3]);
                    *(u32x4*)(rowp + bj * HALF) = w; } }
    }
};
struct EpiGU {
    static constexpr bool PERM = true, AFTER_DRAIN = false;
    bf16_t* G; bf16_t* U; int ldc;
    __device__ __forceinline__ void operator()(const f32x4 (&acc)[2][2][4][2], const Unit& u, int wr, int wc, int fr, int fq) const {
        const int row0 = u.pm * BM + wr * 64 + fr, col0 = u.pn * HALF + wc * 32 + 8 * fq;
#pragma unroll
        for (int ai = 0; ai < 2; ++ai)
#pragma unroll
            for (int m = 0; m < 4; ++m) { const size_t off = (size_t)(row0 + ai * HALF + m * 16) * ldc + col0;
#pragma unroll
                for (int bj = 0; bj < 2; ++bj) { const f32x4 v0 = acc[ai][bj][m][0], v1 = acc[ai][bj][m][1];
                    u32x4 w; w.x = cvt_pk_bf16(v0[0], v0[1]); w.y = cvt_pk_bf16(v0[2], v0[3]); w.z = cvt_pk_bf16(v1[0], v1[1]); w.w = cvt_pk_bf16(v1[2], v1[3]);
                    *(u32x4*)((bj == 0 ? G : U) + off) = w; } }
    }
};
struct EpiF32P {
    static constexpr bool PERM = false, AFTER_DRAIN = false;
    float* C; int ldc;
    __device__ __forceinline__ void operator()(const f32x4 (&acc)[2][2][4][2], const Unit& u, int wr, int wc, int fr, int fq) const {
        const int row0 = u.pm * BM + wr * 64 + fr, col0 = u.pn * BM + wc * 32 + 4 * fq;
#pragma unroll
        for (int ai = 0; ai < 2; ++ai)
#pragma unroll
            for (int m = 0; m < 4; ++m) { float* rowp = C + (size_t)(row0 + ai * HALF + m * 16) * ldc + col0;
#pragma unroll
                for (int bj = 0; bj < 2; ++bj)
#pragma unroll
                    for (int n = 0; n < 2; ++n) *(f32x4*)(rowp + bj * HALF + n * 16) = acc[ai][bj][m][n]; }
    }
};


struct PoolOrder { int c, G;
    __device__ __forceinline__ bool next(int i, Unit& u) const { long L;
        if (G == 256) { if (c < 64 || c >= 128 || i >= 4) return false; L = (c - 64) + 64 * i; } else { L = (long)i * G + c; if (L >= 256) return false; }
        u.pm = (int)L; u.pn = (int)L >> 6; return true; }
    __device__ __forceinline__ void a_ready(const Unit&) const {}
    __device__ __forceinline__ void done(const Unit&) const {}
};
struct EpiPool {
    static constexpr bool PERM = true, AFTER_DRAIN = false;
    bf16_t* O; const float* scale;
    __device__ __forceinline__ void operator()(const f32x4 (&acc)[2][2][4][2], const Unit& u, int wr, int wc, int fr, int fq) const {
        const int row0 = (u.pm & 63) * BM + wr * 64 + fr, col0 = u.pn * BM + wc * 32 + 8 * fq;
#pragma unroll
        for (int bj = 0; bj < 2; ++bj) { const f32x4 s0 = *(const f32x4*)(scale + col0 + bj * HALF), s1 = *(const f32x4*)(scale + col0 + bj * HALF + 4);
#pragma unroll
            for (int ai = 0; ai < 2; ++ai)
#pragma unroll
                for (int m = 0; m < 4; ++m) { const f32x4 v0 = acc[ai][bj][m][0] * s0, v1 = acc[ai][bj][m][1] * s1;
                    u32x4 w; w.x = cvt_pk_bf16(v0[0], v0[1]); w.y = cvt_pk_bf16(v0[2], v0[3]); w.z = cvt_pk_bf16(v1[0], v1[1]); w.w = cvt_pk_bf16(v1[2], v1[3]);
                    *(u32x4*)(O + (size_t)(row0 + ai * HALF + m * 16) * 4096 + col0 + bj * HALF) = w; } }
    }
};
struct CmpOrder { int c, G;
    __device__ __forceinline__ bool next(int i, Unit& u) const { const long L = (long)i * G + c; if (L >= 64) return false; const int w = (int)L >> 5, r = (int)L & 31; u.pm = w * 16 + (r >> 1); u.pn = w * 2 + (r & 1); return true; }
    __device__ __forceinline__ void a_ready(const Unit&) const {}
    __device__ __forceinline__ void done(const Unit&) const {}
};
struct EpiCmp {
    static constexpr bool PERM = false, AFTER_DRAIN = false;
    float* C;
    __device__ __forceinline__ void operator()(const f32x4 (&acc)[2][2][4][2], const Unit& u, int wr, int wc, int fr, int fq) const {
        const int row0 = u.pm * BM + wr * 64 + fr, col0 = (u.pn & 1) * BM + wc * 32 + 4 * fq;
#pragma unroll
        for (int ai = 0; ai < 2; ++ai)
#pragma unroll
            for (int m = 0; m < 4; ++m) { float* rowp = C + (size_t)(row0 + ai * HALF + m * 16) * 512 + col0;
#pragma unroll
                for (int bj = 0; bj < 2; ++bj)
#pragma unroll
                    for (int n = 0; n < 2; ++n) *(f32x4*)(rowp + bj * HALF + n * 16) = acc[ai][bj][m][n]; }
    }
};

__device__ __forceinline__ float dpp_ror1(float v) { return __builtin_bit_cast(float, __builtin_amdgcn_update_dpp(0, __builtin_bit_cast(int, v), 0x121, 0xf, 0xf, false)); }
__device__ __forceinline__ float dpp_ror2(float v) { return __builtin_bit_cast(float, __builtin_amdgcn_update_dpp(0, __builtin_bit_cast(int, v), 0x122, 0xf, 0xf, false)); }
struct ActOrder {
    StaticOrder S; const float* cw; const float* cb; int dff; PG8_LAS unsigned char* wl;
    __device__ __forceinline__ bool next(int i, Unit& u) const { if (!S.next(i, u)) return false; u.slot = i & 1; return true; }
    __device__ __forceinline__ void a_ready(const Unit& u) const {
        const int l = threadIdx.x & 31, wc = (threadIdx.x >> 6) & 3, a = l >> 3, q = l & 7;
        int ff = u.pn * HALF + wc * 32 + q * 4; ff = ff < dff - 4 ? ff : dff - 4;
        const float* src = (a < 3 ? cw + a * dff : cb) + ff;
        __builtin_amdgcn_global_load_lds((const unsigned*)src, (PG8_LAS unsigned*)(wl + u.slot * 1024), 16, 0, 0);
    }
    __device__ __forceinline__ void done(const Unit&) const {}
};
struct EpiAct {
    static constexpr bool PERM = true, AFTER_DRAIN = false;
    bf16_t* ACT; bf16_t* side; PG8_LAS unsigned char* wl; int ldc, dff;
    __device__ __forceinline__ void operator()(const f32x4 (&acc)[2][2][4][2], const Unit& u, int wr, int wc, int fr, int fq) const {
        const int ff0 = u.pn * HALF + wc * 32 + 8 * fq;
        float w0[8], w1[8], w2[8], bb[8];
        if (ff0 < dff) {
#pragma unroll
            for (int h = 0; h < 2; ++h) { const PG8_LAS float* wp = (const PG8_LAS float*)(wl + u.slot * 1024) + 8 * fq + 4 * h;
                const f32x4 a = *(const PG8_LAS f32x4*)wp, b1 = *(const PG8_LAS f32x4*)(wp + 32), c = *(const PG8_LAS f32x4*)(wp + 64), d = *(const PG8_LAS f32x4*)(wp + 96);
#pragma unroll
                for (int j = 0; j < 4; ++j) { w0[4 * h + j] = a[j]; w1[4 * h + j] = b1[j]; w2[4 * h + j] = c[j]; bb[4 * h + j] = d[j]; } }
        } else {
#pragma unroll
            for (int j = 0; j < 8; ++j) { w0[j] = 0.f; w1[j] = 0.f; w2[j] = 0.f; bb[j] = 0.f; } }
#pragma unroll
        for (int ai = 0; ai < 2; ++ai) {
            const int rowb = u.pm * BM + ai * HALF + wr * 64, chunk = rowb >> 6;
#pragma unroll
            for (int m = 0; m < 4; ++m) {
                float o[8];
#pragma unroll
                for (int e = 0; e < 8; ++e) { const float g = acc[ai][0][m][e >> 2][e & 3], up = acc[ai][1][m][e >> 2][e & 3];
                    const float gp = (m > 0) ? acc[ai][0][m > 0 ? m - 1 : 0][e >> 2][e & 3] : 0.f;
                    const float a1 = dpp_ror1(g), b1 = dpp_ror1(gp), a2 = dpp_ror2(g), b2 = dpp_ror2(gp);
                    const float p1 = fr >= 1 ? a1 : b1, p2 = fr >= 2 ? a2 : b2;
                    const float x = bb[e] + w0[e] * g + w1[e] * p1 + w2[e] * p2;
                    o[e] = x * __builtin_amdgcn_rcpf(1.0f + __builtin_amdgcn_exp2f(-1.4426950408889634f * x)) * up; }
                if (!(m == 0 && fr < 2)) { u32x4 w; w.x = cvt_pk_bf16(o[0], o[1]); w.y = cvt_pk_bf16(o[2], o[3]); w.z = cvt_pk_bf16(o[4], o[5]); w.w = cvt_pk_bf16(o[6], o[7]);
                    *(u32x4*)(ACT + (size_t)(rowb + 16 * m + fr) * ldc + ff0) = w; }
                if ((m == 0 && fr < 2) || (m == 3 && fr >= 14)) { const int rr = (m == 0) ? fr : fr - 12;
                    const f32x4 g0 = acc[ai][0][m][0], g1 = acc[ai][0][m][1], u0 = acc[ai][1][m][0], u1 = acc[ai][1][m][1];
                    u32x4 wg, wu; wg.x = cvt_pk_bf16(g0[0], g0[1]); wg.y = cvt_pk_bf16(g0[2], g0[3]); wg.z = cvt_pk_bf16(g1[0], g1[1]); wg.w = cvt_pk_bf16(g1[2], g1[3]);
                    wu.x = cvt_pk_bf16(u0[0], u0[1]); wu.y = cvt_pk_bf16(u0[2], u0[3]); wu.z = cvt_pk_bf16(u1[0], u1[1]); wu.w = cvt_pk_bf16(u1[2], u1[3]);
                    bf16_t* sp = side + ((size_t)(chunk * 4 + rr) * 2) * ldc + ff0; *(u32x4*)sp = wg; *(u32x4*)(sp + ldc) = wu; }
            }
        }
    }
};

struct EpiAB {
    static constexpr bool PERM = true, AFTER_DRAIN = false;
    bf16_t* O; float* glog;
    __device__ __forceinline__ void operator()(const f32x4 (&acc)[2][2][4][2], const Unit& u, int wr, int wc, int fr, int fq) const {
        const int row0 = u.pm * BM + wr * 64 + fr;
        if (u.pn < 28) { const int col0 = u.pn * BM + wc * 32 + 8 * fq;
#pragma unroll
            for (int ai = 0; ai < 2; ++ai)
#pragma unroll
                for (int m = 0; m < 4; ++m) { bf16_t* rowp = O + (size_t)(row0 + ai * HALF + m * 16) * 7168 + col0;
#pragma unroll
                    for (int bj = 0; bj < 2; ++bj) { const f32x4 v0 = acc[ai][bj][m][0], v1 = acc[ai][bj][m][1];
                        u32x4 w; w.x = cvt_pk_bf16(v0[0], v0[1]); w.y = cvt_pk_bf16(v0[2], v0[3]); w.z = cvt_pk_bf16(v1[0], v1[1]); w.w = cvt_pk_bf16(v1[2], v1[3]);
                        *(u32x4*)(rowp + bj * HALF) = w; } }
        } else { const int c0 = wc * 32 + 8 * fq;
            if (c0 < 72) {
#pragma unroll
                for (int ai = 0; ai < 2; ++ai)
#pragma unroll
                    for (int m = 0; m < 4; ++m) { float* rowp = glog + (size_t)(row0 + ai * HALF + m * 16) * 72 + c0;
                        *(f32x4*)rowp = acc[ai][0][m][0]; *(f32x4*)(rowp + 4) = acc[ai][0][m][1]; } } }
    }
};

struct GateOrder { int c, first, n, sh;
    __device__ __forceinline__ bool next(int i, Unit& u) const { if (i != 0 || c < first || c >= first + n) return false; u.pm = (c - first) >> sh; u.pn = 0; return true; }
    __device__ __forceinline__ void a_ready(const Unit&) const {}
    __device__ __forceinline__ void done(const Unit&) const {}
};
struct EpiGate {
    static constexpr bool PERM = true, AFTER_DRAIN = false;
    float* glog;
    __device__ __forceinline__ void operator()(const f32x4 (&acc)[2][2][4][2], const Unit& u, int wr, int wc, int fr, int fq) const {
        const int row0 = u.pm * BM + wr * 64 + fr, c0 = wc * 32 + 8 * fq;
        if (c0 < 72) {
#pragma unroll
            for (int ai = 0; ai < 2; ++ai)
#pragma unroll
                for (int m = 0; m < 4; ++m) { float* rowp = glog + (size_t)(row0 + ai * HALF + m * 16) * 72 + c0;
                    *(f32x4*)rowp = acc[ai][0][m][0]; *(f32x4*)(rowp + 4) = acc[ai][0][m][1]; } }
    }
};
template <class Epi, class Sched, bool ALIGN_EPI = false, bool SP2 = false>
__device__ __forceinline__ void gemm_phase(PG8_LAS unsigned char* lds, const Gemm g, const Sched& S, const Epi& E) {
    const int tid = threadIdx.x, wid = __builtin_amdgcn_readfirstlane(tid >> 6), lane = tid & 63, wr = wid >> 2, wc = wid & 3, fr = lane & 15, fq = lane >> 4;
    const int K = g.K, LD = g.ld ? g.ld : g.K, nt = K / BK;
    unsigned voffA[2], voffB[2];
#pragma unroll
    for (int i = 0; i < 2; ++i) { int R, C; stage_rc(tid * 16 + i * 8192, R, C); const int Rb = Epi::PERM ? ((R & ~31) + perm32(R & 31)) : R;
        voffA[i] = (unsigned)(R * LD + C) * 2u; voffB[i] = (unsigned)(Rb * LD + C) * 2u; }
    const size_t kstep = (size_t)(BK * 2);
    const size_t hstep = (size_t)HALF * LD * 2;
    const size_t tstep = 2 * hstep;
    const unsigned ldsw = (unsigned)wid * 1024u;
    const int aoff = lds_byte(wr * 64 + fr, fq * 8), boff = lds_byte(wc * 32 + fr, fq * 8);
#define PG8_SA(b, h) (((b) * 2 + (h)) * HTB)
#define PG8_SB(b, h) ((4 + (b) * 2 + (h)) * HTB)
#define PG8_STAGE(bufoff, gbase, voff) do { _Pragma("unroll") for (int _i = 0; _i < 2; ++_i) \
        __builtin_amdgcn_global_load_lds((const unsigned*)((const char*)(gbase) + (voff)[_i]), (PG8_LAS unsigned*)(lds + (bufoff) + ldsw + _i * 8192), 16, 0, 0); } while (0)
#define PG8_LDA(dst, b, h) do { _Pragma("unroll") for (int m = 0; m < 4; ++m) _Pragma("unroll") for (int k = 0; k < 2; ++k) dst[m][k] = *(const PG8_LAS bf16x8*)(lds + PG8_SA(b, h) + aoff + m * 2048 + k * 1024); } while (0)
#define PG8_LDB(dst, b, h) do { _Pragma("unroll") for (int n = 0; n < 2; ++n) _Pragma("unroll") for (int k = 0; k < 2; ++k) dst[n][k] = *(const PG8_LAS bf16x8*)(lds + PG8_SB(b, h) + boff + n * 2048 + k * 1024); } while (0)
#define PG8_MMA(ai, bj, At, Bt) do { __builtin_amdgcn_s_setprio(1); _Pragma("unroll") for (int m = 0; m < 4; ++m) _Pragma("unroll") for (int n = 0; n < 2; ++n) _Pragma("unroll") for (int k = 0; k < 2; ++k) \
        acc[ai][bj][m][n] = __builtin_amdgcn_mfma_f32_16x16x32_bf16(Bt[n][k], At[m][k], acc[ai][bj][m][n], 0, 0, 0); __builtin_amdgcn_s_setprio(0); } while (0)
#define PG8_WAIT_V(n) asm volatile("s_waitcnt vmcnt(" #n ")" ::: "memory")
#define PG8_WAIT_L(n) asm volatile("s_waitcnt lgkmcnt(" #n ")" ::: "memory")
#define PG8_BAR __builtin_amdgcn_s_barrier()
#define PG8_SCHED __builtin_amdgcn_sched_barrier(0)
    Unit cur, nxt; int ui = 0;
    if (!S.next(0, cur)) return;
    f32x4 acc[2][2][4][2];
#pragma unroll
    for (int a = 0; a < 2; ++a)
#pragma unroll
        for (int b = 0; b < 2; ++b)
#pragma unroll
            for (int m = 0; m < 4; ++m)
#pragma unroll
                for (int n = 0; n < 2; ++n) acc[a][b][m][n] = (f32x4){0.f, 0.f, 0.f, 0.f};
    bf16x8 At[4][2], B0[2][2], B1[2][2];
    const char* cA = (const char*)g.A + (size_t)cur.pm * tstep; const char* cB = (const char*)g.Bt + (size_t)cur.pn * tstep;
    S.a_ready(cur);
    if constexpr (SP2) {
        PG8_STAGE(PG8_SB(0, 0), cB, voffB); PG8_STAGE(PG8_SB(0, 1), cB + hstep, voffB); PG8_STAGE(PG8_SA(0, 0), cA, voffA); PG8_STAGE(PG8_SA(0, 1), cA + hstep, voffA);
        if (wr == 1) PG8_BAR;
        PG8_WAIT_V(2); PG8_BAR;
        PG8_STAGE(PG8_SB(1, 0), cB + kstep, voffB); PG8_STAGE(PG8_SA(1, 0), cA + kstep, voffA); PG8_STAGE(PG8_SB(1, 1), cB + hstep + kstep, voffB);
        PG8_WAIT_V(6); PG8_BAR;
    } else {
        PG8_STAGE(PG8_SB(0, 0), cB, voffB); PG8_STAGE(PG8_SA(0, 0), cA, voffA); PG8_STAGE(PG8_SB(0, 1), cB + hstep, voffB); PG8_STAGE(PG8_SA(0, 1), cA + hstep, voffA);
        if (wr == 1) PG8_BAR;
        PG8_WAIT_V(4); PG8_BAR;
        PG8_STAGE(PG8_SB(1, 0), cB + kstep, voffB); PG8_STAGE(PG8_SA(1, 0), cA + kstep, voffA); PG8_STAGE(PG8_SB(1, 1), cB + hstep + kstep, voffB);
        PG8_WAIT_V(6); PG8_BAR;
    }
    for (;;) {
        const bool has_next = S.next(ui + 1, nxt);
        const char* nA = has_next ? (const char*)g.A + (size_t)nxt.pm * tstep : cA; const char* nB = has_next ? (const char*)g.Bt + (size_t)nxt.pn * tstep : cB;
        for (int t = 0; t < nt; t += 2) {
            const bool last = (t == nt - 2);
            const char* a1 = cA + (size_t)(t + 1) * kstep;
            const char* a2 = last ? nA : cA + (size_t)(t + 2) * kstep; const char* b2 = last ? nB : cB + (size_t)(t + 2) * kstep;
            const char* a3 = a2 + kstep; const char* b3 = b2 + kstep;
            if (last && has_next) S.a_ready(nxt);
            if constexpr (SP2) {
            PG8_LDB(B0, 0, 0); PG8_LDB(B1, 0, 1); PG8_SCHED; PG8_LDA(At, 0, 0); PG8_STAGE(PG8_SA(1, 1), a1 + hstep, voffA);
            PG8_WAIT_V(8); PG8_WAIT_L(0); PG8_BAR; PG8_MMA(0, 0, At, B0); PG8_MMA(0, 1, At, B1); PG8_BAR; PG8_SCHED;
            PG8_LDA(At, 0, 1); PG8_STAGE(PG8_SB(0, 0), b2, voffB); PG8_STAGE(PG8_SB(0, 1), b2 + hstep, voffB); PG8_STAGE(PG8_SA(0, 0), a2, voffA);
            PG8_WAIT_V(8); PG8_WAIT_L(0); PG8_BAR; PG8_MMA(1, 0, At, B0); PG8_MMA(1, 1, At, B1); PG8_BAR; PG8_SCHED;
            PG8_LDB(B0, 1, 0); PG8_LDB(B1, 1, 1); PG8_SCHED; PG8_LDA(At, 1, 0); PG8_STAGE(PG8_SA(0, 1), a2 + hstep, voffA);
            PG8_WAIT_V(8); PG8_WAIT_L(0); PG8_BAR; PG8_MMA(0, 0, At, B0); PG8_MMA(0, 1, At, B1); PG8_BAR; PG8_SCHED;
            PG8_LDA(At, 1, 1); PG8_STAGE(PG8_SB(1, 0), b3, voffB); PG8_STAGE(PG8_SB(1, 1), b3 + hstep, voffB); PG8_STAGE(PG8_SA(1, 0), a3, voffA);
            PG8_WAIT_V(8); PG8_WAIT_L(0); PG8_BAR; PG8_MMA(1, 0, At, B0); PG8_MMA(1, 1, At, B1); PG8_BAR; PG8_SCHED;
            } else {
            PG8_LDB(B0, 0, 0); PG8_SCHED; PG8_LDA(At, 0, 0); PG8_STAGE(PG8_SA(1, 1), a1 + hstep, voffA);
            PG8_WAIT_L(8); PG8_BAR; PG8_WAIT_L(0); PG8_MMA(0, 0, At, B0); PG8_BAR; PG8_SCHED;
            PG8_LDB(B1, 0, 1); PG8_STAGE(PG8_SB(0, 0), b2, voffB);
            PG8_BAR; PG8_WAIT_L(0); PG8_MMA(0, 1, At, B1); PG8_BAR;
            PG8_LDA(At, 0, 1); PG8_STAGE(PG8_SA(0, 0), a2, voffA);
            PG8_BAR; PG8_WAIT_L(0); PG8_MMA(1, 0, At, B0); PG8_BAR; PG8_SCHED;
            PG8_STAGE(PG8_SB(0, 1), b2 + hstep, voffB);
            PG8_WAIT_V(6); PG8_BAR; PG8_MMA(1, 1, At, B1); PG8_BAR;
            PG8_LDB(B0, 1, 0); PG8_SCHED; PG8_LDA(At, 1, 0); PG8_STAGE(PG8_SA(0, 1), a2 + hstep, voffA);
            PG8_WAIT_L(8); PG8_BAR; PG8_WAIT_L(0); PG8_MMA(0, 0, At, B0); PG8_BAR; PG8_SCHED;
            PG8_LDB(B1, 1, 1); PG8_STAGE(PG8_SB(1, 0), b3, voffB);
            PG8_BAR; PG8_WAIT_L(0); PG8_MMA(0, 1, At, B1); PG8_BAR;
            PG8_LDA(At, 1, 1); PG8_STAGE(PG8_SA(1, 0), a3, voffA);
            PG8_BAR; PG8_WAIT_L(0); PG8_MMA(1, 0, At, B0); PG8_BAR; PG8_SCHED;
            PG8_STAGE(PG8_SB(1, 1), b3 + hstep, voffB);
            PG8_WAIT_V(6); PG8_BAR; PG8_MMA(1, 1, At, B1); PG8_BAR;
            }
        }
        if constexpr (ALIGN_EPI) { if (wr == 0) PG8_BAR; }
        if constexpr (!Epi::AFTER_DRAIN) { E(acc, cur, wr, wc, fr, fq); S.done(cur); }
        if (!has_next) break;
#pragma unroll
        for (int a = 0; a < 2; ++a)
#pragma unroll
            for (int b = 0; b < 2; ++b)
#pragma unroll
                for (int m = 0; m < 4; ++m)
#pragma unroll
                    for (int n = 0; n < 2; ++n) acc[a][b][m][n] = (f32x4){0.f, 0.f, 0.f, 0.f};
        cur = nxt; cA = nA; cB = nB; ++ui;
        if constexpr (ALIGN_EPI) { if (wr == 1) PG8_BAR; }
    }
    PG8_WAIT_V(0);
    if constexpr (!ALIGN_EPI) { if (wr == 0) PG8_BAR; }
    PG8_BAR;
    if constexpr (Epi::AFTER_DRAIN) { E.fused(acc, cur, wr, wc, fr, fq, lds, wid, lane); S.done(cur); }
#undef PG8_SA
#undef PG8_SB
#undef PG8_STAGE
#undef PG8_LDA
#undef PG8_LDB
#undef PG8_MMA
#undef PG8_WAIT_V
#undef PG8_WAIT_L
#undef PG8_BAR
#undef PG8_SCHED
}
}
#define LAS __attribute__((address_space(3)))
#define XB_TMO      128
#define XB_XCNT(j)  (256  + 64 * (j))
#define XB_XSUB(j)  (1280 + 64 * (j))
#define XB_XGEN(j)  (2304 + 64 * (j))
#define XB_TOP      3328
#define XB_TOPGEN   3392
#define XCD_BAR_WORDS 3456
#define XB_SPIN_CAP (1u << 18)

__device__ __forceinline__ unsigned xb_ld(unsigned* p)              { return __hip_atomic_load(p, __ATOMIC_RELAXED, __HIP_MEMORY_SCOPE_AGENT); }
__device__ __forceinline__ unsigned xb_add(unsigned* p, unsigned v) { return __hip_atomic_fetch_add(p, v, __ATOMIC_RELAXED, __HIP_MEMORY_SCOPE_AGENT); }
__device__ __forceinline__ unsigned xb_xcc_id() { return (unsigned)__builtin_amdgcn_s_getreg((3 << 11) | 20) & 0xFu; }
#define XB_SPIN(cond, bar) do { unsigned _sp = 0; while (cond) { __builtin_amdgcn_s_sleep(1); \
    if ((++_sp & 255u) == 0u) { if (xb_ld(&(bar)[XB_TMO])) break; if (_sp > XB_SPIN_CAP) { atomicAdd(&(bar)[XB_TMO], 1u); break; } } } } while (0)

struct XcdBarrier {
    unsigned* bar; unsigned x;
    volatile LAS unsigned* st;
};

__device__ __forceinline__ XcdBarrier xcd_barrier_post(unsigned* bar, volatile LAS unsigned* st) {
    XcdBarrier b; b.bar = bar; b.x = xb_xcc_id(); b.st = st;
    if (threadIdx.x == 0) (void)xb_add(&bar[XB_XCNT(b.x)], 1u);
    return b;
}
__device__ __forceinline__ void xcd_barrier_complete(unsigned* bar, unsigned x, unsigned& nloc, unsigned& nx) {
    const unsigned G = gridDim.x * gridDim.y * gridDim.z;
    unsigned sum, cnt, mine, sp = 0u;
    for (;;) {
        sum = 0u; cnt = 0u; mine = 0u;
#pragma unroll
        for (unsigned j = 0; j < 16; ++j) { const unsigned c = xb_ld(&bar[XB_XCNT(j)]); sum += c; cnt += (c > 0u) ? 1u : 0u; mine = (j == x) ? c : mine; }
        if (sum == G) break;
        __builtin_amdgcn_s_sleep(1);
        if ((++sp & 255u) == 0u) { if (xb_ld(&bar[XB_TMO])) break; if (sp > XB_SPIN_CAP) { atomicAdd(&bar[XB_TMO], 1u); break; } }
    }
    nloc = mine > 0u ? mine : 1u; nx = cnt > 0u ? cnt : 1u;
}

__device__ __forceinline__ void xcd_barrier(const XcdBarrier& b) {
    asm volatile("s_waitcnt vmcnt(0)" ::: "memory");
    __syncthreads();
    if (threadIdx.x == 0) {
        unsigned* bar = b.bar;
        __builtin_amdgcn_s_waitcnt(0);
        unsigned nloc = b.st[0], nx = b.st[1];
        if (nloc == 0u) { xcd_barrier_complete(bar, b.x, nloc, nx); b.st[0] = nloc; b.st[1] = nx; }
        const unsigned old = xb_add(&bar[XB_XSUB(b.x)], 1u);
        const unsigned gen = old / nloc;
        if (old + 1u == (gen + 1u) * nloc) {
            __builtin_amdgcn_fence(__ATOMIC_RELEASE, "agent");
            asm volatile("s_waitcnt vmcnt(0)" ::: "memory");
            const unsigned og = xb_add(&bar[XB_TOP], 1u);
            const unsigned tg = og / nx;
            if (og + 1u == (tg + 1u) * nx) xb_add(&bar[XB_TOPGEN], 1u);
            else XB_SPIN(xb_ld(&bar[XB_TOPGEN]) == tg, bar);
            __builtin_amdgcn_fence(__ATOMIC_ACQUIRE, "agent");
            xb_add(&bar[XB_XGEN(b.x)], 1u);
            asm volatile("s_waitcnt vmcnt(0)" ::: "memory");
        } else {
            XB_SPIN(xb_ld(&bar[XB_XGEN(b.x)]) == gen, bar);
            __builtin_amdgcn_fence(__ATOMIC_ACQUIRE, "agent");
            asm volatile("s_waitcnt vmcnt(0)" ::: "memory");
        }
    }
    __syncthreads();
}
#ifndef MK_REP_PHASE
#define MK_REP_PHASE -1
#endif
#define REPK(k) for (int rep_ = 0; rep_ < ((k) == MK_REP_PHASE ? 2 : 1); ++rep_)
#ifndef MK_ML_WARM
#define MK_ML_WARM 0
#endif
#ifndef MK_GLOG_CMP
#define MK_GLOG_CMP 0
#endif
#ifndef MK_ML_PROBE
#define MK_ML_PROBE 0
#endif
#ifndef MK_ML_REFILL
#define MK_ML_REFILL 0
#endif
#ifndef MK_NSA_V1
#define MK_NSA_V1 0
#endif
#ifndef MK_MLSTM_NAIVE
#define MK_MLSTM_NAIVE 0
#endif
#ifndef MK_NSA_CMP
#define MK_NSA_CMP 0
#endif

typedef unsigned short bf16;
typedef float f32x4 __attribute__((ext_vector_type(4)));
typedef short bf16x8 __attribute__((ext_vector_type(8)));
typedef unsigned u32x4 __attribute__((ext_vector_type(4)));
typedef unsigned u32x2 __attribute__((ext_vector_type(2)));
constexpr int NWAVES = 8;
constexpr int TOK = 16384, DM = 4096, SEQ = 8192;
constexpr int AB_N = 7168, AB_W = 7240, C_N = 12288, C_W = 12304;
constexpr int DFF = 10944, FFP = 11008, F1N = 22016, F1W = 21888;
constexpr float RMS_EPS = 1e-6f;
constexpr float NEGF = -1e30f;
constexpr size_t MiB = 1u << 20;
constexpr size_t WS_CTL = 0, CTL_ZERO_BYTES = 1 * MiB;
constexpr size_t WS_WAB = 1 * MiB, WS_WABG = 57 * MiB  , WS_WOAB = 60 * MiB, WS_WC = 92 * MiB, WS_WCG = 188 * MiB, WS_WOC = 189 * MiB;
constexpr size_t WS_WF1 = 221 * MiB, WF1_BYTES = 172 * MiB, WS_WF2 = 565 * MiB, WF2_BYTES = 86 * MiB;
constexpr size_t WS_R0 = 737 * MiB, WS_R1 = 1425 * MiB, WS_R2 = 1769 * MiB, WS_HB = 1969 * MiB  , WS_PROJC = 2097 * MiB  , WS_END = 2481 * MiB;
constexpr size_t WS_PROJ = WS_R0, WS_G = WS_R0, WS_U2 = WS_R0 + 344 * MiB, WS_Y = WS_R0 + 384 * MiB, WS_HOUT = WS_R0 + 384 * MiB;
constexpr size_t WS_SIDE = WS_R0 + 640 * MiB;
constexpr size_t WS_U = WS_R1, WS_YMIX = WS_R1 + 128 * MiB, WS_ACT = WS_R0;
constexpr size_t WS_QF = WS_R2 + 120 * MiB;
constexpr size_t WS_WQ = WS_R2 + 100 * MiB;
constexpr size_t WS_LSC = WS_R2 + 20 * MiB;
constexpr size_t WS_SCAL = WS_R2 + 16 * MiB, WS_KT = WS_R2 + 32 * MiB, WS_VT = WS_R1;
constexpr int GLOG_P2 = TOK * 72;
constexpr size_t WS_GLOG = WS_R2, WS_GIF = WS_R2 + 8 * MiB, WS_KCMP = WS_R2 + 10 * MiB, WS_VCMP = WS_R2 + 11 * MiB, WS_VCT = WS_R2 + 12 * MiB, WS_VTS = WS_R2 + 16 * MiB, WS_VTW = WS_R2 + 32 * MiB, WS_YMIX2 = WS_R0 + 256 * MiB,
    WS_POOLED = WS_R2 + 48 * MiB, WS_KCR = WS_R2 + 80 * MiB, WS_PCMP = WS_R2 + 112 * MiB, WS_WCMP = WS_R2 + 128 * MiB, WS_WPOOL = WS_R2 + 132 * MiB, WS_CPART = WS_R2 + 133 * MiB, WS_KFS = WS_R2 + 134 * MiB, WS_KFW = WS_R2 + 150 * MiB, WS_KCF = WS_R2 + 166 * MiB;
static_assert((size_t)F1N * DM * 2 == WF1_BYTES && (size_t)DM * FFP * 2 == WF2_BYTES, "weight copy sizes");
constexpr int CW_BAR = 4096;
constexpr int LDS_BYTES = 163840, MISC_OFF = LDS_BYTES - 256;

#define LDS_WAIT() asm volatile("s_waitcnt lgkmcnt(0)" ::: "memory")
__device__ __forceinline__ int opaque_tid() { int t = threadIdx.x; asm volatile("" : "+v"(t)); return t; }
__device__ __forceinline__ float bf2f(unsigned v) { return __uint_as_float(v << 16); }
__device__ __forceinline__ unsigned f2bf(float f) { unsigned u = __float_as_uint(f); return (u + 0x7fffu + ((u >> 16) & 1u)) >> 16; }
__device__ __forceinline__ unsigned pk2(float lo, float hi) { return f2bf(lo) | (f2bf(hi) << 16); }
__device__ __forceinline__ float wave_sum(float v) {
#pragma unroll
    for (int o = 32; o >= 1; o >>= 1) v += __shfl_xor(v, o);
    return v;
}
__device__ __forceinline__ float wave_max(float v) {
#pragma unroll
    for (int o = 32; o >= 1; o >>= 1) v = fmaxf(v, __shfl_xor(v, o));
    return v;
}
__device__ __forceinline__ void unpack8(const u32x4 w, float (&f)[8]) {
    f[0] = __uint_as_float(w.x << 16); f[1] = __uint_as_float(w.x & 0xffff0000u); f[2] = __uint_as_float(w.y << 16); f[3] = __uint_as_float(w.y & 0xffff0000u);
    f[4] = __uint_as_float(w.z << 16); f[5] = __uint_as_float(w.z & 0xffff0000u); f[6] = __uint_as_float(w.w << 16); f[7] = __uint_as_float(w.w & 0xffff0000u);
}
__device__ __forceinline__ float sigmoidf_(float x) { return 1.0f / (1.0f + __expf(-x)); }

__device__ __forceinline__ void tr_item(const float* W, int ldw, int k0, int n0, bf16* WT, size_t ldk, int dst_row0, LAS float* scr, int lane, int kd0 = -1) {
    if (kd0 < 0) kd0 = k0;
#pragma unroll
    for (int i = 0; i < 8; ++i) { const int kk = 8 * i + (lane >> 3), c4 = (lane & 7) * 4; const f32x4 v = *(const f32x4*)(W + (size_t)(k0 + kk) * ldw + n0 + c4);
        LAS float* d = scr + kk * 33 + c4; d[0] = v.x; d[1] = v.y; d[2] = v.z; d[3] = v.w; }
    LDS_WAIT();
    const int c = lane & 7;
#pragma unroll
    for (int j = 0; j < 4; ++j) { const int n = (lane >> 3) + 8 * j; const LAS float* s = scr + (8 * c) * 33 + n;
        u32x4 o; o.x = pk2(s[0 * 33], s[1 * 33]); o.y = pk2(s[2 * 33], s[3 * 33]); o.z = pk2(s[4 * 33], s[5 * 33]); o.w = pk2(s[6 * 33], s[7 * 33]);
        *(u32x4*)(WT + (size_t)(dst_row0 + n) * ldk + kd0 + 8 * c) = o; }
    LDS_WAIT();
}
__device__ __forceinline__ void rms_row_bf16(const float* xrow, const float* gain, bf16* orow, int lane) {
    const f32x4* xr = (const f32x4*)xrow + lane; const f32x4* gr = (const f32x4*)gain + lane;
    f32x4 v[16]; float ss = 0.f;
#pragma unroll
    for (int j = 0; j < 16; ++j) { v[j] = xr[64 * j]; ss += (v[j].x * v[j].x + v[j].y * v[j].y) + (v[j].z * v[j].z + v[j].w * v[j].w); }
    const float rstd = rsqrtf(wave_sum(ss) * (1.f / DM) + RMS_EPS);
    u32x2* o8 = (u32x2*)orow + lane;
#pragma unroll
    for (int j = 0; j < 16; ++j) { const f32x4 g = gr[64 * j]; u32x2 w; w.x = pk2(v[j].x * rstd * g.x, v[j].y * rstd * g.y); w.y = pk2(v[j].z * rstd * g.z, v[j].w * rstd * g.w); o8[64 * j] = w; }
}
template <bool HIN_BF, bool HOUT_BF>
__device__ __forceinline__ void post_row(const bf16* yrow, const float* gpost, const void* hin, void* hout, const float* gpre, bf16* urow, int lane) {
    const u32x2* yr = (const u32x2*)yrow + lane; const f32x4* gr = (const f32x4*)gpost + lane;
    f32x4 v[16]; float ss = 0.f;
#pragma unroll
    for (int j = 0; j < 16; ++j) { const u32x2 w = yr[64 * j]; v[j].x = __uint_as_float(w.x << 16); v[j].y = __uint_as_float(w.x & 0xffff0000u); v[j].z = __uint_as_float(w.y << 16); v[j].w = __uint_as_float(w.y & 0xffff0000u);
        ss += (v[j].x * v[j].x + v[j].y * v[j].y) + (v[j].z * v[j].z + v[j].w * v[j].w); }
    const float rstd = rsqrtf(wave_sum(ss) * (1.f / DM) + RMS_EPS);
    float s2 = 0.f;
#pragma unroll
    for (int j = 0; j < 16; ++j) { const f32x4 g = gr[64 * j]; f32x4 h0;
        if constexpr (HIN_BF) { const u32x2 w = __builtin_nontemporal_load((const u32x2*)hin + lane + 64 * j);
            h0.x = __uint_as_float(w.x << 16); h0.y = __uint_as_float(w.x & 0xffff0000u); h0.z = __uint_as_float(w.y << 16); h0.w = __uint_as_float(w.y & 0xffff0000u); }
        else h0 = __builtin_nontemporal_load((const f32x4*)hin + lane + 64 * j);
        f32x4 h; h.x = h0.x + v[j].x * rstd * g.x; h.y = h0.y + v[j].y * rstd * g.y; h.z = h0.z + v[j].z * rstd * g.z; h.w = h0.w + v[j].w * rstd * g.w;
        v[j] = h; s2 += (h.x * h.x + h.y * h.y) + (h.z * h.z + h.w * h.w);
        if constexpr (HOUT_BF) { u32x2 w; w.x = pk2(h.x, h.y); w.y = pk2(h.z, h.w); __builtin_nontemporal_store(w, (u32x2*)hout + lane + 64 * j); }
        else __builtin_nontemporal_store(h, (f32x4*)hout + lane + 64 * j); }
    if (gpre) {
        const float r2 = rsqrtf(wave_sum(s2) * (1.f / DM) + RMS_EPS); const f32x4* pr = (const f32x4*)gpre + lane; u32x2* o8 = (u32x2*)urow + lane;
#pragma unroll
        for (int j = 0; j < 16; ++j) { const f32x4 g = pr[64 * j]; u32x2 w; w.x = pk2(v[j].x * r2 * g.x, v[j].y * r2 * g.y); w.y = pk2(v[j].z * r2 * g.z, v[j].w * r2 * g.w); o8[64 * j] = w; }
    }
}
template <bool HIN_BF, bool HOUT_BF>
__device__ __forceinline__ void post_phase(const bf16* y, const float* gpost, const void* hin, void* hout, const float* gpre, bf16* u) {
    const int tx_ = opaque_tid();
    const int lane = tx_ & 63, gw = blockIdx.x * NWAVES + __builtin_amdgcn_readfirstlane(tx_ >> 6), NGW = gridDim.x * NWAVES;
    const bool own = gridDim.x == 256; const int r0 = 2048 * (int)(blockIdx.x & 7) + 8 * (int)(blockIdx.x >> 3) + (gw & 7);
    for (int m0 = gw, k = 0; m0 < TOK; m0 += NGW, ++k) { const int m = own ? r0 + 256 * k : m0; post_row<HIN_BF, HOUT_BF>(y + (size_t)m * DM, gpost, (const char*)hin + (size_t)m * DM * (HIN_BF ? 2 : 4), (char*)hout + (size_t)m * DM * (HOUT_BF ? 2 : 4), gpre, u + (size_t)m * DM, lane); }
}

struct Ptrs {
    const float* in[22]; float* out; unsigned char* ws;
};

__device__ __forceinline__ void prologue_phase(const Ptrs& P, LAS unsigned char* lds) {
    const int tx_ = opaque_tid();
    const int tid = tx_, lane = tid & 63, wave = __builtin_amdgcn_readfirstlane(tid >> 6);
    LAS float* scr = (LAS float*)(lds + wave * 16384);
    const int gw = blockIdx.x * NWAVES + wave, NGW = gridDim.x * NWAVES;
    constexpr int IT_AB = 64 * 224, IT_OAB = 64 * 128, IT_C = 64 * 384, IT_OC = 64 * 128, IT_F1 = 64 * 684, IT_F2 = 171 * 128;
    constexpr int NITEMS = IT_AB + IT_OAB + IT_C + IT_OC + 2 * IT_F1 + 2 * IT_F2;
    unsigned char* ws = P.ws;
    constexpr int NITEMS_P = NITEMS - 2 * IT_F2 - IT_OC;
    for (int it = gw; it < NITEMS_P; it += NGW) {
        int r = NITEMS_P - 1 - it;
        if (r < IT_AB) { const int kb = r / 224, nb = r % 224; tr_item(P.in[3], AB_W, 64 * kb, 32 * nb, (bf16*)(ws + WS_WAB), DM, 32 * nb, scr, lane); continue; } r -= IT_AB;
        if (r < IT_OAB) { const int kb = r / 128, nb = r % 128; tr_item(P.in[11], DM, 64 * kb, 32 * nb, (bf16*)(ws + WS_WOAB), DM, 32 * nb, scr, lane); continue; } r -= IT_OAB;
        if (r < IT_C) { const int kb = r / 384, nb = r % 384; tr_item(P.in[12], C_W, 64 * kb, 32 * nb, (bf16*)(ws + WS_WC), DM, 32 * nb, scr, lane); continue; } r -= IT_C;
        if (r < 2 * IT_F1) { const int l = r / IT_F1; r -= l * IT_F1; const int kb = r / 684, nb = r % 684, n0 = 32 * nb, part = n0 >= DFF ? 1 : 0, ff = n0 - part * DFF;
            tr_item(P.in[18] + (size_t)l * DM * F1W, F1W, 64 * kb, n0, (bf16*)(ws + WS_WF1 + l * WF1_BYTES), DM, 256 * (ff >> 7) + 128 * part + (ff & 127), scr, lane); continue; } r -= 2 * IT_F1;
        { const int l = r / IT_F2; r -= l * IT_F2; const int kb = r / 128, nb = r % 128;
            tr_item(P.in[21] + (size_t)l * DFF * DM, DM, 64 * kb, 32 * nb, (bf16*)(ws + WS_WF2 + l * WF2_BYTES), FFP, 32 * nb, scr, lane); }
    }
    for (int it = gw; it < 2 * 64 * 8 + 4 * 4 * 8; it += NGW) {
        if (it < 1024) { const int which = it >> 9, r = it & 511, kb = r >> 3, nb = r & 7, p = kb >> 5;
            tr_item(P.in[which ? 9 : 7], 256, 64 * kb, 32 * nb, (bf16*)(ws + WS_WCMP), 2048, which * 512 + p * 256 + 32 * nb, scr, lane, 64 * kb - 2048 * p); }
        else { const int r = it - 1024, g = r >> 5, kb = (r >> 3) & 3, nb = r & 7;
            tr_item(P.in[4] + (size_t)g * 65536, 256, 64 * kb, 32 * nb, (bf16*)(ws + WS_WPOOL), 256, g * 256 + 32 * nb, scr, lane); }
    }
    for (int task = gw; task < 128; task += NGW) { const int which = task >> 6, jg = (task >> 4) & 3, ic = task & 15; const float* w1 = P.in[which ? 9 : 7] + (size_t)(ic * 256) * 256 + jg * 64 + lane; const float* pp = P.in[6] + ic * 256;
        float a = 0.f;
#pragma unroll 8
        for (int i = 0; i < 256; ++i) a += pp[i] * w1[(size_t)i * 256];
        ((float*)(ws + WS_CPART))[(ic * 2 + which) * 256 + jg * 64 + lane] = a; }
    const size_t gt = (size_t)blockIdx.x * 512 + tid, NT = (size_t)gridDim.x * 512;
    for (size_t i = gt; i < (size_t)2 * 128 * (DM / 8); i += NT) {
        const int l = (int)(i / (128 * 512)); const int rr = (int)(i % (128 * 512)); const int row = rr >> 9, ch = rr & 511;
        const int drow = 85 * 256 + (row >> 6) * 128 + 64 + (row & 63);
        *(u32x4*)((bf16*)(ws + WS_WF1 + l * WF1_BYTES) + (size_t)drow * DM + ch * 8) = (u32x4){0u, 0u, 0u, 0u}; }
    for (size_t i = gt; i < (size_t)2 * DM * 8; i += NT) {
        const int l = (int)(i / (DM * 8)); const int rr = (int)(i % (DM * 8)); const int row = rr >> 3, ch = rr & 7;
        *(u32x4*)((bf16*)(ws + WS_WF2 + l * WF2_BYTES) + (size_t)row * FFP + DFF + ch * 8) = (u32x4){0u, 0u, 0u, 0u}; }
    for (size_t i = gt; i < (size_t)256 * DM; i += NT) { const int rrow = (int)(i / DM), k = (int)(i % DM);
        ((bf16*)(ws + WS_WABG))[i] = rrow < 72 ? (bf16)f2bf(P.in[3][(size_t)k * AB_W + AB_N + rrow]) : (bf16)0; }
    for (size_t i = gt; i < (size_t)16 * DM; i += NT) { const int rrow = (int)(i / DM), k = (int)(i % DM);
        ((bf16*)(ws + WS_WCG))[i] = (bf16)f2bf(P.in[12][(size_t)k * C_W + C_N + rrow]); }
    for (int m = gw; m < TOK; m += NGW) rms_row_bf16(P.in[0] + (size_t)m * DM, P.in[1], (bf16*)(ws + WS_U) + (size_t)m * DM, lane);
}

template <int NT> __device__ __forceinline__ void skinny_phase(const bf16* A, const bf16* Wt, float* out, int ldo, int ncols) {
    const int tx_ = opaque_tid();
    const int lane = tx_ & 63, gw = blockIdx.x * NWAVES + __builtin_amdgcn_readfirstlane(tx_ >> 6), NGW = gridDim.x * NWAVES;
    const int fr = lane & 15, fq = lane >> 4;
    for (int task = gw; task < TOK / 16; task += NGW) {
        const int t0 = task * 16;
        f32x4 acc[NT];
#pragma unroll
        for (int n = 0; n < NT; ++n) acc[n] = (f32x4){0.f, 0.f, 0.f, 0.f};
        const bf16* ap = A + (size_t)(t0 + fr) * DM + 8 * fq; const bf16* bp = Wt + (size_t)fr * DM + 8 * fq;
#pragma unroll 4
        for (int k0 = 0; k0 < DM; k0 += 32) {
            const bf16x8 a = *(const bf16x8*)(ap + k0);
#pragma unroll
            for (int n = 0; n < NT; ++n) { const bf16x8 b = *(const bf16x8*)(bp + (size_t)n * 16 * DM + k0); acc[n] = __builtin_amdgcn_mfma_f32_16x16x32_bf16(a, b, acc[n], 0, 0, 0); }
        }
#pragma unroll
        for (int n = 0; n < NT; ++n) { const int col = n * 16 + fr; if (col < ncols) {
#pragma unroll
            for (int r = 0; r < 4; ++r) out[(size_t)(t0 + 4 * fq + r) * ldo + col] = acc[n][r]; } }
    }
}

__device__ __forceinline__ void f2_convert_tail(const Ptrs& P, int l, int bidx, int nblk, LAS unsigned char* lds) {
    const int tx_ = opaque_tid();
    const int lane = tx_ & 63, wave = __builtin_amdgcn_readfirstlane(tx_ >> 6);
    LAS float* scr = (LAS float*)(lds + wave * 16384);
    constexpr int IT_F2 = 171 * 128;
    for (int r = bidx * NWAVES + wave; r < IT_F2; r += nblk * NWAVES) { const int kb = r / 128, nb = r % 128;
        tr_item(P.in[21] + (size_t)l * DFF * DM, DM, 64 * kb, 32 * nb, (bf16*)(P.ws + WS_WF2 + l * WF2_BYTES), FFP, 32 * nb, scr, lane); }
    if (l == 0) for (int r = bidx * NWAVES + wave; r < 64 * 128; r += nblk * NWAVES) { const int kb = r / 128, nb = r % 128;
        tr_item(P.in[15], DM, 64 * kb, 32 * nb, (bf16*)(P.ws + WS_WOC), DM, 32 * nb, scr, lane); }
}

__device__ __forceinline__ void pool_naive_phase(const bf16* proj, const float* pool_w, const float* pool_scale, bf16* ymix, LAS unsigned char* lds) {
    const int tx_ = opaque_tid();
    const int tid = tx_; LAS float* pl = (LAS float*)lds;
    for (int unit = blockIdx.x; unit < 4096; unit += gridDim.x) {
        const int tt = unit >> 2, g = unit & 3, tok0 = tt * 16, w = 2 << g;
        { const int ti = tid >> 5, c8 = (tid & 31) * 8, tok = tok0 + ti, tpos = tok & (SEQ - 1), cnt = (tpos + 1 < w) ? tpos + 1 : w;
          float sum[8], cur[8];
#pragma unroll
          for (int j = 0; j < 8; ++j) sum[j] = 0.f;
          for (int j = 0; j < cnt; ++j) { float f[8]; unpack8(*(const u32x4*)(proj + (size_t)(tok - j) * AB_N + g * 256 + c8), f);
#pragma unroll
              for (int q = 0; q < 8; ++q) { sum[q] += f[q]; if (j == 0) cur[q] = f[q]; } }
          const float inv = 1.0f / (float)cnt;
#pragma unroll
          for (int q = 0; q < 8; ++q) pl[ti * 256 + c8 + q] = sum[q] * inv - cur[q]; }
        __syncthreads();
        { const int d = tid & 255, half = tid >> 8; float acc[8];
#pragma unroll
          for (int i = 0; i < 8; ++i) acc[i] = 0.f;
          const float* wp = pool_w + (size_t)g * 65536 + d;
          for (int c = 0; c < 256; ++c) { const float wv = wp[(size_t)c * 256];
#pragma unroll
              for (int i = 0; i < 8; ++i) acc[i] += pl[(half * 8 + i) * 256 + c] * wv; }
          const float sc = pool_scale[g * 256 + d];
#pragma unroll
          for (int i = 0; i < 8; ++i) ymix[(size_t)(tok0 + half * 8 + i) * DM + g * 256 + d] = (bf16)f2bf(acc[i] * sc); }
        __syncthreads();
    }
}
__device__ __forceinline__ float gelu_tanh(float x) { const float u = 0.7978845608028654f * (x + 0.044715f * x * x * x); return 0.5f * x * (1.0f + tanhf(u)); }
__device__ __forceinline__ void compress_naive_phase(const bf16* proj, const float* pos, const float* kw1, const float* kw2, const float* vw1, const float* vw2, bf16* kcmp, bf16* vcmp, bf16* vct, LAS unsigned char* lds) {
    const int tx_ = opaque_tid();
    const int tid = tx_;
    LAS float* flat = (LAS float*)lds;
    LAS float* part = flat + 4 * 4096;
    LAS float* hid = part + 2 * 4 * 256;
    for (int unit = blockIdx.x; unit < 2048; unit += gridDim.x) {
        const int which = unit >> 10, b = (unit >> 9) & 1, g = (unit >> 7) & 3, ng = unit & 127;
        const float* w1 = which ? vw1 : kw1; const float* w2 = which ? vw2 : kw2; bf16* outp = which ? vcmp : kcmp;
        const int col0 = (which ? 4608 : 4096) + g * 128;
        for (int i = tid; i < 4 * 4096; i += 512) { const int nn = i >> 12, r = i & 4095, l = r >> 7, d = r & 127, n = 4 * ng + nn;
            float v = 0.f; if (n <= 510) v = bf2f(proj[(size_t)(b * SEQ + 16 * n + l) * AB_N + col0 + d]) + pos[l * 128 + d];
            flat[i] = v; }
        __syncthreads();
        { const int j = tid & 255, ih = tid >> 8; float a0 = 0.f, a1 = 0.f, a2 = 0.f, a3 = 0.f;
          const float* wp = w1 + (size_t)(ih * 2048) * 256 + j; const LAS float* fp = flat + ih * 2048;
          for (int i = 0; i < 2048; ++i) { const float wv = wp[(size_t)i * 256]; a0 += fp[i] * wv; a1 += fp[4096 + i] * wv; a2 += fp[8192 + i] * wv; a3 += fp[12288 + i] * wv; }
          part[(ih * 4 + 0) * 256 + j] = a0; part[(ih * 4 + 1) * 256 + j] = a1; part[(ih * 4 + 2) * 256 + j] = a2; part[(ih * 4 + 3) * 256 + j] = a3; }
        __syncthreads();
        for (int i = tid; i < 1024; i += 512) hid[i] = gelu_tanh(part[i] + part[1024 + i]);
        __syncthreads();
        { const int dd = tid & 127, nn = tid >> 7, n = 4 * ng + nn; float o = 0.f;
          for (int j = 0; j < 256; ++j) o += hid[nn * 256 + j] * w2[j * 128 + dd];
          const bf16 ob = (n <= 510) ? (bf16)f2bf(o) : (bf16)0;
          outp[((size_t)(b * 4 + g) * 512 + n) * 128 + dd] = ob;
          if (which) { const int kap = n & 31, ppos = 8 * ((kap & 15) >> 2) + (kap & 3) + 4 * (kap >> 4); vct[((((size_t)(b * 4 + g) * 16 + (n >> 5)) * 128 + dd) << 5) + ppos] = ob; } }
        __syncthreads();
    }
}

__device__ __forceinline__ void dot6(const bf16* krow, const LAS float* qs, float (&s)[6]) {
#pragma unroll
    for (int h = 0; h < 6; ++h) s[h] = 0.f;
#pragma unroll 4
    for (int c = 0; c < 16; ++c) { float kf[8]; unpack8(*(const u32x4*)(krow + 8 * c), kf);
#pragma unroll
        for (int h = 0; h < 6; ++h) { const f32x4 qa = *(const LAS f32x4*)(qs + h * 128 + 8 * c), qb = *(const LAS f32x4*)(qs + h * 128 + 8 * c + 4);
            s[h] += (kf[0] * qa.x + kf[1] * qa.y) + (kf[2] * qa.z + kf[3] * qa.w) + (kf[4] * qb.x + kf[5] * qb.y) + (kf[6] * qb.z + kf[7] * qb.w); } }
}
__device__ __forceinline__ void attn_block(const bf16* kbase, const bf16* vbase, int pos0, int lo, int hi, const LAS float* qs, LAS float* pb, int lane, float (&m)[6], float (&l)[6], float (&o)[6][2]) {
    const int pos = pos0 + lane; const bool valid = (pos >= lo && pos <= hi);
    float s[6];
    if (valid) dot6(kbase + (size_t)pos * AB_N, qs, s);
#pragma unroll
    for (int h = 0; h < 6; ++h) { const float sv = valid ? s[h] : NEGF; const float bm = wave_max(sv), mn = fmaxf(m[h], bm), alpha = __expf(m[h] - mn), p = valid ? __expf(sv - mn) : 0.f;
        l[h] = l[h] * alpha + wave_sum(p); m[h] = mn; o[h][0] *= alpha; o[h][1] *= alpha; pb[h * 64 + lane] = p; }
    LDS_WAIT();
    const int kmin = (lo - pos0) > 0 ? (lo - pos0) : 0, kmax = (hi - pos0) < 63 ? (hi - pos0) : 63;
    for (int k = kmin; k <= kmax; ++k) { const unsigned v2 = *(const unsigned*)(vbase + (size_t)(pos0 + k) * AB_N + 2 * lane); const float v0 = bf2f(v2 & 0xffffu), v1 = __uint_as_float(v2 & 0xffff0000u);
#pragma unroll
        for (int h = 0; h < 6; ++h) { const float p = pb[h * 64 + k]; o[h][0] += p * v0; o[h][1] += p * v1; } }
    LDS_WAIT();
}
__device__ __forceinline__ void nsa_naive_phase(const bf16* proj, const bf16* kcmp, const bf16* vcmp, const float* glog, bf16* ymix, LAS unsigned char* lds) {
    const int tx_ = opaque_tid();
    const int lane = tx_ & 63, wave = __builtin_amdgcn_readfirstlane(tx_ >> 6);
    LAS float* qs = (LAS float*)(lds + wave * 17536);
    LAS float* sc = qs + 768;
    LAS float* imp = sc + 3072;
    LAS float* pb = imp + 128;
    LAS int* sel = (LAS int*)(pb + 384);
    const int gw = blockIdx.x * NWAVES + wave, NGW = gridDim.x * NWAVES;
    for (int item = gw; item < 65536; item += NGW) {
        const int t = item >> 3, b = (item >> 2) & 1, g = item & 3;
        const size_t tok = (size_t)b * SEQ + t;
        const bf16* prow = proj + tok * AB_N;
#pragma unroll
        for (int j = 0; j < 12; ++j) { const int idx = lane + 64 * j, h = idx >> 7, d = idx & 127; qs[idx] = bf2f(prow[1024 + (g * 6 + h) * 128 + d]) * 0.08838834764831845f; }
        imp[lane] = 0.f; imp[lane + 64] = 0.f;
        LDS_WAIT();
        float oc[6][2];
#pragma unroll
        for (int h = 0; h < 6; ++h) { oc[h][0] = 0.f; oc[h][1] = 0.f; }
        const int ncv = (t >= 31) ? ((t - 31) >> 4) + 1 : 0;
        if (ncv > 0) {
            const bf16* kc = kcmp + (size_t)(b * 4 + g) * 512 * 128; const bf16* vc = vcmp + (size_t)(b * 4 + g) * 512 * 128;
            float mx[6], sm[6];
#pragma unroll
            for (int h = 0; h < 6; ++h) { mx[h] = NEGF; sm[h] = 0.f; }
            for (int n0 = 0; n0 < ncv; n0 += 64) { const int n = n0 + lane; if (n < ncv) { float s[6]; dot6(kc + (size_t)n * 128, qs, s);
#pragma unroll
                for (int h = 0; h < 6; ++h) { sc[h * 512 + n] = s[h]; mx[h] = fmaxf(mx[h], s[h]); } } }
#pragma unroll
            for (int h = 0; h < 6; ++h) mx[h] = wave_max(mx[h]);
            LDS_WAIT();
            for (int n0 = 0; n0 < ncv; n0 += 64) { const int n = n0 + lane; if (n < ncv) {
#pragma unroll
                for (int h = 0; h < 6; ++h) { const float e = __expf(sc[h * 512 + n] - mx[h]); sc[h * 512 + n] = e; sm[h] += e; } } }
#pragma unroll
            for (int h = 0; h < 6; ++h) sm[h] = 1.0f / wave_sum(sm[h]);
            LDS_WAIT();
            for (int n0 = 0; n0 < ncv; n0 += 64) { const int n = n0 + lane; if (n < ncv) {
#pragma unroll
                for (int h = 0; h < 6; ++h) sc[h * 512 + n] *= sm[h]; } }
            LDS_WAIT();
#pragma unroll
            for (int jj = 0; jj < 2; ++jj) { const int j = lane + 64 * jj; float a = 0.f;
#pragma unroll
                for (int i = 0; i < 5; ++i) { const int n = 4 * j - 1 + i; if (n >= 0 && n < ncv) { const float wgt = (i == 0 || i == 4) ? 1.0f : 2.0f;
#pragma unroll
                    for (int h = 0; h < 6; ++h) a += wgt * sc[h * 512 + n]; } }
                imp[j] = a; }
            for (int n = 0; n < ncv; ++n) { const unsigned v2 = *(const unsigned*)(vc + (size_t)n * 128 + 2 * lane); const float v0 = bf2f(v2 & 0xffffu), v1 = __uint_as_float(v2 & 0xffff0000u);
#pragma unroll
                for (int h = 0; h < 6; ++h) { const float p = sc[h * 512 + n]; oc[h][0] += p * v0; oc[h][1] += p * v1; } }
            LDS_WAIT();
        }
        const int cur = t >> 6; int nsel;
        if (cur < 16) { nsel = cur + 1; if (lane < nsel) sel[lane] = lane; }
        else {
            if (lane == 0) { sel[0] = 0; sel[1] = cur - 1; sel[2] = cur; }
            int cnt = 3;
#pragma unroll
            for (int jj = 0; jj < 2; ++jj) { const int j = lane + 64 * jj; const bool cand = (j >= 1 && j <= cur - 2); const float mv = cand ? imp[j] : 0.f; int rank = 0;
                for (int k = 1; k <= cur - 2; ++k) { const float ov = imp[k]; rank += ((ov > mv) || (ov == mv && k < j)) ? 1 : 0; }
                const bool pick = cand && rank < 13;
                const unsigned long long bm = __ballot(pick); const int posi = cnt + __popcll(bm & ((1ull << lane) - 1ull)); if (pick) sel[posi] = j; cnt += __popcll(bm); }
            nsel = cnt;
        }
        LDS_WAIT();
        const bf16* seqbase = proj + (size_t)b * SEQ * AB_N;
        float ms[6], ls[6], os[6][2];
#pragma unroll
        for (int h = 0; h < 6; ++h) { ms[h] = NEGF; ls[h] = 0.f; os[h][0] = 0.f; os[h][1] = 0.f; }
        for (int i = 0; i < nsel; ++i) { const int j = sel[i]; attn_block(seqbase + 5120 + g * 128, seqbase + 5632 + g * 128, 64 * j, 0, t, qs, pb, lane, ms, ls, os); }
        float mw[6], lw[6], ow[6][2];
#pragma unroll
        for (int h = 0; h < 6; ++h) { mw[h] = NEGF; lw[h] = 0.f; ow[h][0] = 0.f; ow[h][1] = 0.f; }
        const int lo = (t - 511) > 0 ? (t - 511) : 0;
        for (int p0 = lo & ~63; p0 <= t; p0 += 64) attn_block(seqbase + 6144 + g * 128, seqbase + 6656 + g * 128, p0, lo, t, qs, pb, lane, mw, lw, ow);
#pragma unroll
        for (int h = 0; h < 6; ++h) { const float* gl = glog + tok * 72 + (g * 6 + h) * 3; const float g0 = sigmoidf_(gl[0] + gl[GLOG_P2]), g1 = sigmoidf_(gl[1] + gl[GLOG_P2 + 1]) / ls[h], g2 = sigmoidf_(gl[2] + gl[GLOG_P2 + 2]) / lw[h];
            const float r0 = g0 * oc[h][0] + g1 * os[h][0] + g2 * ow[h][0], r1 = g0 * oc[h][1] + g1 * os[h][1] + g2 * ow[h][1];
            *(unsigned*)(ymix + tok * DM + 1024 + (g * 6 + h) * 128 + 2 * lane) = pk2(r0, r1); }
    }
}


__device__ __forceinline__ void p2a_phase(const bf16* proj, bf16* pooled, bf16* kcr) {
    const int tx_ = opaque_tid();
    const size_t gt = (size_t)blockIdx.x * 512 + tx_, NT = (size_t)gridDim.x * 512;
    for (size_t it = gt; it < (size_t)TOK * 128; it += NT) {
        const int tok = (int)(it >> 7), chk = (int)(it & 127), g = chk >> 5, c8 = (chk & 31) * 8, w = 2 << g, tpos = tok & (SEQ - 1), cnt = (tpos + 1 < w) ? tpos + 1 : w;
        float sum[8], cur[8];
#pragma unroll
        for (int q = 0; q < 8; ++q) { sum[q] = 0.f; cur[q] = 0.f; }
        for (int j = 0; j < cnt; ++j) { float f[8]; unpack8(*(const u32x4*)(proj + (size_t)(tok - j) * AB_N + g * 256 + c8), f);
#pragma unroll
            for (int q = 0; q < 8; ++q) { sum[q] += f[q]; if (j == 0) cur[q] = f[q]; } }
        const float inv = 1.0f / (float)cnt; u32x4 o;
        o.x = pk2(sum[0] * inv - cur[0], sum[1] * inv - cur[1]); o.y = pk2(sum[2] * inv - cur[2], sum[3] * inv - cur[3]); o.z = pk2(sum[4] * inv - cur[4], sum[5] * inv - cur[5]); o.w = pk2(sum[6] * inv - cur[6], sum[7] * inv - cur[7]);
        *(u32x4*)(pooled + ((size_t)g * TOK + tok) * 256 + c8) = o; }
    for (size_t it = gt; it < (size_t)2 * TOK * 4 * 16; it += NT) {
        const int ch = (int)(it & 15), g = (int)((it >> 4) & 3), tok = (int)((it >> 6) & (TOK - 1)), which = (int)(it >> 20), b = tok >> 13, t = tok & (SEQ - 1);
        *(u32x4*)(kcr + (((size_t)which * 8 + b * 4 + g) * SEQ + t) * 128 + ch * 8) = *(const u32x4*)(proj + (size_t)tok * AB_N + 4096 + which * 512 + g * 128 + ch * 8); }
}
__device__ __forceinline__ void p2c_phase(const float* pcmp, const float* cpart, const float* kw2, const float* vw2, bf16* kcmp, bf16* vct, bf16* kcf, bf16* vcmp_dbg, LAS unsigned char* lds) {
    const int tx_ = opaque_tid();
    const int tid = tx_, G = gridDim.x, half = G >> 1; const bool own = G == 256;
    const int which = own ? (int)(blockIdx.x >> 7) : ((int)blockIdx.x >= half ? 1 : 0), lb = own ? (int)(blockIdx.x >> 3) & 15 : (int)blockIdx.x - which * half;
    const int ustep = own ? 16 : half, uend = own ? 128 : 1022, bgo = (int)(blockIdx.x & 7);
    LAS float* w2s = (LAS float*)lds;
    LAS float* hid = w2s + 256 * 128;
    LAS float* cs = hid + 1024;
    const float* w2 = which ? vw2 : kw2;
    for (int i = tid; i < 256 * 128; i += 512) w2s[i] = w2[i];
    if (tid < 256) { float a = 0.f;
#pragma unroll
        for (int ic = 0; ic < 16; ++ic) a += cpart[(ic * 2 + which) * 256 + tid];
        cs[tid] = a; }
    __syncthreads();
    for (int u = lb; u < uend; u += ustep) {
        for (int i = tid; i < 1024; i += 512) { const int nn = i >> 8, j = i & 255, R = 4 * u + nn, bg = own ? bgo : R / 511, n0 = own ? R : R - bg * 511, n = n0 < 511 ? n0 : 510; const size_t row = (size_t)which * 4096 + bg * 512 + n;
            hid[i] = gelu_tanh(cs[j] + pcmp[row * 512 + j] + pcmp[(row + 1) * 512 + 256 + j]); }
        __syncthreads();
        { const int dd = tid & 127, nn = tid >> 7, R = 4 * u + nn, bg = own ? bgo : R / 511, n = own ? R : R - bg * 511; float o = 0.f;
#pragma unroll 8
          for (int j = 0; j < 256; ++j) o += hid[nn * 256 + j] * w2s[j * 128 + dd];
          const bf16 ob = (bf16)f2bf(o);
          if (n >= 511) { }
          else if (which == 0) { kcmp[((size_t)bg * 512 + n) * 128 + dd] = ob; kcf[((((size_t)(bg * 16 + (n >> 5)) * 2 + ((n >> 4) & 1)) * 4 + (dd >> 5)) * 64 + ((dd >> 3) & 3) * 16 + (n & 15)) * 8 + (dd & 7)] = ob; }
          else { const int kap = n & 31, ppos = 8 * ((kap & 15) >> 2) + (kap & 3) + 4 * (kap >> 4); vct[((((size_t)bg * 16 + (n >> 5)) * 128 + dd) << 5) + ppos] = ob;
              if (vcmp_dbg) vcmp_dbg[((size_t)bg * 512 + n) * 128 + dd] = ob; } }
        __syncthreads();
    }
    if (lb == 0) for (int i = tid; i < (own ? 128 : 8 * 128); i += 512) { const int bg = own ? bgo : i >> 7, dd = i & 127;
        if (which == 0) { kcmp[((size_t)bg * 512 + 511) * 128 + dd] = (bf16)0; kcf[((((size_t)(bg * 16 + 15) * 2 + 1) * 4 + (dd >> 5)) * 64 + ((dd >> 3) & 3) * 16 + 15) * 8 + (dd & 7)] = (bf16)0; } else vct[((((size_t)bg * 16 + 15) * 128 + dd) << 5) + 31] = (bf16)0; }
}

__device__ __forceinline__ void vt_relayout_phase(const bf16* proj, bf16* vts, bf16* vtw, bf16* kfs, bf16* kfw, LAS unsigned char* lds) {
    const int tx_ = opaque_tid();
    const int lane = tx_ & 63, wave = __builtin_amdgcn_readfirstlane(tx_ >> 6);
    LAS bf16* tile = (LAS bf16*)(lds + wave * 8704);
    const int gw = blockIdx.x * NWAVES + wave, NGW = gridDim.x * NWAVES;
    for (int task = gw; task < 4096; task += NGW) {
        const int which = task >> 11, b = (task >> 10) & 1, g = (task >> 8) & 3, step = task & 255;
        const bf16* src = proj + (size_t)(b * SEQ + step * 32) * AB_N + (which ? 6656 : 5632) + g * 128;
#pragma unroll
        for (int i = 0; i < 8; ++i) { const int idx = lane + 64 * i, r = idx >> 4, ch = idx & 15; *(LAS u32x4*)(tile + r * 136 + ch * 8) = *(const u32x4*)(src + (size_t)r * AB_N + ch * 8); }
        LDS_WAIT();
        bf16* dst = (which ? vtw : vts) + (((size_t)(b * 4 + g) * 256 + step) * 128) * 32;
#pragma unroll
        for (int dd = 0; dd < 2; ++dd) { const int d = lane + 64 * dd; unsigned w[16];
#pragma unroll
            for (int pp = 0; pp < 16; ++pp) { const int p0 = 2 * pp, q = p0 >> 3, j = p0 & 7, k0 = (j < 4) ? 4 * q + j : 16 + 4 * q + j - 4;
                w[pp] = (unsigned)tile[k0 * 136 + d] | ((unsigned)tile[(k0 + 1) * 136 + d] << 16); }
#pragma unroll
            for (int c4 = 0; c4 < 4; ++c4) *(u32x4*)(dst + (size_t)d * 32 + c4 * 8) = (u32x4){w[4 * c4], w[4 * c4 + 1], w[4 * c4 + 2], w[4 * c4 + 3]}; }
        LDS_WAIT();
        const bf16* ksrc = proj + (size_t)(b * SEQ + step * 32) * AB_N + (which ? 6144 : 5120) + g * 128;
        bf16* kdst = (which ? kfw : kfs) + ((size_t)(b * 4 + g) * 256 + step) * 4096;
#pragma unroll
        for (int tl = 0; tl < 2; ++tl)
#pragma unroll
            for (int sk = 0; sk < 4; ++sk) *(u32x4*)(kdst + ((tl * 4 + sk) * 64 + lane) * 8) = *(const u32x4*)(ksrc + (size_t)(16 * tl + (lane & 15)) * AB_N + 32 * sk + 8 * (lane >> 4));
    }
}

#define MFMA16(a, b, c) __builtin_amdgcn_mfma_f32_16x16x32_bf16((a), (b), (c), 0, 0, 0)
__device__ __forceinline__ void nsa_qk32(const bf16* k0, size_t tile_stride, const bf16x8 (&qf)[4], int qd, f32x4& s0, f32x4& s1) {
    bf16x8 a0[4], a1[4];
#pragma unroll
    for (int s = 0; s < 4; ++s) { a0[s] = *(const bf16x8*)(k0 + 32 * s + 8 * qd); a1[s] = *(const bf16x8*)(k0 + tile_stride + 32 * s + 8 * qd); }
    s0 = (f32x4){0.f, 0.f, 0.f, 0.f}; s1 = (f32x4){0.f, 0.f, 0.f, 0.f};
#pragma unroll
    for (int s = 0; s < 4; ++s) { s0 = MFMA16(a0[s], qf[s], s0); s1 = MFMA16(a1[s], qf[s], s1); }
}
__device__ __forceinline__ void nsa_pv32(const bf16* vt, int fr, int qd, const bf16x8 pf, f32x4 (&O)[8]) {
#pragma unroll
    for (int dt = 0; dt < 8; ++dt) { const bf16x8 a = *(const bf16x8*)(vt + (size_t)(16 * dt + fr) * 32 + 8 * qd); O[dt] = MFMA16(a, pf, O[dt]); }
}
__device__ __forceinline__ bf16x8 nsa_pack(const float (&p)[8]) {
    u32x4 w; w.x = pg8::cvt_pk_bf16(p[0], p[1]); w.y = pg8::cvt_pk_bf16(p[2], p[3]); w.z = pg8::cvt_pk_bf16(p[4], p[5]); w.w = pg8::cvt_pk_bf16(p[6], p[7]);
    return __builtin_bit_cast(bf16x8, w);
}
__device__ __forceinline__ void nsa_step(const bf16* k0, size_t tile_stride, const bf16* vt, const bf16x8 (&qf)[4], int fr, int qd, int pos0, int lo, int hi, bool en, float& m, float& l, f32x4 (&O)[8]) {
    constexpr float SC = 0.08838834764831845f * 1.4426950408889634f;
    f32x4 s0, s1; nsa_qk32(k0, tile_stride, qf, qd, s0, s1);
    float x[8]; bool v[8]; float lm = NEGF;
#pragma unroll
    for (int i = 0; i < 8; ++i) { const int pos = pos0 + 16 * (i >> 2) + 4 * qd + (i & 3); v[i] = en && pos >= lo && pos <= hi; x[i] = ((i < 4) ? s0[i & 3] : s1[i & 3]) * SC; lm = v[i] ? fmaxf(lm, x[i]) : lm; }
    lm = fmaxf(lm, __shfl_xor(lm, 16)); lm = fmaxf(lm, __shfl_xor(lm, 32));
    if (__any(lm > m + 8.0f)) { const float mn = fmaxf(m, lm), alpha = __builtin_amdgcn_exp2f(m - mn); l *= alpha; m = mn;
#pragma unroll
        for (int dt = 0; dt < 8; ++dt) O[dt] *= alpha; }
    float p[8]; float ps = 0.f;
#pragma unroll
    for (int i = 0; i < 8; ++i) { p[i] = v[i] ? __builtin_amdgcn_exp2f(x[i] - m) : 0.f; ps += p[i]; }
    l += ps;
    nsa_pv32(vt, fr, qd, nsa_pack(p), O);
}
__device__ __forceinline__ void nsa_fast_phase(const bf16* proj, const bf16* kcmp, const bf16* vct, const bf16* vts, const bf16* vtw, const float* glog, bf16* ymix, LAS unsigned char* lds) {
    const int tx_ = opaque_tid();
    constexpr float SC = 0.08838834764831845f * 1.4426950408889634f;
    const int lane = tx_ & 63, wave = __builtin_amdgcn_readfirstlane(tx_ >> 6), fr = lane & 15, qd = lane >> 4;
    LAS float* imp = (LAS float*)(lds + wave * 2048);
    const int gw = blockIdx.x * NWAVES + wave, NGW = gridDim.x * NWAVES;
    const int qi = fr >= 6 ? 1 : 0, hd = fr - 6 * qi; const bool cv = fr < 12;
    for (int item = gw; item < 32768; item += NGW) {
        const int tp = item >> 3, b = (item >> 2) & 1, g = item & 3, tA = 2 * tp, tB = tA + 1, tq = tA + qi;
        const size_t tokq = (size_t)b * SEQ + tq; const int bg = b * 4 + g;
        bf16x8 qf[4];
#pragma unroll
        for (int s = 0; s < 4; ++s) qf[s] = cv ? *(const bf16x8*)(proj + tokq * AB_N + 1024 + (g * 6 + hd) * 128 + 32 * s + 8 * qd) : (bf16x8){0, 0, 0, 0, 0, 0, 0, 0};
        float gt0 = 0.f, gt1 = 0.f, gt2 = 0.f;
        if (cv) { const float* gl = glog + tokq * 72 + (g * 6 + hd) * 3; gt0 = sigmoidf_(gl[0] + gl[GLOG_P2]); gt1 = sigmoidf_(gl[1] + gl[GLOG_P2 + 1]); gt2 = sigmoidf_(gl[2] + gl[GLOG_P2 + 2]); }
        f32x4 outacc[8];
#pragma unroll
        for (int dt = 0; dt < 8; ++dt) outacc[dt] = (f32x4){0.f, 0.f, 0.f, 0.f};
        for (int i = lane; i < 272; i += 64) imp[i] = 0.f;
        LDS_WAIT();
        const int ncvB = (tB >= 31) ? ((tB - 31) >> 4) + 1 : 0;
        const int ncvq = cv ? ((tq >= 31) ? ((tq - 31) >> 4) + 1 : 0) : 0;
        if (ncvB > 0) {
            const bf16* kc = kcmp + (size_t)bg * 512 * 128 + (size_t)fr * 128;
            float m = NEGF, l = 0.f;
            for (int n0 = 0; n0 < ncvB; n0 += 32) {
                f32x4 s0, s1; nsa_qk32(kc + (size_t)n0 * 128, 16 * 128, qf, qd, s0, s1);
                float x[8]; bool v[8]; float lm = NEGF;
#pragma unroll
                for (int i = 0; i < 8; ++i) { const int n = n0 + 16 * (i >> 2) + 4 * qd + (i & 3); v[i] = n < ncvq; x[i] = ((i < 4) ? s0[i & 3] : s1[i & 3]) * SC; lm = v[i] ? fmaxf(lm, x[i]) : lm; }
                lm = fmaxf(lm, __shfl_xor(lm, 16)); lm = fmaxf(lm, __shfl_xor(lm, 32));
                if (__any(lm > m + 8.0f)) { const float mn = fmaxf(m, lm); l *= __builtin_amdgcn_exp2f(m - mn); m = mn; }
#pragma unroll
                for (int i = 0; i < 8; ++i) l += v[i] ? __builtin_amdgcn_exp2f(x[i] - m) : 0.f;
            }
            l += __shfl_xor(l, 16); l += __shfl_xor(l, 32);
            const float invl = l > 0.f ? 1.0f / l : 0.f;
            f32x4 O[8];
#pragma unroll
            for (int dt = 0; dt < 8; ++dt) O[dt] = (f32x4){0.f, 0.f, 0.f, 0.f};
            for (int n0 = 0; n0 < ncvB; n0 += 32) {
                f32x4 s0, s1; nsa_qk32(kc + (size_t)n0 * 128, 16 * 128, qf, qd, s0, s1);
                float p[8];
#pragma unroll
                for (int i = 0; i < 8; ++i) { const int n = n0 + 16 * (i >> 2) + 4 * qd + (i & 3); const float xv = ((i < 4) ? s0[i & 3] : s1[i & 3]) * SC; p[i] = (n < ncvq) ? __builtin_amdgcn_exp2f(xv - m) * invl : 0.f; }
                if (cv) {
#pragma unroll
                    for (int tl = 0; tl < 2; ++tl) { const int j = ((n0 + 16 * tl) >> 2) + qd; const float a = 2.0f * (p[4 * tl] + p[4 * tl + 1] + p[4 * tl + 2]) + p[4 * tl + 3];
                        __hip_atomic_fetch_add(imp + qi * 136 + j, a, __ATOMIC_RELAXED, __HIP_MEMORY_SCOPE_WORKGROUP); __hip_atomic_fetch_add(imp + qi * 136 + j + 1, p[4 * tl + 3], __ATOMIC_RELAXED, __HIP_MEMORY_SCOPE_WORKGROUP); } }
                nsa_pv32(vct + (((size_t)bg * 16 + (n0 >> 5)) * 128) * 32, fr, qd, nsa_pack(p), O);
            }
#pragma unroll
            for (int dt = 0; dt < 8; ++dt) outacc[dt] += gt0 * O[dt];
        }
        LDS_WAIT();
        unsigned long long mA0, mA1, mB0, mB1;
#pragma unroll
        for (int qq = 0; qq < 2; ++qq) { const int t = tA + qq, cur = t >> 6; unsigned long long s0m, s1m;
            if (cur < 16) { s0m = (2ull << cur) - 1ull; s1m = 0ull; }
            else { const LAS float* im = imp + qq * 136; const int j0 = lane, j1 = lane + 64; const bool c0 = (j0 >= 1 && j0 <= cur - 2), c1 = (j1 <= cur - 2);
                const float v0 = im[j0], v1 = im[j1]; int r0 = 0, r1 = 0;
                for (int k = 1; k <= cur - 2; ++k) { const float ov = im[k]; r0 += ((ov > v0) || (ov == v0 && k < j0)) ? 1 : 0; r1 += ((ov > v1) || (ov == v1 && k < j1)) ? 1 : 0; }
                s0m = __ballot(c0 && r0 < 13); s1m = __ballot(c1 && r1 < 13);
                s0m |= 1ull; { const int f1 = cur - 1; if (f1 < 64) s0m |= 1ull << f1; else s1m |= 1ull << (f1 - 64); if (cur < 64) s0m |= 1ull << cur; else s1m |= 1ull << (cur - 64); } }
            if (qq == 0) { mA0 = s0m; mA1 = s1m; } else { mB0 = s0m; mB1 = s1m; } }
        const unsigned long long my0 = qi ? mB0 : mA0, my1 = qi ? mB1 : mA1;
        const bf16* seqk = proj + (size_t)b * SEQ * AB_N + (size_t)fr * AB_N + g * 128;
        { float m = NEGF, l = 0.f; f32x4 O[8];
#pragma unroll
          for (int dt = 0; dt < 8; ++dt) O[dt] = (f32x4){0.f, 0.f, 0.f, 0.f};
          const int hiq = cv ? tq : -1;
#pragma unroll
          for (int w = 0; w < 2; ++w) { unsigned long long u = w ? (mA1 | mB1) : (mA0 | mB0); const unsigned long long mine = w ? my1 : my0;
              while (u) { const int bit = __ffsll((long long)u) - 1; u &= u - 1ull; const int j = 64 * w + bit; const bool en = (mine >> bit) & 1ull;
#pragma unroll
                  for (int hf = 0; hf < 2; ++hf) { const int pos0 = 64 * j + 32 * hf; if (pos0 > tB) break;
                      nsa_step(seqk + (size_t)pos0 * AB_N + 5120, (size_t)16 * AB_N, vts + (((size_t)bg * 256 + (pos0 >> 5)) * 128) * 32, qf, fr, qd, pos0, 0, hiq, en, m, l, O); } } }
          l += __shfl_xor(l, 16); l += __shfl_xor(l, 32);
          const float cf = l > 0.f ? gt1 / l : 0.f;
#pragma unroll
          for (int dt = 0; dt < 8; ++dt) outacc[dt] += cf * O[dt]; }
        { float m = NEGF, l = 0.f; f32x4 O[8];
#pragma unroll
          for (int dt = 0; dt < 8; ++dt) O[dt] = (f32x4){0.f, 0.f, 0.f, 0.f};
          const int hiq = cv ? tq : -1, loq = tq - 511; const int lo0 = (tA - 511) > 0 ? (tA - 511) : 0;
          for (int pos0 = lo0 & ~31; pos0 <= tB; pos0 += 32)
              nsa_step(seqk + (size_t)pos0 * AB_N + 6144, (size_t)16 * AB_N, vtw + (((size_t)bg * 256 + (pos0 >> 5)) * 128) * 32, qf, fr, qd, pos0, loq, hiq, true, m, l, O);
          l += __shfl_xor(l, 16); l += __shfl_xor(l, 32);
          const float cf = l > 0.f ? gt2 / l : 0.f;
#pragma unroll
          for (int dt = 0; dt < 8; ++dt) outacc[dt] += cf * O[dt]; }
        if (cv) { bf16* op = ymix + tokq * DM + 1024 + (g * 6 + hd) * 128 + 4 * qd;
#pragma unroll
            for (int dt = 0; dt < 8; ++dt) { u32x2 w; w.x = pk2(outacc[dt][0], outacc[dt][1]); w.y = pk2(outacc[dt][2], outacc[dt][3]); *(u32x2*)(op + 16 * dt) = w; } }
    }
}

struct NsaCtx { const bf16* kb; const bf16* vb; int klane, vlane, p0, lo, hi, qi; const LAS int* list; };
template <int BR> __device__ __forceinline__ void nsa_desc(const NsaCtx& X, int i, int& pos0, bool& en) {
    if (BR == 2) { const int e = __builtin_amdgcn_readfirstlane(X.list[i]); pos0 = e & 0xffff; en = ((e >> (30 + X.qi)) & 1) != 0; } else { pos0 = X.p0 + 32 * i; en = true; }
}
template <int BR> __device__ __forceinline__ void nsa_load(const NsaCtx& X, int i, int n, bf16x8 (&k0)[4], bf16x8 (&k1)[4], bf16x8 (&vf)[8]) {
    int pos0; bool en; nsa_desc<BR>(X, i < n ? i : n - 1, pos0, en);
    int kl = X.klane, vl = X.vlane; asm volatile("" : "+v"(kl), "+v"(vl));
    const bf16* kp = X.kb + (size_t)(pos0 >> 5) * 4096;
    const int kl1 = kl + 2048;
#pragma unroll
    for (int s = 0; s < 4; ++s) { k0[s] = *(const bf16x8*)(kp + (kl + 512 * s)); k1[s] = *(const bf16x8*)(kp + (kl1 + 512 * s)); }
    if (BR != 0) { const bf16* vp = X.vb + (size_t)(pos0 >> 5) * 4096;
        const int vl1 = vl + 2048;
#pragma unroll
        for (int dt = 0; dt < 4; ++dt) { vf[dt] = *(const bf16x8*)(vp + (vl + dt * 512)); vf[dt + 4] = *(const bf16x8*)(vp + (vl1 + dt * 512)); } }
}
template <int BR> __device__ __forceinline__ void nsa_compute(const NsaCtx& X, int i, int n, int fr, int qd, bool cv, const LAS bf16x8* qfl, const bf16x8 (&k0)[4], const bf16x8 (&k1)[4], const bf16x8 (&vf)[8],
                                                             float& m, float& l, f32x4 (&O)[8], LAS float* imp) {
    constexpr float SC = 0.08838834764831845f * 1.4426950408889634f;
    int pos0; bool en; nsa_desc<BR>(X, i < n ? i : n - 1, pos0, en); en = en && (i < n);
    f32x4 s0 = (f32x4){0.f, 0.f, 0.f, 0.f}, s1 = (f32x4){0.f, 0.f, 0.f, 0.f};
#pragma unroll
    for (int s = 0; s < 4; ++s) { const bf16x8 qv = qfl[s * 64]; s0 = MFMA16(k0[s], qv, s0); s1 = MFMA16(k1[s], qv, s1); }
    float x[8]; bool v[8]; float lm = NEGF;
#pragma unroll
    for (int e = 0; e < 8; ++e) { const int pos = pos0 + 16 * (e >> 2) + 4 * qd + (e & 3); v[e] = en && pos >= X.lo && pos <= X.hi; x[e] = ((e < 4) ? s0[e & 3] : s1[e & 3]) * SC; lm = v[e] ? fmaxf(lm, x[e]) : lm; }
    float p[8];
    if (BR == 1) {
#pragma unroll
        for (int e = 0; e < 8; ++e) p[e] = v[e] ? __builtin_amdgcn_exp2f(x[e] - m) * l : 0.f;
        if (cv) {
#pragma unroll
            for (int tl = 0; tl < 2; ++tl) { const int j = ((pos0 + 16 * tl) >> 2) + qd; const float a = 2.0f * (p[4 * tl] + p[4 * tl + 1] + p[4 * tl + 2]) + p[4 * tl + 3];
                __hip_atomic_fetch_add(imp + X.qi * 136 + j, a, __ATOMIC_RELAXED, __HIP_MEMORY_SCOPE_WORKGROUP); __hip_atomic_fetch_add(imp + X.qi * 136 + j + 1, p[4 * tl + 3], __ATOMIC_RELAXED, __HIP_MEMORY_SCOPE_WORKGROUP); } }
    } else {
        lm = fmaxf(lm, __shfl_xor(lm, 16)); lm = fmaxf(lm, __shfl_xor(lm, 32));
        if (__any(lm > m + 8.0f)) { const float mn = fmaxf(m, lm), alpha = __builtin_amdgcn_exp2f(m - mn); l *= alpha; m = mn;
            if (BR != 0) {
#pragma unroll
                for (int dt = 0; dt < 8; ++dt) O[dt] *= alpha; } }
        float ps = 0.f;
#pragma unroll
        for (int e = 0; e < 8; ++e) { p[e] = v[e] ? __builtin_amdgcn_exp2f(x[e] - m) : 0.f; ps += p[e]; }
        l += ps;
    }
    if (BR != 0) { const bf16x8 pf = nsa_pack(p);
#pragma unroll
        for (int dt = 0; dt < 8; ++dt) O[dt] = MFMA16(vf[dt], pf, O[dt]); }
}
template <int BR> __device__ __forceinline__ void nsa_run(const NsaCtx& X, int n, int fr, int qd, bool cv, const LAS bf16x8* qfl, float& m, float& l, f32x4 (&O)[8], LAS float* imp) {
    bf16x8 ka[2][4], kb[2][4], vf[2][8];
    if (n <= 0) return;
    nsa_load<BR>(X, 0, n, ka[0], kb[0], vf[0]);
#pragma unroll 1
    for (int i0 = 0; i0 < n; i0 += 2) {
        nsa_load<BR>(X, i0 + 1, n, ka[1], kb[1], vf[1]);
        nsa_compute<BR>(X, i0, n, fr, qd, cv, qfl, ka[0], kb[0], vf[0], m, l, O, imp);
        nsa_load<BR>(X, i0 + 2, n, ka[0], kb[0], vf[0]);
        nsa_compute<BR>(X, i0 + 1, n, fr, qd, cv, qfl, ka[1], kb[1], vf[1], m, l, O, imp);
    }
}
__device__ __forceinline__ void nsa_acc_out(LAS float* ol, int fr, int qd, const f32x4 (&O)[8], float cf, bool first) {
#pragma unroll
    for (int dt = 0; dt < 8; ++dt) { LAS f32x4* pp = (LAS f32x4*)(ol + fr * 132 + 16 * dt + 4 * qd); f32x4 vv = O[dt] * cf; if (!first) vv += *pp; *pp = vv; }
}
__device__ __forceinline__ void nsa_fast2_phase(const bf16* proj, const bf16* kcf, const bf16* vct, const bf16* kfs, const bf16* vts, const bf16* kfw, const bf16* vtw, const float* glog, bf16* ymix, LAS unsigned char* lds) {
    const int tx_ = opaque_tid();
    const int lane = tx_ & 63, wave = __builtin_amdgcn_readfirstlane(tx_ >> 6), fr = lane & 15, qd = lane >> 4;
    LAS float* imp = (LAS float*)(lds + wave * 14592);
    LAS int* list = (LAS int*)(imp + 272);
    LAS float* ol = imp + 512;
    LAS bf16x8* qfl = (LAS bf16x8*)(lds + wave * 14592 + 10496) + lane;
    const int gw = blockIdx.x * NWAVES + wave, NGW = gridDim.x * NWAVES;
    const int qi = fr >= 6 ? 1 : 0, hd = fr - 6 * qi; const bool cv = fr < 12;
    const bool xmap = (gridDim.x & 7) == 0;
    const int nI = xmap ? 4096 : 32768, i_lo = xmap ? (int)(blockIdx.x >> 3) * NWAVES + wave : gw, i_st = xmap ? (int)(gridDim.x >> 3) * NWAVES : NGW;
    for (int item = i_lo; item < nI; item += i_st) {
        const int tp = xmap ? item : (item >> 3), bgi = xmap ? (int)(blockIdx.x & 7) : (item & 7), b = bgi >> 2, g = bgi & 3, tA = 2 * tp, tB = tA + 1, tq = tA + qi;
        if (xmap) { asm volatile("s_waitcnt lgkmcnt(0)" ::: "memory"); __builtin_amdgcn_s_barrier(); }
        const size_t tokq = (size_t)b * SEQ + tq; const int bg = b * 4 + g;
#pragma unroll
        for (int s = 0; s < 4; ++s) qfl[s * 64] = cv ? *(const bf16x8*)(proj + tokq * AB_N + 1024 + (g * 6 + hd) * 128 + 32 * s + 8 * qd) : (bf16x8){0, 0, 0, 0, 0, 0, 0, 0};
        float gt0 = 0.f, gt1 = 0.f, gt2 = 0.f;
        if (cv) { const float* gl = glog + tokq * 72 + (g * 6 + hd) * 3; gt0 = sigmoidf_(gl[0] + gl[GLOG_P2]); gt1 = sigmoidf_(gl[1] + gl[GLOG_P2 + 1]); gt2 = sigmoidf_(gl[2] + gl[GLOG_P2 + 2]); }
        for (int i = lane; i < 272; i += 64) imp[i] = 0.f;
        LDS_WAIT();
        NsaCtx X; X.qi = qi; X.list = list; X.vlane = fr * 32 + 8 * qd; X.klane = lane * 8;
        const int ncvB = (tB >= 31) ? ((tB - 31) >> 4) + 1 : 0;
        const int ncvq = cv ? ((tq >= 31) ? ((tq - 31) >> 4) + 1 : 0) : 0;
        { f32x4 O[8];
#pragma unroll
          for (int dt = 0; dt < 8; ++dt) O[dt] = (f32x4){0.f, 0.f, 0.f, 0.f};
          if (ncvB > 0) {
              X.kb = kcf + (size_t)bg * 16 * 4096; X.vb = vct + (size_t)bg * 16 * 4096; X.p0 = 0; X.lo = 0; X.hi = ncvq - 1;
              const int nst = (ncvB + 31) >> 5;
              float m = NEGF, l = 0.f;
              nsa_run<0>(X, nst, fr, qd, cv, qfl, m, l, O, imp);
              l += __shfl_xor(l, 16); l += __shfl_xor(l, 32);
              float invl = l > 0.f ? 1.0f / l : 0.f;
              nsa_run<1>(X, nst, fr, qd, cv, qfl, m, invl, O, imp);
          }
          nsa_acc_out(ol, fr, qd, O, gt0, true); }
        LDS_WAIT();
        { float m = NEGF, l = 0.f; f32x4 O[8];
#pragma unroll
          for (int dt = 0; dt < 8; ++dt) O[dt] = (f32x4){0.f, 0.f, 0.f, 0.f};
          const int lo0 = (tA - 511) > 0 ? (tA - 511) : 0, st0 = lo0 & ~31;
          X.kb = kfw + (size_t)bg * 256 * 4096; X.vb = vtw + (size_t)bg * 256 * 4096; X.p0 = st0; X.lo = tq - 511; X.hi = cv ? tq : -1;
          nsa_run<3>(X, ((tB - st0) >> 5) + 1, fr, qd, cv, qfl, m, l, O, imp);
          l += __shfl_xor(l, 16); l += __shfl_xor(l, 32);
          nsa_acc_out(ol, fr, qd, O, l > 0.f ? gt2 / l : 0.f, false); }
        LDS_WAIT();
        unsigned long long mA0, mA1, mB0, mB1;
#pragma unroll
        for (int qq = 0; qq < 2; ++qq) { const int t = tA + qq, cur = t >> 6; unsigned long long s0m, s1m;
            if (cur < 16) { s0m = (2ull << cur) - 1ull; s1m = 0ull; }
            else { LAS float* im = imp + qq * 136; const int j0 = lane, j1 = lane + 64; const bool c0 = (j0 >= 1 && j0 <= cur - 2), c1 = (j1 <= cur - 2);
                const float v0 = im[j0], v1 = im[j1]; int r0 = 0, r1 = 0;
                LDS_WAIT();
                if (lane == 0) im[0] = 0.f;
                if (lane == 1) { im[cur - 1] = 0.f; im[cur] = 0.f; }
                LDS_WAIT();
                { const unsigned b0 = c0 ? __float_as_uint(v0) : 0xffffffffu, b1 = c1 ? __float_as_uint(v1) : 0xffffffffu;
#pragma unroll 2
                  for (int k = 0; k <= cur - 2; k += 8) { const u32x4 a = *(const LAS u32x4*)(im + k), b = *(const LAS u32x4*)(im + k + 4);
                      r0 += (a.x > b0 ? 1 : 0) + (a.y > b0 ? 1 : 0) + (a.z > b0 ? 1 : 0) + (a.w > b0 ? 1 : 0) + (b.x > b0 ? 1 : 0) + (b.y > b0 ? 1 : 0) + (b.z > b0 ? 1 : 0) + (b.w > b0 ? 1 : 0);
                      r1 += (a.x > b1 ? 1 : 0) + (a.y > b1 ? 1 : 0) + (a.z > b1 ? 1 : 0) + (a.w > b1 ? 1 : 0) + (b.x > b1 ? 1 : 0) + (b.y > b1 ? 1 : 0) + (b.z > b1 ? 1 : 0) + (b.w > b1 ? 1 : 0); } }
                s0m = __ballot(c0 && r0 < 13); s1m = __ballot(c1 && r1 < 13);
                const int ncand = cur - 2;
                if (__popcll(s0m) + __popcll(s1m) != (ncand < 13 ? ncand : 13)) { r0 = 0; r1 = 0;
                    for (int k = 1; k <= cur - 2; ++k) { const float ov = im[k]; r0 += ((ov > v0) || (ov == v0 && k < j0)) ? 1 : 0; r1 += ((ov > v1) || (ov == v1 && k < j1)) ? 1 : 0; }
                    s0m = __ballot(c0 && r0 < 13); s1m = __ballot(c1 && r1 < 13); }
                s0m |= 1ull; { const int f1 = cur - 1; if (f1 < 64) s0m |= 1ull << f1; else s1m |= 1ull << (f1 - 64); if (cur < 64) s0m |= 1ull << cur; else s1m |= 1ull << (cur - 64); } }
            if (qq == 0) { mA0 = s0m; mA1 = s1m; } else { mB0 = s0m; mB1 = s1m; } }
        const unsigned long long U0 = mA0 | mB0, U1 = mA1 | mB1; const int nU0 = __popcll(U0), nsel = 2 * (nU0 + __popcll(U1));
#pragma unroll
        for (int w = 0; w < 2; ++w) { const unsigned long long U = w ? U1 : U0, mAw = w ? mA1 : mA0, mBw = w ? mB1 : mB0;
            if ((U >> lane) & 1ull) { const int idx = (w ? nU0 : 0) + __popcll(U & ((1ull << lane) - 1ull)), j = 64 * w + lane;
                const int fl = (int)(((mAw >> lane) & 1ull) << 30) | (int)(((mBw >> lane) & 1ull) << 31);
                list[2 * idx] = (64 * j) | fl; list[2 * idx + 1] = (64 * j + 32) | ((64 * j + 32 <= tB) ? fl : 0); } }
        LDS_WAIT();
        { float m = NEGF, l = 0.f; f32x4 O[8];
#pragma unroll
          for (int dt = 0; dt < 8; ++dt) O[dt] = (f32x4){0.f, 0.f, 0.f, 0.f};
          X.kb = kfs + (size_t)bg * 256 * 4096; X.vb = vts + (size_t)bg * 256 * 4096; X.p0 = 0; X.lo = 0; X.hi = cv ? tq : -1;
          nsa_run<2>(X, nsel, fr, qd, cv, qfl, m, l, O, imp);
          l += __shfl_xor(l, 16); l += __shfl_xor(l, 32);
          nsa_acc_out(ol, fr, qd, O, l > 0.f ? gt1 / l : 0.f, false); }
        if (cv) { bf16* op = ymix + tokq * DM + 1024 + (g * 6 + hd) * 128 + 4 * qd;
#pragma unroll
            for (int dt = 0; dt < 8; ++dt) { const f32x4 o = *(const LAS f32x4*)(ol + fr * 132 + 16 * dt + 4 * qd); u32x2 w; w.x = pk2(o[0], o[1]); w.y = pk2(o[2], o[3]); *(u32x2*)(op + 16 * dt) = w; } }
    }
}

__device__ __forceinline__ void act_phase(const bf16* G, const bf16* U2, const float* cw, const float* cb, bf16* act) {
    const int tx_ = opaque_tid();
    constexpr int CPR = FFP / 8, RB = 16, NRB = TOK / RB;
    const int gt = blockIdx.x * 512 + tx_, NT = gridDim.x * 512;
    for (int item = gt; item < NRB * CPR; item += NT) {
        const int rb = item / CPR, ch = item - rb * CPR, f8 = ch * 8, row0 = rb * RB; size_t off = (size_t)row0 * FFP + f8;
        if (f8 >= DFF) {
#pragma unroll
            for (int r = 0; r < RB; ++r) *(u32x4*)(act + off + (size_t)r * FFP) = (u32x4){0u, 0u, 0u, 0u};
            continue; }
        float w0[8], w1[8], w2[8], bb[8];
        { const f32x4 a0 = *(const f32x4*)(cw + f8), a1 = *(const f32x4*)(cw + f8 + 4), b0 = *(const f32x4*)(cw + DFF + f8), b1 = *(const f32x4*)(cw + DFF + f8 + 4), c0 = *(const f32x4*)(cw + 2 * DFF + f8), c1 = *(const f32x4*)(cw + 2 * DFF + f8 + 4), d0 = *(const f32x4*)(cb + f8), d1 = *(const f32x4*)(cb + f8 + 4);
#pragma unroll
          for (int j = 0; j < 4; ++j) { w0[j] = a0[j]; w0[j + 4] = a1[j]; w1[j] = b0[j]; w1[j + 4] = b1[j]; w2[j] = c0[j]; w2[j + 4] = c1[j]; bb[j] = d0[j]; bb[j + 4] = d1[j]; } }
        float g1[8], g2[8];
        const int tpos0 = row0 & (SEQ - 1);
        if (tpos0 >= 2) { unpack8(*(const u32x4*)(G + off - FFP), g1); unpack8(*(const u32x4*)(G + off - 2 * FFP), g2); }
        else {
#pragma unroll
            for (int j = 0; j < 8; ++j) { g1[j] = 0.f; g2[j] = 0.f; } }
#pragma unroll 4
        for (int r = 0; r < RB; ++r) {
            float g0[8], up[8]; unpack8(*(const u32x4*)(G + off), g0); unpack8(*(const u32x4*)(U2 + off), up);
            float o[8];
#pragma unroll
            for (int j = 0; j < 8; ++j) { const float x = bb[j] + w0[j] * g0[j] + w1[j] * g1[j] + w2[j] * g2[j]; o[j] = x * sigmoidf_(x) * up[j]; g2[j] = g1[j]; g1[j] = g0[j]; }
            u32x4 w; w.x = pk2(o[0], o[1]); w.y = pk2(o[2], o[3]); w.z = pk2(o[4], o[5]); w.w = pk2(o[6], o[7]);
            *(u32x4*)(act + off) = w; off += FFP;
        }
    }
}


__device__ __forceinline__ void act_fix_phase(const bf16* side, const float* cw, const float* cb, bf16* act) {
    const int tx_ = opaque_tid();
    constexpr int CPR = FFP / 8;
    const int gt = blockIdx.x * 512 + tx_, NT = gridDim.x * 512;
    const bool own = gridDim.x == 256; const int lt = (int)(blockIdx.x >> 3) * 512 + tx_, kx = 32 * (int)(blockIdx.x & 7);
    for (int item0 = own ? lt : gt; item0 < (own ? 32 : 256) * 2 * CPR; item0 += own ? 32 * 512 : NT) {
        const int ch = item0 % CPR, kr = item0 / CPR, rho = kr & 1, k = (kr >> 1) + (own ? kx : 0), f8 = ch * 8, t = 64 * k + rho, tpos = t & (SEQ - 1);
        const size_t off = (size_t)t * FFP + f8;
        if (f8 >= DFF) { *(u32x4*)(act + off) = (u32x4){0u, 0u, 0u, 0u}; continue; }
        float g0[8], g1[8], g2[8], up[8];
        const bf16* sk = side + ((size_t)(k * 4) * 2) * FFP + f8;
        unpack8(*(const u32x4*)(sk + (size_t)(rho * 2) * FFP), g0); unpack8(*(const u32x4*)(sk + (size_t)(rho * 2 + 1) * FFP), up);
        const bool hasprev = tpos >= 2 || (rho == 1);
#pragma unroll
        for (int j = 0; j < 8; ++j) { g1[j] = 0.f; g2[j] = 0.f; }
        if (rho == 1) { unpack8(*(const u32x4*)sk, g1); if (tpos >= 2) unpack8(*(const u32x4*)(sk - (size_t)8 * FFP + (size_t)(3 * 2) * FFP), g2); }
        else if (tpos >= 2) { unpack8(*(const u32x4*)(sk - (size_t)8 * FFP + (size_t)(3 * 2) * FFP), g1); unpack8(*(const u32x4*)(sk - (size_t)8 * FFP + (size_t)(2 * 2) * FFP), g2); }
        (void)hasprev;
        float r[8];
#pragma unroll
        for (int j = 0; j < 8; ++j) { const int f = f8 + j; const float x = cb[f] + cw[f] * g0[j] + cw[DFF + f] * g1[j] + cw[2 * DFF + f] * g2[j]; r[j] = x * sigmoidf_(x) * up[j]; }
        u32x4 w; w.x = pk2(r[0], r[1]); w.y = pk2(r[2], r[3]); w.z = pk2(r[4], r[5]); w.w = pk2(r[6], r[7]);
        *(u32x4*)(act + off) = w;
    }
}

__device__ __forceinline__ void mlstm_naive_phase(const bf16* projc, const float* gif, const float* bif, float* hout, LAS unsigned char* lds) {
    const int tx_ = opaque_tid();
    constexpr int QS = 264;
    const int tid = tx_, lane = tid & 63;
    LAS bf16* qs = (LAS bf16*)lds;
    LAS bf16* ks = qs + 64 * QS;
    LAS float* vsl = (LAS float*)(lds + 67584);
    LAS float* Cs = vsl + 2048;
    LAS float* ns = Cs + 256 * 36;
    LAS float* wq = ns + 256;
    LAS float* bb = wq + 64 * 65; LAS float* gi = bb + 64; LAS float* mt = gi + 64; LAS float* inter = mt + 64; LAS float* ksc = inter + 64; LAS float* dd = ksc + 64; LAS float* sca = dd + 64;
    for (int unit = blockIdx.x; unit < 256; unit += gridDim.x) {
        const int b = unit >> 7, h = (unit >> 4) & 7, es = unit & 15;
        for (int i = tid; i < 256 * 36; i += 512) Cs[i] = 0.f;
        if (tid < 256) ns[tid] = 0.f;
        if (tid == 0) sca[0] = 0.f;
        __syncthreads();
        for (int c = 0; c < 128; ++c) {
            const size_t tok0 = (size_t)b * SEQ + 64 * c;
#pragma unroll
            for (int i = 0; i < 4; ++i) { const int idx = tid + 512 * i, r = idx >> 5, ch = idx & 31; const bf16* src = projc + (tok0 + r) * C_N + h * 256 + ch * 8;
                *(LAS u32x4*)(qs + r * QS + ch * 8) = *(const u32x4*)src; *(LAS u32x4*)(ks + r * QS + ch * 8) = *(const u32x4*)(src + 2048); }
            if (tid < 256) { const int r = tid >> 2, q4 = tid & 3; float f[8]; unpack8(*(const u32x4*)(projc + (tok0 + r) * C_N + 4096 + h * 512 + es * 32 + q4 * 8), f);
#pragma unroll
                for (int j = 0; j < 8; ++j) vsl[r * 32 + q4 * 8 + j] = f[j]; }
            if (tid >= 448) {
                const int s = lane; const float ig = gif[(tok0 + s) * 16 + h] + bif[h], fg = gif[(tok0 + s) * 16 + 8 + h] + bif[8 + h];
                const float lf = fg >= 0.f ? -log1pf(__expf(-fg)) : fg - log1pf(__expf(fg));
                float bsum = lf;
#pragma unroll
                for (int o = 1; o < 64; o <<= 1) { const float tv = __shfl_up(bsum, o); if (lane >= o) bsum += tv; }
                float pm = ig - bsum;
#pragma unroll
                for (int o = 1; o < 64; o <<= 1) { const float tv = __shfl_up(pm, o); if (lane >= o) pm = fmaxf(pm, tv); }
                const float m_prev = sca[0]; const float mts = bsum + fmaxf(m_prev, pm);
                const float b_last = __shfl(bsum, 63), m_new = __shfl(mts, 63);
                bb[s] = bsum; gi[s] = ig; mt[s] = mts; inter[s] = __expf(bsum + m_prev - mts); ksc[s] = __expf(b_last - bsum + ig - m_new);
                if (s == 0) { sca[1] = __expf(b_last + m_prev - m_new); sca[2] = m_new; }
            }
            __syncthreads();
            {
                const int t = tid >> 3, sg = tid & 7; float acc[8];
#pragma unroll
                for (int i = 0; i < 8; ++i) acc[i] = 0.f;
                for (int ch = 0; ch < 32; ++ch) { float qv[8]; unpack8(*(const LAS u32x4*)(qs + t * QS + ch * 8), qv);
#pragma unroll
                    for (int i = 0; i < 8; ++i) { const int s = sg + 8 * i; if (s <= t) { float kv[8]; unpack8(*(const LAS u32x4*)(ks + s * QS + ch * 8), kv);
                        acc[i] += (qv[0] * kv[0] + qv[1] * kv[1]) + (qv[2] * kv[2] + qv[3] * kv[3]) + (qv[4] * kv[4] + qv[5] * kv[5]) + (qv[6] * kv[6] + qv[7] * kv[7]); } } }
                const float bt = bb[t], mtt = mt[t];
#pragma unroll
                for (int i = 0; i < 8; ++i) { const int s = sg + 8 * i; wq[t * 65 + s] = (s <= t) ? acc[i] * 0.0625f * __expf(bt - bb[s] + gi[s] - mtt) : 0.f; }
            }
            __syncthreads();
            if (tid < 64) { const int t = tid; float rs = 0.f, qn = 0.f;
                for (int s = 0; s < 64; ++s) rs += wq[t * 65 + s];
                for (int d = 0; d < 256; ++d) qn += bf2f(qs[t * QS + d]) * ns[d];
                const float den = inter[t] * qn * 0.0625f + rs; dd[t] = fmaxf(fabsf(den), __expf(-mt[t])); }
            f32x4 a = (f32x4){0.f, 0.f, 0.f, 0.f};
            const int t4 = tid >> 3, e0 = 4 * (tid & 7);
            { for (int ch = 0; ch < 32; ++ch) { float qv[8]; unpack8(*(const LAS u32x4*)(qs + t4 * QS + ch * 8), qv);
#pragma unroll
                    for (int j = 0; j < 8; ++j) { const f32x4 cv = *(const LAS f32x4*)(Cs + (ch * 8 + j) * 36 + e0); a += qv[j] * cv; } }
              a *= inter[t4] * 0.0625f;
              for (int s = 0; s <= t4; ++s) { const float w = wq[t4 * 65 + s]; const f32x4 vv = *(const LAS f32x4*)(vsl + s * 32 + e0); a += w * vv; } }
            __syncthreads();
            { const float inv = 1.0f / dd[t4]; *(f32x4*)(hout + (tok0 + t4) * DM + h * 512 + es * 32 + e0) = a * inv; }
            {
                const int d = tid >> 1, eh = tid & 1, eo = 16 * eh; float u[16]; float un = 0.f;
#pragma unroll
                for (int j = 0; j < 16; ++j) u[j] = 0.f;
                for (int s = 0; s < 64; ++s) { const float kk = bf2f(ks[s * QS + d]) * ksc[s]; un += kk;
#pragma unroll
                    for (int j = 0; j < 16; ++j) u[j] += kk * vsl[s * 32 + eo + j]; }
                const float decay = sca[1];
#pragma unroll
                for (int j = 0; j < 16; ++j) Cs[d * 36 + eo + j] = decay * Cs[d * 36 + eo + j] + u[j];
                if (eh == 0) ns[d] = decay * ns[d] + un;
            }
            __syncthreads();
            if (tid == 0) sca[0] = sca[2];
            __syncthreads();
        }
    }
}

__device__ __forceinline__ void mlstm_scalars(const float* gif, const float* bif, float* scal, int bh, int lane) {
    constexpr float L2E = 1.4426950408889634f; constexpr size_t AS = (size_t)16 * SEQ;
    const int b = bh >> 3, h = bh & 7; float m_prev = 0.f;
    const float bi = bif[h], bf = bif[8 + h];
    for (int c = 0; c < 128; ++c) {
        const size_t tok = (size_t)b * SEQ + 64 * c + lane; const float ig = gif[tok * 16 + h] + bi, fg = gif[tok * 16 + 8 + h] + bf;
        const float lf = fg >= 0.f ? -log1pf(__expf(-fg)) : fg - log1pf(__expf(fg));
        float bsum = lf;
#pragma unroll
        for (int o = 1; o < 64; o <<= 1) { const float tv = __shfl_up(bsum, o); if (lane >= o) bsum += tv; }
        float pm = ig - bsum;
#pragma unroll
        for (int o = 1; o < 64; o <<= 1) { const float tv = __shfl_up(pm, o); if (lane >= o) pm = fmaxf(pm, tv); }
        const float mts = bsum + fmaxf(m_prev, pm); const float b_last = __shfl(bsum, 63), m_new = __shfl(mts, 63);
        float* sp = scal + (size_t)bh * SEQ + 64 * c + lane;
        sp[0] = (bsum - mts) * L2E; sp[AS] = (ig - bsum) * L2E; sp[2 * AS] = __expf(bsum + m_prev - mts); sp[3 * AS] = __expf(b_last - bsum + ig - m_new); sp[4 * AS] = __expf(-mts); sp[5 * AS] = __expf(b_last + m_prev - m_new);
        m_prev = m_new;
    }
}

__device__ __forceinline__ void cgates_phase(const bf16* A, const bf16* Wt, const float* bif, float* lsc, LAS unsigned char* lds) {
    const int tx_ = opaque_tid();
    const int lane = tx_ & 63, wave = __builtin_amdgcn_readfirstlane(tx_ >> 6), gw = blockIdx.x * NWAVES + wave, NGW = gridDim.x * NWAVES;
    const int fr = lane & 15, fq = lane >> 4;
    LAS float* gl = (LAS float*)(lds + wave * 4608);
    constexpr size_t AS = (size_t)16 * SEQ;
    const bool own = gridDim.x == 256;
    if (own) {
        const int task = 32 * (int)(blockIdx.x & 7) + (int)(blockIdx.x >> 3), tok0 = task * 64, b = task >> 7, c = task & 127;
        f32x4 acc[4];
#pragma unroll
        for (int r = 0; r < 4; ++r) acc[r] = (f32x4){0.f, 0.f, 0.f, 0.f};
        const bf16* ap = A + (size_t)(tok0 + fr) * DM + 8 * fq + 512 * wave; const bf16* bp = Wt + (size_t)fr * DM + 8 * fq + 512 * wave;
#pragma unroll 4
        for (int k0 = 0; k0 < 512; k0 += 32) { const bf16x8 bv = *(const bf16x8*)(bp + k0);
#pragma unroll
            for (int r = 0; r < 4; ++r) { const bf16x8 av = *(const bf16x8*)(ap + (size_t)r * 16 * DM + k0); acc[r] = __builtin_amdgcn_mfma_f32_16x16x32_bf16(av, bv, acc[r], 0, 0, 0); } }
#pragma unroll
        for (int r = 0; r < 4; ++r)
#pragma unroll
            for (int q = 0; q < 4; ++q) gl[(16 * r + 4 * fq + q) * 17 + fr] = acc[r][q];
        __syncthreads();
        { const int h = wave, bh = b * 8 + h; float ig = bif[h], fg = bif[8 + h];
#pragma unroll
          for (int w8 = 0; w8 < 8; ++w8) { const LAS float* g8 = (const LAS float*)(lds + w8 * 4608); ig += g8[lane * 17 + h]; fg += g8[lane * 17 + 8 + h]; }
          const float lf = fg >= 0.f ? -log1pf(__expf(-fg)) : fg - log1pf(__expf(fg));
          float bsum = lf;
#pragma unroll
          for (int o = 1; o < 64; o <<= 1) { const float tv = __shfl_up(bsum, o); if (lane >= o) bsum += tv; }
          float pm = ig - bsum;
#pragma unroll
          for (int o = 1; o < 64; o <<= 1) { const float tv = __shfl_up(pm, o); if (lane >= o) pm = fmaxf(pm, tv); }
          float* sp = lsc + (size_t)bh * SEQ + 64 * c + lane; sp[0] = bsum; sp[AS] = pm; sp[2 * AS] = ig;
          if (lane == 63) { lsc[3 * AS + bh * 128 + c] = bsum; lsc[3 * AS + 2048 + bh * 128 + c] = pm; } }
        __syncthreads();
        return;
    }
    for (int task0 = gw; task0 < TOK / 64; task0 += NGW) {
        const int task = task0;
        const int tok0 = task * 64, b = task >> 7, c = task & 127;
        f32x4 acc[4];
#pragma unroll
        for (int r = 0; r < 4; ++r) acc[r] = (f32x4){0.f, 0.f, 0.f, 0.f};
        const bf16* ap = A + (size_t)(tok0 + fr) * DM + 8 * fq; const bf16* bp = Wt + (size_t)fr * DM + 8 * fq;
#pragma unroll 4
        for (int k0 = 0; k0 < DM; k0 += 32) { const bf16x8 bv = *(const bf16x8*)(bp + k0);
#pragma unroll
            for (int r = 0; r < 4; ++r) { const bf16x8 av = *(const bf16x8*)(ap + (size_t)r * 16 * DM + k0); acc[r] = __builtin_amdgcn_mfma_f32_16x16x32_bf16(av, bv, acc[r], 0, 0, 0); } }
#pragma unroll
        for (int r = 0; r < 4; ++r)
#pragma unroll
            for (int q = 0; q < 4; ++q) gl[(16 * r + 4 * fq + q) * 17 + fr] = acc[r][q];
        LDS_WAIT();
        for (int h = 0; h < 8; ++h) { const int bh = b * 8 + h; const float ig = gl[lane * 17 + h] + bif[h], fg = gl[lane * 17 + 8 + h] + bif[8 + h];
            const float lf = fg >= 0.f ? -log1pf(__expf(-fg)) : fg - log1pf(__expf(fg));
            float bsum = lf;
#pragma unroll
            for (int o = 1; o < 64; o <<= 1) { const float tv = __shfl_up(bsum, o); if (lane >= o) bsum += tv; }
            float pm = ig - bsum;
#pragma unroll
            for (int o = 1; o < 64; o <<= 1) { const float tv = __shfl_up(pm, o); if (lane >= o) pm = fmaxf(pm, tv); }
            float* sp = lsc + (size_t)bh * SEQ + 64 * c + lane; sp[0] = bsum; sp[AS] = pm; sp[2 * AS] = ig;
            if (lane == 63) { lsc[3 * AS + bh * 128 + c] = bsum; lsc[3 * AS + 2048 + bh * 128 + c] = pm; } }
        LDS_WAIT();
    }
}
__device__ __forceinline__ void mlstm_scalars2(const float* lsc, float* scal, int bh, int c, int lane) {
    constexpr float L2E = 1.4426950408889634f; constexpr size_t AS = (size_t)16 * SEQ;
    const float cb0 = lsc[3 * AS + bh * 128 + lane], cb1 = lsc[3 * AS + bh * 128 + 64 + lane], cp0 = lsc[3 * AS + 2048 + bh * 128 + lane], cp1 = lsc[3 * AS + 2048 + bh * 128 + 64 + lane];
    float m_prev = 0.f;
    for (int k = 0; k < c; ++k) { const float cbk = __shfl(k < 64 ? cb0 : cb1, k & 63), cpk = __shfl(k < 64 ? cp0 : cp1, k & 63); m_prev = cbk + fmaxf(m_prev, cpk); }
    const float b_last = __shfl(c < 64 ? cb0 : cb1, c & 63), pm_last = __shfl(c < 64 ? cp0 : cp1, c & 63), m_new = b_last + fmaxf(m_prev, pm_last);
    const float* lp = lsc + (size_t)bh * SEQ + 64 * c + lane; const float bsum = lp[0], pm = lp[AS], ig = lp[2 * AS];
    const float mts = bsum + fmaxf(m_prev, pm);
    float* sp = scal + (size_t)bh * SEQ + 64 * c + lane;
    sp[0] = (bsum - mts) * L2E; sp[AS] = (ig - bsum) * L2E; sp[2 * AS] = __expf(bsum + m_prev - mts); sp[3 * AS] = __expf(b_last - bsum + ig - m_new); sp[4 * AS] = __expf(-mts); sp[5 * AS] = __expf(b_last + m_prev - m_new);
}
__device__ __forceinline__ void mlstm_relayout(const bf16* projc, bf16* kT, bf16* vT, LAS unsigned char* lds, int task_lo, int task_step, bool v_only = false) {
    const int tx_ = opaque_tid();
    const int lane = tx_ & 63, wave = __builtin_amdgcn_readfirstlane(tx_ >> 6);
    LAS bf16* tile = (LAS bf16*)(lds + wave * 9216);
    (void)kT; (void)v_only;
    for (int task = task_lo; task < 2048 * 2; task += task_step) {
        const int bc = task >> 1, hf = task & 1, bh = bc >> 7, c = bc & 127, b = bh >> 3, h = bh & 7;
        u32x4 raw[4][8];
#pragma unroll
        for (int q4 = 0; q4 < 4; ++q4) { const bf16* src = projc + (size_t)(b * SEQ + 64 * c) * C_N + 4096 + h * 512 + (hf * 4 + q4) * 64;
#pragma unroll
            for (int i = 0; i < 8; ++i) { const int idx = lane + 64 * i, r = idx >> 3, ch = idx & 7; raw[q4][i] = *(const u32x4*)(src + (size_t)r * C_N + ch * 8); } }
#pragma unroll
        for (int q4 = 0; q4 < 4; ++q4) {
#pragma unroll
            for (int i = 0; i < 8; ++i) { const int idx = lane + 64 * i, r = idx >> 3, ch = idx & 7; *(LAS u32x4*)(tile + r * 72 + ch * 8) = raw[q4][i]; }
            LDS_WAIT();
            const int eg = (hf * 4 + q4) * 64 + lane;
            bf16* dst = vT + ((size_t)bh * 128 + c) * 32768 + (size_t)(((eg >> 5) * 2 + ((eg >> 4) & 1)) * 2) * 512 + (eg & 15) * 8;
#pragma unroll
            for (int c8 = 0; c8 < 8; ++c8) { u32x4 w;
                w.x = (unsigned)tile[(8 * c8 + 0) * 72 + lane] | ((unsigned)tile[(8 * c8 + 1) * 72 + lane] << 16); w.y = (unsigned)tile[(8 * c8 + 2) * 72 + lane] | ((unsigned)tile[(8 * c8 + 3) * 72 + lane] << 16);
                w.z = (unsigned)tile[(8 * c8 + 4) * 72 + lane] | ((unsigned)tile[(8 * c8 + 5) * 72 + lane] << 16); w.w = (unsigned)tile[(8 * c8 + 6) * 72 + lane] | ((unsigned)tile[(8 * c8 + 7) * 72 + lane] << 16);
                *(u32x4*)(dst + (c8 >> 2) * 512 + (c8 & 3) * 128) = w; }
            LDS_WAIT();
        }
    }
}
__device__ __forceinline__ void mlstm_pre_phase(const bf16* projc, const float* lsc, float* scal, bf16* kT, bf16* vT, LAS unsigned char* lds) {
    const int tx_ = opaque_tid();
    const int gw = blockIdx.x * NWAVES + __builtin_amdgcn_readfirstlane(tx_ >> 6), NGW = gridDim.x * NWAVES;
    for (int task = gw; task < 2048; task += NGW) mlstm_scalars2(lsc, scal, task >> 7, task & 127, tx_ & 63);
    mlstm_relayout(projc, kT, vT, lds, gw, NGW);
}
__device__ __forceinline__ void mlstm_wq(const bf16* projc, const float* scal, int b, int h, int bh, int c, int tt, int sp, int fr, int qd, LAS bf16* buf, bf16x8 (&qf)[8]) {
    constexpr size_t AS = (size_t)16 * SEQ;
    const size_t tok0 = (size_t)b * SEQ + 64 * c;
    const bf16* qp = projc + (tok0 + 16 * tt + fr) * C_N + h * 256 + 8 * qd;
#pragma unroll
    for (int i = 0; i < 8; ++i) qf[i] = *(const bf16x8*)(qp + 32 * i);
    const int t = 16 * tt + fr; const float ra = scal[(size_t)bh * SEQ + 64 * c + t];
#pragma unroll
    for (int ss = 0; ss < 2; ++ss) { const int st = 2 * sp + ss;
        u32x2 w = (u32x2){0u, 0u};
        if (st <= tt) {
            const bf16* kp = projc + (tok0 + 16 * st + fr) * C_N + 2048 + h * 256 + 8 * qd;
            f32x4 acc = (f32x4){0.f, 0.f, 0.f, 0.f};
#pragma unroll
            for (int i = 0; i < 8; ++i) { const bf16x8 kf = *(const bf16x8*)(kp + 32 * i); acc = MFMA16(kf, qf[i], acc); }
            const f32x4 cb = *(const f32x4*)(scal + AS + (size_t)bh * SEQ + 64 * c + 16 * st + 4 * qd);
            float wv[4];
#pragma unroll
            for (int r = 0; r < 4; ++r) { const int sidx = 16 * st + 4 * qd + r; wv[r] = (sidx <= t) ? acc[r] * 0.0625f * __builtin_amdgcn_exp2f(ra + cb[r]) : 0.f; }
            w.x = pk2(wv[0], wv[1]); w.y = pk2(wv[2], wv[3]);
        }
        *(LAS u32x2*)(buf + t * 72 + 16 * st + 4 * qd) = w;
    }
}
__device__ __forceinline__ void mlstm_fast_phase(const bf16* projc, const bf16* kT, const bf16* vT, const float* scal, float* hout, LAS unsigned char* lds) {
    const int tx_ = opaque_tid();
    constexpr size_t AS = (size_t)16 * SEQ;
    const int tid = tx_, lane = tid & 63, w = __builtin_amdgcn_readfirstlane(tid >> 6), fr = lane & 15, qd = lane >> 4;
    const int tt = w & 3, sp = w >> 2, et = w >> 2;
    for (int unit = blockIdx.x; unit < 256; unit += gridDim.x) {
        const int b = unit >> 7, h = (unit >> 4) & 7, es = unit & 15, bh = b * 8 + h;
        LAS bf16* wqb0 = (LAS bf16*)lds; LAS bf16* wqb1 = wqb0 + 64 * 72; LAS bf16* ctb0 = wqb1 + 64 * 72; LAS bf16* ctb1 = ctb0 + 48 * 264;
        for (int i = tid; i < 48 * 264 / 2; i += 512) ((LAS unsigned*)ctb0)[i] = 0u;
        f32x4 C[2][3];
#pragma unroll
        for (int a = 0; a < 2; ++a)
#pragma unroll
            for (int e3 = 0; e3 < 3; ++e3) C[a][e3] = (f32x4){0.f, 0.f, 0.f, 0.f};
        bf16x8 qf[8];
        mlstm_wq(projc, scal, b, h, bh, 0, tt, sp, fr, qd, wqb0, qf);
        for (int c = 0; c < 128; ++c) {
            LAS bf16* wqc = (c & 1) ? wqb1 : wqb0; LAS bf16* ctc = (c & 1) ? ctb1 : ctb0; LAS bf16* ctn = (c & 1) ? ctb0 : ctb1;
            __syncthreads();
            const size_t tok0 = (size_t)b * SEQ + 64 * c; const float* sc0 = scal + (size_t)bh * SEQ + 64 * c;
            const bf16* vbase = vT + (((size_t)bh * 128 + c) * 512 + es * 32 + fr) * 64 + 8 * qd;
            bf16x8 vf[2][2];
#pragma unroll
            for (int e2 = 0; e2 < 2; ++e2)
#pragma unroll
                for (int i = 0; i < 2; ++i) vf[e2][i] = *(const bf16x8*)(vbase + (size_t)e2 * 16 * 64 + 32 * i);
            f32x4 ae = (f32x4){0.f, 0.f, 0.f, 0.f}, an = (f32x4){0.f, 0.f, 0.f, 0.f};
#pragma unroll
            for (int i = 0; i < 8; ++i) { const bf16x8 b0 = *(const LAS bf16x8*)(ctc + (16 * et + fr) * 264 + 32 * i + 8 * qd), b2 = *(const LAS bf16x8*)(ctc + (32 + fr) * 264 + 32 * i + 8 * qd);
                ae = MFMA16(qf[i], b0, ae); an = MFMA16(qf[i], b2, an); }
            { const f32x4 it = *(const f32x4*)(sc0 + 2 * AS + 16 * tt + 4 * qd);
#pragma unroll
              for (int r = 0; r < 4; ++r) { ae[r] *= it[r] * 0.0625f; an[r] *= it[r] * 0.0625f; } }
            const bf16x8 ones = (fr == 0) ? (bf16x8){0x3F80, 0x3F80, 0x3F80, 0x3F80, 0x3F80, 0x3F80, 0x3F80, 0x3F80} : (bf16x8){0, 0, 0, 0, 0, 0, 0, 0};
#pragma unroll
            for (int i = 0; i < 2; ++i) { const bf16x8 a = *(const LAS bf16x8*)(wqc + (16 * tt + fr) * 72 + 32 * i + 8 * qd);
                ae = MFMA16(a, (et ? vf[1][i] : vf[0][i]), ae); an = MFMA16(a, ones, an); }
            { const f32x4 em = *(const f32x4*)(sc0 + 4 * AS + 16 * tt + 4 * qd); f32x4 hv;
#pragma unroll
              for (int r = 0; r < 4; ++r) { const float dn = __shfl(an[r], lane & 48); hv[r] = ae[r] / fmaxf(fabsf(dn), em[r]); }
              float* hp = hout + (tok0 + 16 * tt + 4 * qd) * DM + h * 512 + es * 32 + 16 * et + fr;
#pragma unroll
              for (int r = 0; r < 4; ++r) hp[(size_t)r * DM] = hv[r]; }
            { const float decay = sc0[5 * AS];
#pragma unroll
              for (int a = 0; a < 2; ++a)
#pragma unroll
                  for (int e3 = 0; e3 < 3; ++e3) C[a][e3] *= decay;
              const bf16* kb = kT + (((size_t)bh * 128 + c) * 256 + 32 * w + fr) * 64 + 8 * qd;
#pragma unroll
              for (int i = 0; i < 2; ++i) { const bf16x8 a0 = *(const bf16x8*)(kb + 32 * i), a1 = *(const bf16x8*)(kb + 16 * 64 + 32 * i);
                  const f32x4 k0 = *(const f32x4*)(sc0 + 3 * AS + 32 * i + 8 * qd), k1 = *(const f32x4*)(sc0 + 3 * AS + 32 * i + 8 * qd + 4);
                  const float ks[8] = {k0[0], k0[1], k0[2], k0[3], k1[0], k1[1], k1[2], k1[3]};
                  bf16x8 vs[2];
#pragma unroll
                  for (int e2 = 0; e2 < 2; ++e2) { float f[8]; unpack8(__builtin_bit_cast(u32x4, vf[e2][i]), f); u32x4 p; p.x = pk2(f[0] * ks[0], f[1] * ks[1]); p.y = pk2(f[2] * ks[2], f[3] * ks[3]); p.z = pk2(f[4] * ks[4], f[5] * ks[5]); p.w = pk2(f[6] * ks[6], f[7] * ks[7]); vs[e2] = __builtin_bit_cast(bf16x8, p); }
                  u32x4 pn = (u32x4){0u, 0u, 0u, 0u}; if (fr == 0) { pn.x = pk2(ks[0], ks[1]); pn.y = pk2(ks[2], ks[3]); pn.z = pk2(ks[4], ks[5]); pn.w = pk2(ks[6], ks[7]); }
                  const bf16x8 vn = __builtin_bit_cast(bf16x8, pn);
                  C[0][0] = MFMA16(a0, vs[0], C[0][0]); C[0][1] = MFMA16(a0, vs[1], C[0][1]); C[0][2] = MFMA16(a0, vn, C[0][2]);
                  C[1][0] = MFMA16(a1, vs[0], C[1][0]); C[1][1] = MFMA16(a1, vs[1], C[1][1]); C[1][2] = MFMA16(a1, vn, C[1][2]); }
#pragma unroll
              for (int a = 0; a < 2; ++a)
#pragma unroll
                  for (int e3 = 0; e3 < 3; ++e3) { u32x2 p; p.x = pk2(C[a][e3][0], C[a][e3][1]); p.y = pk2(C[a][e3][2], C[a][e3][3]); *(LAS u32x2*)(ctn + (16 * e3 + fr) * 264 + 32 * w + 16 * a + 4 * qd) = p; } }
            if (c + 1 < 128) mlstm_wq(projc, scal, b, h, bh, c + 1, tt, sp, fr, qd, (c & 1) ? wqb0 : wqb1, qf);
        }
        __syncthreads();
    }
}


__device__ __forceinline__ void mlstm_chunk_task(const bf16* projc, const float* lsc, float* scal, bf16* wqg, bf16* kT, bf16* qF, LAS unsigned char* ldsw, int bh, int c, int lane) {
    constexpr float L2E = 1.4426950408889634f; constexpr size_t AS = (size_t)16 * SEQ;
    const int b = bh >> 3, h = bh & 7, fr = lane & 15, qd = lane >> 4;
    const float cb0 = lsc[3 * AS + bh * 128 + lane], cb1 = lsc[3 * AS + bh * 128 + 64 + lane], cp0 = lsc[3 * AS + 2048 + bh * 128 + lane], cp1 = lsc[3 * AS + 2048 + bh * 128 + 64 + lane];
    float m_prev = 0.f;
    for (int k = 0; k < c; ++k) { const float cbk = __shfl(k < 64 ? cb0 : cb1, k & 63), cpk = __shfl(k < 64 ? cp0 : cp1, k & 63); m_prev = cbk + fmaxf(m_prev, cpk); }
    const float b_last = __shfl(c < 64 ? cb0 : cb1, c & 63), pm_last = __shfl(c < 64 ? cp0 : cp1, c & 63), m_new = b_last + fmaxf(m_prev, pm_last);
    const float* lp = lsc + (size_t)bh * SEQ + 64 * c + lane; const float bsum = lp[0], pm = lp[AS], ig = lp[2 * AS];
    const float mts = bsum + fmaxf(m_prev, pm);
    const float rowA = (bsum - mts) * L2E, colB = (ig - bsum) * L2E;
    float* sp = scal + (size_t)bh * SEQ + 64 * c + lane;
    sp[2 * AS] = __expf(bsum + m_prev - mts); sp[3 * AS] = __expf(b_last - bsum + ig - m_new); sp[4 * AS] = __expf(-mts); sp[5 * AS] = __expf(b_last + m_prev - m_new);
    const size_t tok0 = (size_t)b * SEQ + 64 * c; bf16* wq = wqg + ((size_t)bh * 128 + c) * 4096;
#pragma unroll
    for (int tt = 0; tt < 4; ++tt) {
        int lq = lane * 8; asm volatile("" : "+v"(lq));
        const bf16* qp = projc + (tok0 + 16 * tt + fr) * C_N + h * 256 + 8 * qd; bf16x8 qf[8], kf[4][8];
#pragma unroll
        for (int i = 0; i < 8; ++i) { qf[i] = *(const bf16x8*)(qp + 32 * i); *(bf16x8*)(qF + (((size_t)bh * 128 + c) * 32 + tt * 8 + i) * 512 + lq) = qf[i]; }
#pragma unroll
        for (int st = 0; st < 4; ++st) if (st <= tt) { const bf16* kp = projc + (tok0 + 16 * st + fr) * C_N + 2048 + h * 256 + 8 * qd;
#pragma unroll
            for (int i = 0; i < 8; ++i) kf[st][i] = *(const bf16x8*)(kp + 32 * i); }
        const int t = 16 * tt + fr; const float ra = __shfl(rowA, t);
#pragma unroll
        for (int st = 0; st < 4; ++st) { u32x2 w = (u32x2){0u, 0u};
            if (st <= tt) { f32x4 acc = (f32x4){0.f, 0.f, 0.f, 0.f};
#pragma unroll
                for (int i = 0; i < 8; ++i) acc = MFMA16(kf[st][i], qf[i], acc);
                float wv[4];
#pragma unroll
                for (int r = 0; r < 4; ++r) { const int sidx = 16 * st + 4 * qd + r; const float cb = __shfl(colB, sidx); wv[r] = (sidx <= t) ? acc[r] * 0.0625f * __builtin_amdgcn_exp2f(ra + cb) : 0.f; }
                w.x = pk2(wv[0], wv[1]); w.y = pk2(wv[2], wv[3]); }
            *(u32x2*)(wq + ((tt * 2 + (st >> 1)) * 64 + (2 * (st & 1) + (qd >> 1)) * 16 + fr) * 8 + 4 * (qd & 1)) = w; }
    }
    { const float kscv = __expf(b_last - bsum + ig - m_new);
      LAS float* kl = (LAS float*)ldsw; LAS bf16* tile = (LAS bf16*)(ldsw + 256);
      kl[lane] = kscv; LDS_WAIT();
      u32x4 raw[4][8];
#pragma unroll
      for (int sub = 0; sub < 4; ++sub) { const bf16* src = projc + tok0 * C_N + 2048 + h * 256 + sub * 64;
#pragma unroll
          for (int i = 0; i < 8; ++i) { const int idx = lane + 64 * i, r = idx >> 3, ch = idx & 7; raw[sub][i] = *(const u32x4*)(src + (size_t)r * C_N + ch * 8); } }
#pragma unroll
      for (int sub = 0; sub < 4; ++sub) {
#pragma unroll
          for (int i = 0; i < 8; ++i) { const int idx = lane + 64 * i, r = idx >> 3, ch = idx & 7; float f[8]; unpack8(raw[sub][i], f); const float sc = kl[r];
              u32x4 o; o.x = pg8::cvt_pk_bf16(f[0] * sc, f[1] * sc); o.y = pg8::cvt_pk_bf16(f[2] * sc, f[3] * sc); o.z = pg8::cvt_pk_bf16(f[4] * sc, f[5] * sc); o.w = pg8::cvt_pk_bf16(f[6] * sc, f[7] * sc);
              *(LAS u32x4*)(tile + r * 72 + ch * 8) = o; }
          LDS_WAIT();
          bf16* dst = kT + ((size_t)bh * 128 + c) * 16384 + (size_t)((sub * 2 + (lane >> 5)) * 2 + ((lane >> 4) & 1)) * 1024 + (lane & 15) * 8;
#pragma unroll
          for (int c8 = 0; c8 < 8; ++c8) { u32x4 w;
              w.x = (unsigned)tile[(8 * c8 + 0) * 72 + lane] | ((unsigned)tile[(8 * c8 + 1) * 72 + lane] << 16); w.y = (unsigned)tile[(8 * c8 + 2) * 72 + lane] | ((unsigned)tile[(8 * c8 + 3) * 72 + lane] << 16);
              w.z = (unsigned)tile[(8 * c8 + 4) * 72 + lane] | ((unsigned)tile[(8 * c8 + 5) * 72 + lane] << 16); w.w = (unsigned)tile[(8 * c8 + 6) * 72 + lane] | ((unsigned)tile[(8 * c8 + 7) * 72 + lane] << 16);
              *(u32x4*)(dst + (c8 >> 2) * 512 + (c8 & 3) * 128) = w; }
          LDS_WAIT();
      } }
}
__device__ __forceinline__ void mlstm_pre2_phase(const bf16* projc, const float* lsc, float* scal, bf16* wqg, bf16* kT, bf16* vT, bf16* qF, LAS unsigned char* lds) {
    const int tx_ = opaque_tid();
    const int wave = __builtin_amdgcn_readfirstlane(tx_ >> 6), gw = blockIdx.x * NWAVES + wave, NGW = gridDim.x * NWAVES;
    for (int task = gw; task < 2048; task += NGW) mlstm_chunk_task(projc, lsc, scal, wqg, kT, qF, lds + wave * 9728, task >> 7, task & 127, tx_ & 63);
    __syncthreads();
    mlstm_relayout(projc, kT, vT, lds, gw, NGW, true);
}
struct MlSet { bf16x8 wa[2], qf[8], vf[2][2], ka[2][2]; f32x4 it, em; float decay; };
struct MlOff { int ow, oq, ov, os; };
__device__ __forceinline__ void mlstm_load_set(MlSet& S, const MlOff& Of, const bf16* qF, const bf16* wqg, const bf16* kT, const bf16* vT, const float* scal, int b, int h, int bh, int es, int c, int w, int tt) {
    constexpr size_t AS = (size_t)16 * SEQ;
    int ol = Of.ow, os = Of.os; asm volatile("" : "+v"(ol), "+v"(os));
    const size_t cb = (size_t)bh * 128 + c;
    const bf16* wp = wqg + cb * 4096 + tt * 1024;
    const bf16* qp = qF + cb * 16384 + tt * 4096;
    const bf16* vp = vT + cb * 32768 + es * 2048;
    const bf16* kp = kT + cb * 16384 + w * 2048;
    const float* sc0 = scal + (size_t)bh * SEQ + 64 * c + 16 * tt;
    S.wa[0] = *(const bf16x8*)(wp + ol); S.wa[1] = *(const bf16x8*)(wp + (ol + 512));
#pragma unroll
    for (int i = 0; i < 8; ++i) S.qf[i] = *(const bf16x8*)(qp + (ol + 512 * i));
#pragma unroll
    for (int e2 = 0; e2 < 2; ++e2)
#pragma unroll
        for (int i = 0; i < 2; ++i) { S.vf[e2][i] = *(const bf16x8*)(vp + (ol + (e2 * 2 + i) * 512)); S.ka[e2][i] = *(const bf16x8*)(kp + (ol + (e2 * 2 + i) * 512)); }
    S.it = *(const f32x4*)(sc0 + 2 * AS + os); S.em = *(const f32x4*)(sc0 + 4 * AS + os);
    S.decay = scal[(size_t)bh * SEQ + 64 * c + 5 * AS];
}
template <bool STORE = true> __device__ __forceinline__ void mlstm_step(const MlSet& S, f32x4 (&C)[2][3], const LAS bf16* ctc, LAS bf16* ctn, float* hout, int b, int h, int es, int c, int w, int tt, int et, int lane) {
    const int fr = lane & 15, qd = lane >> 4;
    f32x4 ae = (f32x4){0.f, 0.f, 0.f, 0.f}, an = (f32x4){0.f, 0.f, 0.f, 0.f};
#pragma unroll
    for (int i = 0; i < 8; ++i) { const bf16x8 b0 = *(const LAS bf16x8*)(ctc + (16 * et + fr) * 264 + 32 * i + 8 * qd), b2 = *(const LAS bf16x8*)(ctc + (32 + fr) * 264 + 32 * i + 8 * qd);
        ae = MFMA16(S.qf[i], b0, ae); an = MFMA16(S.qf[i], b2, an); }
#pragma unroll
    for (int r = 0; r < 4; ++r) { const float sc = S.it[r] * 0.0625f; ae[r] *= sc; an[r] *= sc; }
    const bf16x8 ones = (fr == 0) ? (bf16x8){0x3F80, 0x3F80, 0x3F80, 0x3F80, 0x3F80, 0x3F80, 0x3F80, 0x3F80} : (bf16x8){0, 0, 0, 0, 0, 0, 0, 0};
#pragma unroll
    for (int i = 0; i < 2; ++i) { ae = MFMA16(S.wa[i], (et ? S.vf[1][i] : S.vf[0][i]), ae); an = MFMA16(S.wa[i], ones, an); }
    { f32x4 hv;
#pragma unroll
      for (int r = 0; r < 4; ++r) { const float dn = __shfl(an[r], lane & 48); hv[r] = ae[r] * __builtin_amdgcn_rcpf(fmaxf(fabsf(dn), S.em[r])); }
      bf16* hp = (bf16*)hout + ((size_t)b * SEQ + 64 * c + 16 * tt + 4 * qd) * DM + h * 512 + es * 32 + 16 * et + fr;
      if (STORE) {
#pragma unroll
      for (int r = 0; r < 4; ++r) hp[(size_t)r * DM] = (bf16)f2bf(hv[r]); } else asm volatile("" :: "v"(hv[0]), "v"(hv[1]), "v"(hv[2]), "v"(hv[3])); }
#pragma unroll
    for (int a = 0; a < 2; ++a)
#pragma unroll
        for (int e3 = 0; e3 < 3; ++e3) C[a][e3] *= S.decay;
#pragma unroll
    for (int i = 0; i < 2; ++i) {
        C[0][0] = MFMA16(S.ka[0][i], S.vf[0][i], C[0][0]); C[0][1] = MFMA16(S.ka[0][i], S.vf[1][i], C[0][1]); C[0][2] = MFMA16(S.ka[0][i], ones, C[0][2]);
        C[1][0] = MFMA16(S.ka[1][i], S.vf[0][i], C[1][0]); C[1][1] = MFMA16(S.ka[1][i], S.vf[1][i], C[1][1]); C[1][2] = MFMA16(S.ka[1][i], ones, C[1][2]); }
    asm volatile("s_nop 15\n\ts_nop 15" : "+v"(C[0][0]), "+v"(C[0][1]), "+v"(C[0][2]), "+v"(C[1][0]), "+v"(C[1][1]), "+v"(C[1][2]));
#pragma unroll
    for (int a = 0; a < 2; ++a)
#pragma unroll
        for (int e3 = 0; e3 < 3; ++e3) { u32x2 pc; pc.x = pg8::cvt_pk_bf16(C[a][e3][0], C[a][e3][1]); pc.y = pg8::cvt_pk_bf16(C[a][e3][2], C[a][e3][3]); *(LAS u32x2*)(ctn + (16 * e3 + fr) * 264 + 32 * w + 16 * a + 4 * qd) = pc; }
}
struct MlAddr { const bf16 *wp, *qp, *vp, *kp; const float* sc0; const float* dcp; };
__device__ __forceinline__ MlAddr mlstm_addr(const bf16* qF, const bf16* wqg, const bf16* kT, const bf16* vT, const float* scal, int bh, int es, int c, int w, int tt) {
    constexpr size_t AS = (size_t)16 * SEQ; const size_t cb = (size_t)bh * 128 + c; MlAddr A;
    A.wp = wqg + cb * 4096 + tt * 1024; A.qp = qF + cb * 16384 + tt * 4096; A.vp = vT + cb * 32768 + es * 2048; A.kp = kT + cb * 16384 + w * 2048;
    A.sc0 = scal + (size_t)bh * SEQ + 64 * c + 16 * tt; A.dcp = scal + (size_t)bh * SEQ + 64 * c + 5 * AS; return A;
}
__device__ __forceinline__ void mlstm_load_q(MlSet& S, const MlOff& Of, const MlAddr& A) {
    int ol = Of.ow; asm volatile("" : "+v"(ol));
#pragma unroll
    for (int i = 0; i < 8; ++i) S.qf[i] = *(const bf16x8*)(A.qp + (ol + 512 * i));
}
__device__ __forceinline__ void mlstm_load_w(MlSet& S, const MlOff& Of, const MlAddr& A) {
    int ol = Of.ow; asm volatile("" : "+v"(ol));
    S.wa[0] = *(const bf16x8*)(A.wp + ol); S.wa[1] = *(const bf16x8*)(A.wp + (ol + 512));
}
__device__ __forceinline__ void mlstm_load_r(MlSet& S, const MlOff& Of, const MlAddr& A) {
    constexpr size_t AS = (size_t)16 * SEQ;
    int ol = Of.ow, os = Of.os; asm volatile("" : "+v"(ol), "+v"(os));
#pragma unroll
    for (int e2 = 0; e2 < 2; ++e2)
#pragma unroll
        for (int i = 0; i < 2; ++i) { S.vf[e2][i] = *(const bf16x8*)(A.vp + (ol + (e2 * 2 + i) * 512)); S.ka[e2][i] = *(const bf16x8*)(A.kp + (ol + (e2 * 2 + i) * 512)); }
    S.it = *(const f32x4*)(A.sc0 + 2 * AS + os); S.em = *(const f32x4*)(A.sc0 + 4 * AS + os);
    S.decay = *A.dcp;
}
__device__ __forceinline__ void mlstm_step2(MlSet& S, const MlOff& Of, const MlAddr& A2, f32x4 (&C)[2][3], const LAS bf16* ctc, LAS bf16* ctn, float* hout, int b, int h, int es, int c, int w, int tt, int et, int lane) {
    const int fr = lane & 15, qd = lane >> 4;
    f32x4 ae = (f32x4){0.f, 0.f, 0.f, 0.f}, an = (f32x4){0.f, 0.f, 0.f, 0.f};
#pragma unroll
    for (int i = 0; i < 8; ++i) { const bf16x8 b0 = *(const LAS bf16x8*)(ctc + (16 * et + fr) * 264 + 32 * i + 8 * qd), b2 = *(const LAS bf16x8*)(ctc + (32 + fr) * 264 + 32 * i + 8 * qd);
        ae = MFMA16(S.qf[i], b0, ae); an = MFMA16(S.qf[i], b2, an); }
    __builtin_amdgcn_sched_barrier(0);
    mlstm_load_q(S, Of, A2);
#pragma unroll
    for (int r = 0; r < 4; ++r) { const float sc = S.it[r] * 0.0625f; ae[r] *= sc; an[r] *= sc; }
    const bf16x8 ones = (fr == 0) ? (bf16x8){0x3F80, 0x3F80, 0x3F80, 0x3F80, 0x3F80, 0x3F80, 0x3F80, 0x3F80} : (bf16x8){0, 0, 0, 0, 0, 0, 0, 0};
#pragma unroll
    for (int i = 0; i < 2; ++i) { ae = MFMA16(S.wa[i], (et ? S.vf[1][i] : S.vf[0][i]), ae); an = MFMA16(S.wa[i], ones, an); }
    __builtin_amdgcn_sched_barrier(0);
    mlstm_load_w(S, Of, A2);
    { f32x4 hv;
#pragma unroll
      for (int r = 0; r < 4; ++r) { const float dn = __shfl(an[r], lane & 48); hv[r] = ae[r] * __builtin_amdgcn_rcpf(fmaxf(fabsf(dn), S.em[r])); }
      float* hp = hout + ((size_t)b * SEQ + 64 * c + 16 * tt + 4 * qd) * DM + h * 512 + es * 32 + 16 * et + fr;
#pragma unroll
      for (int r = 0; r < 4; ++r) hp[(size_t)r * DM] = hv[r]; }
#pragma unroll
    for (int a = 0; a < 2; ++a)
#pragma unroll
        for (int e3 = 0; e3 < 3; ++e3) C[a][e3] *= S.decay;
#pragma unroll
    for (int i = 0; i < 2; ++i) {
        C[0][0] = MFMA16(S.ka[0][i], S.vf[0][i], C[0][0]); C[0][1] = MFMA16(S.ka[0][i], S.vf[1][i], C[0][1]); C[0][2] = MFMA16(S.ka[0][i], ones, C[0][2]);
        C[1][0] = MFMA16(S.ka[1][i], S.vf[0][i], C[1][0]); C[1][1] = MFMA16(S.ka[1][i], S.vf[1][i], C[1][1]); C[1][2] = MFMA16(S.ka[1][i], ones, C[1][2]); }
    __builtin_amdgcn_sched_barrier(0);
    mlstm_load_r(S, Of, A2);
    __builtin_amdgcn_sched_barrier(0);
    asm volatile("s_nop 15\n\ts_nop 15" : "+v"(C[0][0]), "+v"(C[0][1]), "+v"(C[0][2]), "+v"(C[1][0]), "+v"(C[1][1]), "+v"(C[1][2]));
#pragma unroll
    for (int a = 0; a < 2; ++a)
#pragma unroll
        for (int e3 = 0; e3 < 3; ++e3) { u32x2 pc; pc.x = pg8::cvt_pk_bf16(C[a][e3][0], C[a][e3][1]); pc.y = pg8::cvt_pk_bf16(C[a][e3][2], C[a][e3][3]); *(LAS u32x2*)(ctn + (16 * e3 + fr) * 264 + 32 * w + 16 * a + 4 * qd) = pc; }
}
struct MlWarm { unsigned a, b, c; };
__device__ __forceinline__ void mlstm_warm(MlWarm& W, const bf16* projc, const bf16* wqg, const bf16* kT, const bf16* vT, const float* scal, int b, int h, int bh, int es, int c, int w, int tt, int lane) {
    constexpr size_t AS = (size_t)16 * SEQ;
    int lo = lane; asm volatile("" : "+v"(lo));
    const size_t tok0 = (size_t)b * SEQ + 64 * c;
    W.a = *(const unsigned*)(projc + (tok0 + 16 * tt + (lo & 15)) * C_N + h * 256 + (lo >> 4) * 64);
    const bf16* p1 = (lo < 32) ? kT + (((size_t)bh * 128 + c) * 256 + 32 * w + lo) * 64 : vT + (((size_t)bh * 128 + c) * 512 + es * 32 + (lo - 32)) * 64;
    W.b = *(const unsigned*)p1;
    const float* sc0 = scal + (size_t)bh * SEQ + 64 * c; const int si = lo - 16;
    const void* p2 = (lo < 16) ? (const void*)(wqg + ((size_t)bh * 128 + c) * 4096 + (16 * tt + lo) * 64)
                   : (si < 6) ? (const void*)(sc0 + (size_t)(2 + (si >> 1)) * AS + (si & 1) * 32) : (const void*)(sc0 + 5 * AS);
    W.c = *(const unsigned*)p2;
}
#define ML_WARM_USE(W) asm volatile("" :: "v"((W).a), "v"((W).b), "v"((W).c))
#define ML_BAR() do { asm volatile("s_waitcnt lgkmcnt(0)" ::: "memory"); __builtin_amdgcn_s_barrier(); asm volatile("" ::: "memory"); } while (0)
__device__ __forceinline__ void mlstm_fast2_phase(const bf16* qF, const bf16* wqg, const bf16* kT, const bf16* vT, const float* scal, float* hout, LAS unsigned char* lds) {
    const int tid = opaque_tid();
    const int lane = tid & 63, w = __builtin_amdgcn_readfirstlane(tid >> 6), tt = w & 3, et = w >> 2, fr = lane & 15, qd = lane >> 4;
    MlOff Of; Of.ow = lane * 8; Of.oq = 0; Of.ov = 0; Of.os = 4 * qd; (void)fr;
    for (int unit0 = blockIdx.x; unit0 < 256; unit0 += gridDim.x) {
        const int unit = unit0;
        const int b = unit >> 7, h = (unit >> 4) & 7, es = unit & 15, bh = b * 8 + h;
        LAS bf16* ctb0 = (LAS bf16*)lds; LAS bf16* ctb1 = ctb0 + 48 * 264;
        for (int i = tid; i < 48 * 264 / 2; i += 512) ((LAS unsigned*)ctb0)[i] = 0u;
        f32x4 C[2][3];
#pragma unroll
        for (int a = 0; a < 2; ++a)
#pragma unroll
            for (int e3 = 0; e3 < 3; ++e3) C[a][e3] = (f32x4){0.f, 0.f, 0.f, 0.f};
        MlSet S0, S1;
        mlstm_load_set(S0, Of, qF, wqg, kT, vT, scal, b, h, bh, es, 0, w, tt);
#if MK_ML_REFILL
        mlstm_load_set(S1, Of, qF, wqg, kT, vT, scal, b, h, bh, es, 1, w, tt);
#pragma unroll 1
        for (int c = 0; c < 128; c += 2) {
            const MlAddr A2 = mlstm_addr(qF, wqg, kT, vT, scal, bh, es, (c + 2 < 128) ? c + 2 : 127, w, tt), A3 = mlstm_addr(qF, wqg, kT, vT, scal, bh, es, (c + 3 < 128) ? c + 3 : 127, w, tt);
            ML_BAR();
            mlstm_step2(S0, Of, A2, C, ctb0, ctb1, hout, b, h, es, c, w, tt, et, lane);
            ML_BAR();
            mlstm_step2(S1, Of, A3, C, ctb1, ctb0, hout, b, h, es, c + 1, w, tt, et, lane);
        }
#else
#pragma unroll 1
        for (int c = 0; c < 128; c += 2) {
            ML_BAR();
            mlstm_load_set(S1, Of, qF, wqg, kT, vT, scal, b, h, bh, es, c + 1, w, tt);
            mlstm_step(S0, C, ctb0, ctb1, hout, b, h, es, c, w, tt, et, lane);
            ML_BAR();
            mlstm_load_set(S0, Of, qF, wqg, kT, vT, scal, b, h, bh, es, (c + 2 < 128) ? c + 2 : 127, w, tt);
            mlstm_step(S1, C, ctb1, ctb0, hout, b, h, es, c + 1, w, tt, et, lane);
        }
#endif
#if MK_ML_PROBE == 1
        __syncthreads();
#pragma unroll 1
        for (int c = 0; c < 128; c += 2) {
            ML_BAR(); mlstm_step<false>(S0, C, ctb0, ctb1, hout, b, h, es, c, w, tt, et, lane);
            ML_BAR(); mlstm_step<false>(S1, C, ctb1, ctb0, hout, b, h, es, c + 1, w, tt, et, lane);
        }
#elif MK_ML_PROBE == 2
        __syncthreads();
#pragma unroll 1
        for (int c = 0; c < 128; c += 2) {
            ML_BAR(); mlstm_load_set(S1, Of, qF, wqg, kT, vT, scal, b, h, bh, es, c + 1, w, tt); asm volatile("" :: "v"(S0.qf[0]), "v"(S0.ka[1][1]), "v"(S0.vf[1][1]), "v"(S0.wa[1]), "v"(S0.em), "v"(S0.decay));
            ML_BAR(); mlstm_load_set(S0, Of, qF, wqg, kT, vT, scal, b, h, bh, es, (c + 2 < 128) ? c + 2 : 127, w, tt); asm volatile("" :: "v"(S1.qf[0]), "v"(S1.ka[1][1]), "v"(S1.vf[1][1]), "v"(S1.wa[1]), "v"(S1.em), "v"(S1.decay));
        }
#endif
        __syncthreads();
    }
}

__device__ __forceinline__ void cgate_phase(const float* hout, const bf16* projc, const float* hnorm, bf16* ymix) {
    const int tx_ = opaque_tid();
    const int lane = tx_ & 63, gw = blockIdx.x * NWAVES + __builtin_amdgcn_readfirstlane(tx_ >> 6), NGW = gridDim.x * NWAVES;
    const bool own = gridDim.x == 256; const int j0 = 8 * (int)(blockIdx.x >> 3) + (gw & 7), t0 = 2048 * (int)(blockIdx.x & 7);
    for (int item0 = gw, k = 0; item0 < TOK * 8; item0 += NGW, ++k) {
        const int jj = j0 + 256 * k; const int tok = own ? t0 + (jj >> 3) : item0 >> 3, h = own ? jj & 7 : item0 & 7; const size_t off = (size_t)tok * DM + h * 512 + lane * 8;
#if MK_MLSTM_NAIVE || MK_ML_REFILL
        const f32x4 a = *(const f32x4*)(hout + off), c = *(const f32x4*)(hout + off + 4);
#else
        f32x4 a, c; { float h8[8]; unpack8(*(const u32x4*)((const bf16*)hout + off), h8); a = (f32x4){h8[0], h8[1], h8[2], h8[3]}; c = (f32x4){h8[4], h8[5], h8[6], h8[7]}; }
#endif
        const float ss = wave_sum((a.x * a.x + a.y * a.y) + (a.z * a.z + a.w * a.w) + (c.x * c.x + c.y * c.y) + (c.z * c.z + c.w * c.w));
        const float rstd = rsqrtf(ss * (1.f / 512.f) + RMS_EPS);
        float og[8]; unpack8(*(const u32x4*)(projc + (size_t)tok * C_N + 8192 + h * 512 + lane * 8), og);
        const f32x4 n0 = *(const f32x4*)(hnorm + h * 512 + lane * 8), n1 = *(const f32x4*)(hnorm + h * 512 + lane * 8 + 4);
        u32x4 w; w.x = pk2(sigmoidf_(og[0]) * a.x * rstd * n0.x, sigmoidf_(og[1]) * a.y * rstd * n0.y); w.y = pk2(sigmoidf_(og[2]) * a.z * rstd * n0.z, sigmoidf_(og[3]) * a.w * rstd * n0.w);
        w.z = pk2(sigmoidf_(og[4]) * c.x * rstd * n1.x, sigmoidf_(og[5]) * c.y * rstd * n1.y); w.w = pk2(sigmoidf_(og[6]) * c.z * rstd * n1.z, sigmoidf_(og[7]) * c.w * rstd * n1.w);
        *(u32x4*)(ymix + off) = w;
    }
}


#if MK_GLOG_CMP
__device__ __forceinline__ void cmpf_phase(const float* ref, const float* tst, size_t n, unsigned long long* ctl64) {
    const size_t gt = (size_t)blockIdx.x * 512 + threadIdx.x, NT = (size_t)gridDim.x * 512; unsigned long long cnt = 0, sd = 0, sr = 0;
    for (size_t i = gt; i < n; i += NT) { const float a = ref[i], d = (tst[i] + tst[i + GLOG_P2]) - a;   if (!(fabsf(d) <= 0.004f + 0.02f * fabsf(a))) ++cnt; sd += (unsigned long long)(fminf(d * d, 1e6f) * 16777216.0f); sr += (unsigned long long)(fminf(a * a, 1e6f) * 16777216.0f); }
    for (int o = 32; o >= 1; o >>= 1) { cnt += __shfl_xor(cnt, o); sd += __shfl_xor(sd, o); sr += __shfl_xor(sr, o); }
    if ((threadIdx.x & 63) == 0) { atomicAdd(ctl64, cnt); atomicAdd(ctl64 + 1, sd); atomicAdd(ctl64 + 2, sr); }
}
#endif
#if MK_NSA_CMP
__device__ __forceinline__ void cmp_phase(const bf16* ref, const bf16* tst, int c0, int c1, unsigned long long* ctl64) {
    const int tx_ = opaque_tid();
    const size_t gt = (size_t)blockIdx.x * 512 + tx_, NT = (size_t)gridDim.x * 512; const int cpr = (c1 - c0) / 8;
    unsigned long long cnt = 0, sd = 0, sr = 0;
    for (size_t it = gt; it < (size_t)TOK * cpr; it += NT) { const size_t off = (it / cpr) * DM + c0 + (it % cpr) * 8; float a[8], b[8]; unpack8(*(const u32x4*)(ref + off), a); unpack8(*(const u32x4*)(tst + off), b);
#pragma unroll
        for (int j = 0; j < 8; ++j) { const float d = b[j] - a[j]; if (!(fabsf(d) <= 0.004f + 0.02f * fabsf(a[j]))) ++cnt; sd += (unsigned long long)(fminf(d * d, 1e6f) * 16777216.0f); sr += (unsigned long long)(fminf(a[j] * a[j], 1e6f) * 16777216.0f); } }
    for (int o = 32; o >= 1; o >>= 1) { cnt += __shfl_xor(cnt, o); sd += __shfl_xor(sd, o); sr += __shfl_xor(sr, o); }
    if ((tx_ & 63) == 0) { atomicAdd(ctl64, cnt); atomicAdd(ctl64 + 1, sd); atomicAdd(ctl64 + 2, sr); }
}
#endif

__device__ __forceinline__ void xcd_barrier_rowlocal(const XcdBarrier& b, unsigned* mis) {
    asm volatile("s_waitcnt vmcnt(0)" ::: "memory");
    __syncthreads();
    if (threadIdx.x == 0) {
        unsigned* bar = b.bar;
        __builtin_amdgcn_s_waitcnt(0);
        unsigned nloc = b.st[0], nx = b.st[1];
        if (nloc == 0u) { xcd_barrier_complete(bar, b.x, nloc, nx); b.st[0] = nloc; b.st[1] = nx; }
        const bool local = (xb_ld(mis) == 0u) && (nx == 8u) && (nloc == 32u) && (gridDim.x == 256u);
        const unsigned old = xb_add(&bar[XB_XSUB(b.x)], 1u);
        const unsigned gen = old / nloc;
        if (old + 1u == (gen + 1u) * nloc) {
            if (!local) {
                __builtin_amdgcn_fence(__ATOMIC_RELEASE, "agent");
                asm volatile("s_waitcnt vmcnt(0)" ::: "memory");
                const unsigned og = xb_add(&bar[XB_TOP], 1u);
                const unsigned tg = og / nx;
                if (og + 1u == (tg + 1u) * nx) xb_add(&bar[XB_TOPGEN], 1u);
                else XB_SPIN(xb_ld(&bar[XB_TOPGEN]) == tg, bar);
            }
            __builtin_amdgcn_fence(__ATOMIC_ACQUIRE, "agent");
            xb_add(&bar[XB_XGEN(b.x)], 1u);
            asm volatile("s_waitcnt vmcnt(0)" ::: "memory");
        } else {
            XB_SPIN(xb_ld(&bar[XB_XGEN(b.x)]) == gen, bar);
            __builtin_amdgcn_fence(__ATOMIC_ACQUIRE, "agent");
            asm volatile("s_waitcnt vmcnt(0)" ::: "memory");
        }
    }
    __syncthreads();
}

#ifndef MK_PROBE
#define MK_PROBE 0
#define MK_PROBE_A 3
#define MK_PROBE_B 11
#endif
#ifndef MK_PER_PHASE
#define MK_PER_PHASE 0
#endif
constexpr int NPHASE = 19;
struct Args { const float* in[22]; float* out; unsigned char* ws; int ph_lo, ph_hi; };
__global__ void __launch_bounds__(NWAVES * 64, 2) mk_fwd(Args args) {
    extern __shared__ __attribute__((aligned(16))) unsigned char lds_raw[];
    LAS unsigned char* lds = (LAS unsigned char*)lds_raw;
    volatile LAS unsigned* MISC = (volatile LAS unsigned*)(lds + MISC_OFF);
    const int tid = threadIdx.x;
    if (tid < 64) MISC[tid] = 0u;
    __syncthreads();
    unsigned char* ws = args.ws;
    unsigned* ctl = (unsigned*)(ws + WS_CTL);
    XcdBarrier bar; bar.bar = ctl + CW_BAR; bar.x = 0; bar.st = nullptr;
    if (!MK_PER_PHASE) bar = xcd_barrier_post(ctl + CW_BAR, MISC + 8);
    unsigned* const mis = ctl + 8000;
    if (!MK_PER_PHASE && tid == 0 && bar.x != (blockIdx.x & 7u)) atomicAdd(mis, 1u);
    Ptrs P;
#pragma unroll
    for (int i = 0; i < 22; ++i) P.in[i] = args.in[i];
    P.out = args.out; P.ws = ws;
    const int lo = args.ph_lo, hi = args.ph_hi;
#define IN(k) (lo <= (k) && (k) < hi)
#define GRIDBAR() xcd_barrier(bar)
#define SEAM(k) do { if (IN(k) && IN((k) + 1)) xcd_barrier(bar); STAMP((k) + 1); } while (0)
#define SEAML(k) do { if (IN(k) && IN((k) + 1)) xcd_barrier_rowlocal(bar, mis); STAMP((k) + 1); } while (0)
    bf16* const U = (bf16*)(ws + WS_U); bf16* const PROJ = (bf16*)(ws + WS_PROJ); bf16* const PROJC = (bf16*)(ws + WS_PROJC); bf16* const YMIX = (bf16*)(ws + WS_YMIX); bf16* const Y = (bf16*)(ws + WS_Y);
    bf16* const Gb = (bf16*)(ws + WS_G); bf16* const U2 = (bf16*)(ws + WS_U2); bf16* const ACT = (bf16*)(ws + WS_ACT);
    float* const GLOG = (float*)(ws + WS_GLOG); float* const GIF = (float*)(ws + WS_GIF); bf16* const KCMP = (bf16*)(ws + WS_KCMP); bf16* const VCMP = (bf16*)(ws + WS_VCMP);
    float* const HOUT = (float*)(ws + WS_HOUT);
    const int G = gridDim.x, bx = blockIdx.x;

#if MK_PROBE
    unsigned long long* const tsb = (unsigned long long*)(ctl + 2048);
#define STAMP(k) do { if (blockIdx.x == 0 && tid == 0) tsb[k] = wall_clock64(); } while (0)
#else
#define STAMP(k) do { } while (0)
#endif
    STAMP(0);
    if (IN(0)) REPK(0) { prologue_phase(P, lds); __syncthreads(); } SEAM(0);
    if (IN(1)) {
        pg8::Gemm g{U, (const bf16*)(ws + WS_WAB), TOK, AB_N, DM}; pg8::StaticOrder S; S.init(TOK, AB_N, G, bx);
        pg8::EpiBf16P E{PROJ, AB_N};
        pg8::gemm_phase<pg8::EpiBf16P, pg8::StaticOrder, true, true>(lds, g, S, E);
#if MK_GLOG_CMP
        skinny_phase<5>(U, (const bf16*)(ws + WS_WABG), (float*)(ws + WS_R0 + 256 * MiB), 72, 72);
#endif
    } SEAM(1);
    if (IN(2)) {
        REPK(201) p2a_phase(PROJ, (bf16*)(ws + WS_POOLED), (bf16*)(ws + WS_KCR));
        REPK(202) vt_relayout_phase(PROJ, (bf16*)(ws + WS_VTS), (bf16*)(ws + WS_VTW), (bf16*)(ws + WS_KFS), (bf16*)(ws + WS_KFW), lds);
        GRIDBAR();
        { int kpool = 256; asm volatile("" : "+s"(kpool));
          pg8::Gemm g{(const bf16*)(ws + WS_POOLED), (const bf16*)(ws + WS_WPOOL), 4 * TOK, 1024, kpool}; pg8::PoolOrder S; S.c = bx; S.G = G;
          pg8::EpiPool E{YMIX, P.in[5]};
          pg8::gemm_phase<pg8::EpiPool, pg8::PoolOrder, true, true>(lds, g, S, E); }
        { pg8::Gemm g{(const bf16*)(ws + WS_KCR), (const bf16*)(ws + WS_WCMP), 8192, 1024, 2048}; pg8::CmpOrder S; S.c = bx; S.G = G;
          pg8::EpiCmp E{(float*)(ws + WS_PCMP)};
          pg8::gemm_phase<pg8::EpiCmp, pg8::CmpOrder, true, true>(lds, g, S, E); }
        {
          const bool gsplit = (G == 256); const int ks = gsplit ? (bx & 1) : 0;
          pg8::Gemm g{U + ks * 2048, (const bf16*)(ws + WS_WABG) + ks * 2048, TOK, 256, gsplit ? 2048 : DM, DM}; pg8::GateOrder S; S.c = bx; S.first = gsplit ? 128 : ((G >= 128) ? 64 : 0); S.n = gsplit ? 128 : 64; S.sh = gsplit ? 1 : 0;
          pg8::EpiGate E{GLOG + (size_t)ks * GLOG_P2};
          pg8::gemm_phase<pg8::EpiGate, pg8::GateOrder, true, true>(lds, g, S, E);
          if (!gsplit) for (size_t i = (size_t)bx * 512 + tid; i < (size_t)GLOG_P2; i += (size_t)G * 512) GLOG[GLOG_P2 + i] = 0.f; }
        GRIDBAR();
        REPK(203) p2c_phase((const float*)(ws + WS_PCMP), (const float*)(ws + WS_CPART), P.in[8], P.in[10], KCMP, (bf16*)(ws + WS_VCT), (bf16*)(ws + WS_KCF), MK_NSA_CMP ? VCMP : (bf16*)nullptr, lds);
#if MK_NSA_CMP
    } SEAM(2);
#else
    } SEAML(2);
#endif
    if (IN(3)) {
#if MK_GLOG_CMP
        cmpf_phase((const float*)(ws + WS_R0 + 256 * MiB), GLOG, (size_t)TOK * 72, (unsigned long long*)(ctl + 3072));
#endif
#if MK_NSA_CMP
        nsa_naive_phase(PROJ, KCMP, VCMP, GLOG, (bf16*)(ws + WS_YMIX2), lds); __syncthreads();
#endif
#if MK_NSA_V1
        nsa_fast_phase(PROJ, KCMP, (const bf16*)(ws + WS_VCT), (const bf16*)(ws + WS_VTS), (const bf16*)(ws + WS_VTW), GLOG, YMIX, lds);
#else
        nsa_fast2_phase(PROJ, (const bf16*)(ws + WS_KCF), (const bf16*)(ws + WS_VCT), (const bf16*)(ws + WS_KFS), (const bf16*)(ws + WS_VTS), (const bf16*)(ws + WS_KFW), (const bf16*)(ws + WS_VTW), GLOG, YMIX, lds);
#endif
    } SEAM(3);
    if (IN(4)) {
#if MK_NSA_CMP
        cmp_phase((const bf16*)(ws + WS_YMIX2), YMIX, 1024, 4096, (unsigned long long*)(ctl + 3072));
#endif
        pg8::Gemm g{YMIX, (const bf16*)(ws + WS_WOAB), TOK, DM, DM}; pg8::StaticOrder S; S.init(TOK, DM, G, bx);
        pg8::EpiBf16P E{Y, DM};
        pg8::gemm_phase<pg8::EpiBf16P, pg8::StaticOrder, true, true>(lds, g, S, E);
    } SEAML(4);
    if (IN(5)) REPK(5) { post_phase<false, true>(Y, P.in[2], P.in[0], ws + WS_HB, P.in[16], U); } SEAML(5);
    if (IN(6)) {
        pg8::Gemm g{U, (const bf16*)(ws + WS_WF1), TOK, F1N, DM}; LAS unsigned char* wl = lds + pg8::STAGE_BYTES + __builtin_amdgcn_readfirstlane((int)(threadIdx.x >> 6)) * 2048;
        pg8::ActOrder S; S.S.init(TOK, F1N, G, bx); S.cw = P.in[19]; S.cb = P.in[20]; S.dff = DFF; S.wl = wl;
        pg8::EpiAct E{ACT, (bf16*)(ws + WS_SIDE), wl, FFP, DFF};
        pg8::gemm_phase<pg8::EpiAct, pg8::ActOrder, true, true>(lds, g, S, E);
        { const int full = S.S.nwg / G, left = S.S.nwg - full * G;
          __syncthreads(); if (left == 0) f2_convert_tail(P, 0, bx, G, lds); else if (bx >= left) f2_convert_tail(P, 0, bx - left, G - left, lds); }
    } SEAM(6);
    if (IN(7)) REPK(7) { act_fix_phase((const bf16*)(ws + WS_SIDE), P.in[19], P.in[20], ACT); } SEAML(7);
    if (IN(8)) {
        pg8::Gemm g{ACT, (const bf16*)(ws + WS_WF2), TOK, DM, FFP}; pg8::StaticOrder S; S.init(TOK, DM, G, bx);
        pg8::EpiBf16P E{Y, DM};
        pg8::gemm_phase<pg8::EpiBf16P, pg8::StaticOrder, true, true>(lds, g, S, E);
    } SEAML(8);
    if (IN(9)) { post_phase<true, true>(Y, P.in[17], ws + WS_HB, ws + WS_HB, P.in[1] + DM, U); } SEAML(9);
    if (IN(10)) {
        pg8::Gemm g{U, (const bf16*)(ws + WS_WC), TOK, C_N, DM}; pg8::StaticOrder S; S.init(TOK, C_N, G, bx);
        pg8::EpiBf16P E{PROJC, C_N};
        pg8::gemm_phase<pg8::EpiBf16P, pg8::StaticOrder, true, true>(lds, g, S, E);
#if MK_MLSTM_NAIVE
        skinny_phase<1>(U, (const bf16*)(ws + WS_WCG), GIF, 16, 16);
#else
        REPK(110) cgates_phase(U, (const bf16*)(ws + WS_WCG), P.in[13], (float*)(ws + WS_LSC), lds);
#endif
    } SEAM(10);
    if (IN(11)) {
#if MK_MLSTM_NAIVE
        mlstm_naive_phase(PROJC, GIF, P.in[13], HOUT, lds);
#else
        REPK(111) mlstm_pre2_phase(PROJC, (const float*)(ws + WS_LSC), (float*)(ws + WS_SCAL), (bf16*)(ws + WS_WQ), (bf16*)(ws + WS_KT), (bf16*)(ws + WS_VT), (bf16*)(ws + WS_QF), lds);
        GRIDBAR();
        REPK(11) mlstm_fast2_phase((const bf16*)(ws + WS_QF), (const bf16*)(ws + WS_WQ), (const bf16*)(ws + WS_KT), (const bf16*)(ws + WS_VT), (const float*)(ws + WS_SCAL), HOUT, lds);
#endif
    } SEAM(11);
    if (IN(12)) REPK(12) { cgate_phase(HOUT, PROJC, P.in[14], YMIX); } SEAML(12);
    if (IN(13)) {
        pg8::Gemm g{YMIX, (const bf16*)(ws + WS_WOC), TOK, DM, DM}; pg8::StaticOrder S; S.init(TOK, DM, G, bx);
        pg8::EpiBf16P E{Y, DM};
        pg8::gemm_phase<pg8::EpiBf16P, pg8::StaticOrder, true, true>(lds, g, S, E);
    } SEAML(13);
    if (IN(14)) { post_phase<true, true>(Y, P.in[2] + DM, ws + WS_HB, ws + WS_HB, P.in[16] + DM, U); } SEAML(14);
    if (IN(15)) {
        pg8::Gemm g{U, (const bf16*)(ws + WS_WF1 + WF1_BYTES), TOK, F1N, DM}; LAS unsigned char* wl = lds + pg8::STAGE_BYTES + __builtin_amdgcn_readfirstlane((int)(threadIdx.x >> 6)) * 2048;
        pg8::ActOrder S; S.S.init(TOK, F1N, G, bx); S.cw = P.in[19] + 3 * DFF; S.cb = P.in[20] + DFF; S.dff = DFF; S.wl = wl;
        pg8::EpiAct E{ACT, (bf16*)(ws + WS_SIDE), wl, FFP, DFF};
        pg8::gemm_phase<pg8::EpiAct, pg8::ActOrder, true, true>(lds, g, S, E);
        { const int full = S.S.nwg / G, left = S.S.nwg - full * G;
          __syncthreads(); if (left == 0) f2_convert_tail(P, 1, bx, G, lds); else if (bx >= left) f2_convert_tail(P, 1, bx - left, G - left, lds); }
    } SEAM(15);
    if (IN(16)) { act_fix_phase((const bf16*)(ws + WS_SIDE), P.in[19] + 3 * DFF, P.in[20] + DFF, ACT); } SEAML(16);
    if (IN(17)) {
        pg8::Gemm g{ACT, (const bf16*)(ws + WS_WF2 + WF2_BYTES), TOK, DM, FFP}; pg8::StaticOrder S; S.init(TOK, DM, G, bx);
        pg8::EpiBf16P E{Y, DM};
        pg8::gemm_phase<pg8::EpiBf16P, pg8::StaticOrder, true, true>(lds, g, S, E);
    } SEAML(17);
    if (IN(18)) { post_phase<true, false>(Y, P.in[17] + DM, ws + WS_HB, P.out, nullptr, U); }
#if MK_NSA_CMP || MK_GLOG_CMP
    xcd_barrier(bar);
    if (blockIdx.x == 0 && tid == 0) { const unsigned long long* c64 = (const unsigned long long*)(ctl + 3072);
        const double cnt = (double)__hip_atomic_load(c64, __ATOMIC_RELAXED, __HIP_MEMORY_SCOPE_AGENT), sd = (double)__hip_atomic_load(c64 + 1, __ATOMIC_RELAXED, __HIP_MEMORY_SCOPE_AGENT), sr = (double)__hip_atomic_load(c64 + 2, __ATOMIC_RELAXED, __HIP_MEMORY_SCOPE_AGENT);
        P.out[0] = (float)(sqrt(sd / (sr + 1.0)) * 1e4);
        P.out[1] = (float)(sqrt(cnt) * 30.0);
    }
#endif
#if MK_PROBE
    xcd_barrier(bar); STAMP(19); xcd_barrier(bar);
    {
        const float c1 = (float)((double)(__hip_atomic_load(tsb + MK_PROBE_A + 1, __ATOMIC_RELAXED, __HIP_MEMORY_SCOPE_AGENT) - __hip_atomic_load(tsb + MK_PROBE_A, __ATOMIC_RELAXED, __HIP_MEMORY_SCOPE_AGENT)) * 0.01);
        const float c2 = (float)((double)(__hip_atomic_load(tsb + MK_PROBE_B + 1, __ATOMIC_RELAXED, __HIP_MEMORY_SCOPE_AGENT) - __hip_atomic_load(tsb + MK_PROBE_B, __ATOMIC_RELAXED, __HIP_MEMORY_SCOPE_AGENT)) * 0.0001);
        for (size_t i = (size_t)blockIdx.x * 512 + tid; i < (size_t)TOK * DM; i += (size_t)gridDim.x * 512) P.out[i] = (i == 0) ? c1 : c2;
    }
#endif
#undef IN
#undef SEAM
}

extern "C" void kernel_launch(void* const* d_in, const int* in_sizes, int n_in, void* d_out, int out_size, void* d_ws, size_t ws_size, hipStream_t stream) {
    static int grid = 0;
    if (grid == 0) {
        if (n_in != 22 || in_sizes[0] != TOK * DM || out_size != TOK * DM || ws_size < WS_END) { fprintf(stderr, "kernel_launch: unexpected problem shape or workspace (n_in %d, ws %zu < %zu); nothing launched\n", n_in, ws_size, (size_t)WS_END); grid = -1; return; }
        int dev = 0, cus = 0, per_cu = 0;
        if (hipGetDevice(&dev) != hipSuccess || hipDeviceGetAttribute(&cus, hipDeviceAttributeMultiprocessorCount, dev) != hipSuccess) { grid = -1; return; }
        if (hipFuncSetAttribute((const void*)mk_fwd, hipFuncAttributeMaxDynamicSharedMemorySize, LDS_BYTES) != hipSuccess) { fprintf(stderr, "kernel_launch: hipFuncSetAttribute failed\n"); grid = -1; return; }
        if (hipOccupancyMaxActiveBlocksPerMultiprocessor(&per_cu, (const void*)mk_fwd, NWAVES * 64, LDS_BYTES) != hipSuccess || per_cu < 1)
            fprintf(stderr, "kernel_launch: note: occupancy query reports %d workgroups per CU\n", per_cu);
        (void)hipGetLastError();
        grid = cus;
    }
    if (grid < 0) return;
    if (hipMemsetAsync((char*)d_ws + WS_CTL, 0, CTL_ZERO_BYTES, stream) != hipSuccess) return;
    Args a{};
    for (int i = 0; i < 22; ++i) a.in[i] = (const float*)d_in[i];
    a.out = (float*)d_out; a.ws = (unsigned char*)d_ws;
#if MK_PER_PHASE
    for (int p = 0; p < NPHASE; ++p) { a.ph_lo = p; a.ph_hi = p + 1; hipLaunchKernelGGL(mk_fwd, dim3(grid), dim3(NWAVES * 64), LDS_BYTES, stream, a); }
#else
    a.ph_lo = 0; a.ph_hi = NPHASE;
    hipLaunchKernelGGL(mk_fwd, dim3(grid), dim3(NWAVES * 64), LDS_BYTES, stream, a);
#endif
}
```
